# Optimizing an MI355X kernel written in HIP

```python
import math
import jax, jax.numpy as jnp
from jax import lax
import numpy as np

D_MODEL = 4096
BATCH = 4
SEQ = 2048
DEPTH = 2
DEC_BATCH = 128
DEC_SEQ = 8
PAST_LEN = 16384
PAGE_SIZE = 128

N_MIXERS = 2
N_SSM_LAYERS = (DEPTH + 1) // 2
N_POOL_LAYERS = DEPTH // 2
SSM_GROUP = 16
SSM_GROUPS = D_MODEL // SSM_GROUP
SSM_STATE = 64
SSM_BLOCK = 128
DT_MIN = 1e-3
DT_MAX = 1e-1
POOL_WINDOWS = (2, 4, 8, 16)
POOL_GROUPS = len(POOL_WINDOWS)
POOL_WIDTH = D_MODEL // POOL_GROUPS
POOL_BUF = max(POOL_WINDOWS) - 1
D_FF = -(-(8 * D_MODEL) // (3 * 256)) * 256
RMS_EPS = 1e-6

kernel_name = "s5_pool_hybrid_decode_step"


def rmsnorm(x, g):
    xf = x.astype(jnp.float32)
    y = xf * lax.rsqrt(jnp.mean(xf * xf, axis=-1, keepdims=True) + RMS_EPS) * g.astype(jnp.float32)
    return y.astype(x.dtype)


def _ssm_combine(e1, e2):
    a1r, a1i, b1r, b1i = e1
    a2r, a2i, b2r, b2i = e2
    return (a1r * a2r - a1i * a2i,
            a1r * a2i + a1i * a2r,
            a2r * b1r - a2i * b1i + b2r,
            a2r * b1i + a2i * b1r + b2i)


def s5_mixer(h, h0_re, h0_im, lam_re, lam_im, log_step, b_re, b_im, c_re, c_im, d_skip, w_glu):
    bt, t, _ = h.shape
    f32 = jnp.float32
    lr = lam_re.astype(f32)
    li = lam_im.astype(f32)
    dt = jnp.exp(log_step.astype(f32))[:, None]
    mag = jnp.exp(lr * dt)
    ar = mag * jnp.cos(li * dt)
    ai = mag * jnp.sin(li * dt)
    den = lr * lr + li * li
    fr = ((ar - 1.0) * lr + ai * li) / den
    fi = (ai * lr - (ar - 1.0) * li) / den
    br = b_re.astype(f32)
    bi = b_im.astype(f32)
    bbr = fr[..., None] * br - fi[..., None] * bi
    bbi = fr[..., None] * bi + fi[..., None] * br
    cr = c_re.astype(f32)
    ci = c_im.astype(f32)

    blk = math.gcd(t, SSM_BLOCK)
    nb = t // blk
    u = h.astype(f32)
    ub = jnp.swapaxes(u, 0, 1).reshape(nb, blk, bt, SSM_GROUPS, SSM_GROUP)
    a_r = jnp.broadcast_to(ar, (blk, 1, SSM_GROUPS, SSM_STATE))
    a_i = jnp.broadcast_to(ai, (blk, 1, SSM_GROUPS, SSM_STATE))

    def block(carry, u_blk):
        sr, si = carry
        bur = jnp.einsum('tbgc,gpc->tbgp', u_blk, bbr)
        bui = jnp.einsum('tbgc,gpc->tbgp', u_blk, bbi)
        bur = bur.at[0].add(ar * sr - ai * si)
        bui = bui.at[0].add(ar * si + ai * sr)
        _, _, xr, xi = lax.associative_scan(_ssm_combine, (a_r, a_i, bur, bui), axis=0)
        y = jnp.einsum('tbgp,gcp->tbgc', xr, cr) - jnp.einsum('tbgp,gcp->tbgc', xi, ci)
        return (xr[-1], xi[-1]), y

    if h0_re is None:
        s0 = (jnp.zeros((bt, SSM_GROUPS, SSM_STATE), f32), jnp.zeros((bt, SSM_GROUPS, SSM_STATE), f32))
    else:
        s0 = (h0_re.astype(f32), h0_im.astype(f32))
    (sr, si), yb = lax.scan(block, s0, ub)
    y = jnp.swapaxes(yb.reshape(t, bt, D_MODEL), 0, 1) + d_skip.astype(f32) * u
    y = jax.nn.gelu(y).astype(h.dtype)
    g = y @ w_glu
    out = g[..., :D_MODEL] * jax.nn.sigmoid(g[..., D_MODEL:])
    return out, sr.astype(h.dtype), si.astype(h.dtype)


def pool_mixer(h, buf, start_pos, w_pool, scale):
    bt, t, d = h.shape
    f32 = jnp.float32
    hf = h.astype(f32)
    past = jnp.zeros((bt, POOL_BUF, d), f32) if buf is None else buf.astype(f32)
    ext = jnp.concatenate([past, hf], axis=1)
    cs = jnp.concatenate([jnp.zeros((bt, 1, d), f32), jnp.cumsum(ext, axis=1)], axis=1)
    pos = jnp.arange(t, dtype=jnp.int32) + start_pos
    parts = []
    for gi, w in enumerate(POOL_WINDOWS):
        sl = slice(gi * POOL_WIDTH, (gi + 1) * POOL_WIDTH)
        lo = POOL_BUF + 1 - w
        wsum = cs[:, POOL_BUF + 1:POOL_BUF + 1 + t, sl] - cs[:, lo:lo + t, sl]
        cnt = jnp.minimum(pos + 1, w).astype(f32)[:, None]
        parts.append(wsum / cnt - hf[:, :, sl])
    p = jnp.stack(parts, axis=2).astype(h.dtype)
    z = jnp.einsum('btgc,gcd->btgd', p, w_pool).reshape(bt, t, d)
    out = z * scale
    new_buf = ext[:, -POOL_BUF:, :].astype(h.dtype)
    return out, new_buf


def swiglu(h, w_gate_up, w_down):
    gu = h @ w_gate_up
    return (jax.nn.silu(gu[..., :D_FF]) * gu[..., D_FF:]) @ w_down


def trunk(x, ssm_re, ssm_im, pool_buf, start_pos, norm_mix, norm_ffn, ssm_lambda_re, ssm_lambda_im,
          ssm_log_step, ssm_b_re, ssm_b_im, ssm_c_re, ssm_c_im, ssm_d, ssm_w_glu, pool_w, pool_scale,
          ffn_w_gate_up, ffn_w_down, norm_final):
    new_re, new_im, new_pool = [], [], []
    for i in range(DEPTH):
        j = i // N_MIXERS
        h = rmsnorm(x, norm_mix[i])
        if i % N_MIXERS == 0:
            h0r = None if ssm_re is None else ssm_re[j]
            h0i = None if ssm_im is None else ssm_im[j]
            out, sr, si = s5_mixer(h, h0r, h0i, ssm_lambda_re[j], ssm_lambda_im[j], ssm_log_step[j],
                                   ssm_b_re[j], ssm_b_im[j], ssm_c_re[j], ssm_c_im[j], ssm_d[j], ssm_w_glu[j])
            new_re.append(sr)
            new_im.append(si)
        else:
            pb = None if pool_buf is None else pool_buf[j]
            out, nbuf = pool_mixer(h, pb, start_pos, pool_w[j], pool_scale[j])
            new_pool.append(nbuf)
        x = x + out
        x = x + swiglu(rmsnorm(x, norm_ffn[i]), ffn_w_gate_up[i], ffn_w_down[i])
    y = rmsnorm(x, norm_final)
    return y, jnp.stack(new_re), jnp.stack(new_im), jnp.stack(new_pool)


def setup_inputs(seed: int = 0) -> dict:
    key = jax.random.key(seed)
    k = jax.random.split(key, 24)
    f32 = jnp.float32
    nrm = lambda kk, shape, s: jax.random.normal(kk, shape, f32) * s
    G, P, C = SSM_GROUPS, SSM_STATE, SSM_GROUP
    lam_im0 = jnp.broadcast_to(math.pi * jnp.arange(P, dtype=f32), (N_SSM_LAYERS, G, P))
    return {
        "x_prompt": nrm(k[0], (BATCH, SEQ, D_MODEL), 1.0),
        "x_sample": nrm(k[1], (DEC_BATCH, DEC_SEQ, D_MODEL), 1.0),
        "state_ssm_re": nrm(k[2], (N_SSM_LAYERS, DEC_BATCH, G, P), 0.1),
        "state_ssm_im": nrm(k[3], (N_SSM_LAYERS, DEC_BATCH, G, P), 0.1),
        "state_pool": nrm(k[4], (N_POOL_LAYERS, DEC_BATCH, POOL_BUF, D_MODEL), 1.0),
        "norm_mix": 1.0 + nrm(k[5], (DEPTH, D_MODEL), 0.02),
        "norm_ffn": 1.0 + nrm(k[6], (DEPTH, D_MODEL), 0.02),
        "ssm_lambda_re": -0.5 + nrm(k[7], (N_SSM_LAYERS, G, P), 0.01),
        "ssm_lambda_im": lam_im0 + nrm(k[8], (N_SSM_LAYERS, G, P), 0.01),
        "ssm_log_step": jax.random.uniform(k[9], (N_SSM_LAYERS, G), f32, math.log(DT_MIN), math.log(DT_MAX)),
        "ssm_b_re": nrm(k[10], (N_SSM_LAYERS, G, P, C), (2 * C) ** -0.5),
        "ssm_b_im": nrm(k[11], (N_SSM_LAYERS, G, P, C), (2 * C) ** -0.5),
        "ssm_c_re": nrm(k[12], (N_SSM_LAYERS, G, C, P), P ** -0.5),
        "ssm_c_im": nrm(k[13], (N_SSM_LAYERS, G, C, P), P ** -0.5),
        "ssm_d": nrm(k[14], (N_SSM_LAYERS, D_MODEL), 1.0),
        "ssm_w_glu": nrm(k[15], (N_SSM_LAYERS, D_MODEL, 2 * D_MODEL), D_MODEL ** -0.5),
        "pool_w": nrm(k[16], (N_POOL_LAYERS, POOL_GROUPS, POOL_WIDTH, POOL_WIDTH), POOL_WIDTH ** -0.5),
        "pool_scale": 1.0 + nrm(k[17], (N_POOL_LAYERS, D_MODEL), 0.02),
        "ffn_w_gate_up": nrm(k[18], (DEPTH, D_MODEL, 2 * D_FF), D_MODEL ** -0.5),
        "ffn_w_down": nrm(k[19], (DEPTH, D_FF, D_MODEL), D_FF ** -0.5),
        "norm_final": 1.0 + nrm(k[20], (D_MODEL,), 0.02),
    }


def reference(x_prompt, x_sample, state_ssm_re, state_ssm_im, state_pool, norm_mix, norm_ffn,
              ssm_lambda_re, ssm_lambda_im, ssm_log_step, ssm_b_re, ssm_b_im, ssm_c_re, ssm_c_im,
              ssm_d, ssm_w_glu, pool_w, pool_scale, ffn_w_gate_up, ffn_w_down, norm_final):
    y_prompt, ssm_re_p, ssm_im_p, pool_p = trunk(
        x_prompt, None, None, None, 0, norm_mix, norm_ffn, ssm_lambda_re, ssm_lambda_im, ssm_log_step,
        ssm_b_re, ssm_b_im, ssm_c_re, ssm_c_im, ssm_d, ssm_w_glu, pool_w, pool_scale,
        ffn_w_gate_up, ffn_w_down, norm_final)
    y_sample, ssm_re_s, ssm_im_s, pool_s = trunk(
        x_sample, state_ssm_re, state_ssm_im, state_pool, PAST_LEN, norm_mix, norm_ffn, ssm_lambda_re,
        ssm_lambda_im, ssm_log_step, ssm_b_re, ssm_b_im, ssm_c_re, ssm_c_im, ssm_d, ssm_w_glu, pool_w,
        pool_scale, ffn_w_gate_up, ffn_w_down, norm_final)
    return (y_prompt, y_sample, ssm_re_p, ssm_im_p, pool_p, ssm_re_s, ssm_im_s, pool_s)
```

```cpp
#include <hip/hip_runtime.h>
#include <cstdio>
#include <cstdint>
namespace pg8 {
#define PG8_LAS __attribute__((address_space(3)))
typedef unsigned short bf16_t;
typedef short bf16x8 __attribute__((ext_vector_type(8)));
typedef float f32x4 __attribute__((ext_vector_type(4)));
typedef unsigned u32x4 __attribute__((ext_vector_type(4)));
constexpr int BM = 256, BK = 64, HALF = 128, HTB = HALF * BK * 2  , STAGE_BYTES = 8 * HTB, NXCD = 8, WGM = 8;

__host__ __device__ __forceinline__ int lds_byte(int r, int c) { const int st = (r >> 4) * 2 + (c >> 5), rr = r & 15, cc = c & 31, ob = rr * 64 + cc * 2; return st * 1024 + (ob ^ (((ob >> 9) & 1) << 5)); }
__host__ __device__ __forceinline__ void stage_rc(int b, int& R, int& C) { const int st = b / 1024, sb = b % 1024, swz = sb ^ (((sb >> 9) & 1) << 5); R = (st >> 1) * 16 + swz / 64; C = (st & 1) * 32 + (swz % 64) / 2; }
__host__ __device__ __forceinline__ int perm32(int rho) { const int n = rho >> 4, i = rho & 15; return 8 * (i >> 2) + 4 * n + (i & 3); }

struct Unit { int pm, pn; };
struct Gemm { const bf16_t* A; const bf16_t* Bt; int M, N, K; };

struct StaticOrder {
    int nM, nN, nwg, G, c;
    __host__ __device__ void init(int M, int N, int G_, int c_) { nM = M / BM; nN = N / BM; nwg = nM * nN; G = G_; c = c_; }
    __host__ __device__ bool next(int i, Unit& u) const {
        const long L = (long)i * G + c; if (L >= nwg) return false;
        int wgid = (int)L; { const int q = nwg / NXCD, r = nwg % NXCD, xcd = wgid % NXCD, off = wgid / NXCD; wgid = (xcd < r ? xcd * (q + 1) : r * (q + 1) + (xcd - r) * q) + off; }
        const int nig = WGM * nN, gid = wgid / nig, fm = gid * WGM, gsz = (nM - fm) < WGM ? (nM - fm) : WGM;
        u.pm = fm + ((wgid % nig) % gsz); u.pn = (wgid % nig) / gsz; return true;
    }
    __device__ __forceinline__ void a_ready(const Unit&) const {}
    __device__ __forceinline__ void done(const Unit&) const {}
};


__device__ __forceinline__ unsigned cvt_pk_bf16(float lo, float hi) { unsigned r; asm volatile("v_cvt_pk_bf16_f32 %0, %1, %2" : "=v"(r) : "v"(lo), "v"(hi)); return r; }
__device__ __forceinline__ float sigmoid_f(float x) { return __builtin_amdgcn_rcpf(1.0f + __expf(-x)); }

struct EpiGlu {
    static constexpr bool PERM = false, AFTER_DRAIN = false;
    const float* xin_p; const float* xin_s; float* xout;
    __device__ __forceinline__ void operator()(const f32x4 (&acc)[2][2][4][2], const Unit& u, int wr, int wc, int fr, int fq) const {
        const int row0 = u.pm * BM + wr * 64 + fr, col0 = u.pn * HALF + wc * 32 + 4 * fq;
        const float* xb = (u.pm < 32) ? xin_p + (size_t)row0 * 4096 : xin_s + (size_t)(row0 - 8192) * 4096;
        float* ob = xout + (size_t)row0 * 4096;
#pragma unroll
        for (int ai = 0; ai < 2; ++ai)
#pragma unroll
            for (int m = 0; m < 4; ++m) { const size_t off = (size_t)(ai * HALF + m * 16) * 4096 + col0;
#pragma unroll
                for (int n = 0; n < 2; ++n) { const f32x4 xv = *(const f32x4*)(xb + off + 16 * n); const f32x4 a = acc[ai][0][m][n], b = acc[ai][1][m][n]; f32x4 o;
#pragma unroll
                    for (int j = 0; j < 4; ++j) o[j] = xv[j] + a[j] * sigmoid_f(b[j]);
                    *(f32x4*)(ob + off + 16 * n) = o; } }
    }
};
struct EpiSwiglu {
    static constexpr bool PERM = true, AFTER_DRAIN = false;
    bf16_t* O; int ldc;
    __device__ __forceinline__ void operator()(const f32x4 (&acc)[2][2][4][2], const Unit& u, int wr, int wc, int fr, int fq) const {
        const int row0 = u.pm * BM + wr * 64 + fr, col0 = u.pn * HALF + wc * 32 + 8 * fq;
#pragma unroll
        for (int ai = 0; ai < 2; ++ai)
#pragma unroll
            for (int m = 0; m < 4; ++m) { bf16_t* rowp = O + (size_t)(row0 + ai * HALF + m * 16) * ldc + col0;
                f32x4 h[2];
#pragma unroll
                for (int n = 0; n < 2; ++n) { const f32x4 g = acc[ai][0][m][n], v = acc[ai][1][m][n];
#pragma unroll
                    for (int j = 0; j < 4; ++j) h[n][j] = g[j] * sigmoid_f(g[j]) * v[j]; }
                u32x4 w; w.x = cvt_pk_bf16(h[0][0], h[0][1]); w.y = cvt_pk_bf16(h[0][2], h[0][3]); w.z = cvt_pk_bf16(h[1][0], h[1][1]); w.w = cvt_pk_bf16(h[1][2], h[1][3]);
                *(u32x4*)rowp = w; }
    }
};
template <bool POOL> struct EpiResid {
    static constexpr bool PERM = false, AFTER_DRAIN = false;
    float* x; const float* scale;
    __device__ __forceinline__ void operator()(const f32x4 (&acc)[2][2][4][2], const Unit& u, int wr, int wc, int fr, int fq) const {
        const int pm = POOL ? (u.pm % 36) : u.pm;
        const int row0 = pm * BM + wr * 64 + fr, col0 = u.pn * BM + wc * 32 + 4 * fq;
        f32x4 sv[2][2];
#pragma unroll
        for (int bj = 0; bj < 2; ++bj)
#pragma unroll
            for (int n = 0; n < 2; ++n) sv[bj][n] = POOL ? *(const f32x4*)(scale + col0 + bj * HALF + n * 16) : (f32x4){1.f, 1.f, 1.f, 1.f};
#pragma unroll
        for (int ai = 0; ai < 2; ++ai)
#pragma unroll
            for (int m = 0; m < 4; ++m) { float* rowp = x + (size_t)(row0 + ai * HALF + m * 16) * 4096 + col0;
#pragma unroll
                for (int bj = 0; bj < 2; ++bj)
#pragma unroll
                    for (int n = 0; n < 2; ++n) { const f32x4 xv = *(const f32x4*)(rowp + bj * HALF + n * 16);
                        *(f32x4*)(rowp + bj * HALF + n * 16) = POOL ? xv + acc[ai][bj][m][n] * sv[bj][n] : xv + acc[ai][bj][m][n]; } }
    }
};
struct PoolOrder {
    int G, c;
    __device__ bool next(int i, Unit& u) const {
        const int L = i * G + c; if (L >= 576) return false;
        const int grp = L / 144, rem = L % 144; u.pm = grp * 36 + rem % 36; u.pn = grp * 4 + rem / 36; return true;
    }
    __device__ __forceinline__ void a_ready(const Unit&) const {}
    __device__ __forceinline__ void done(const Unit&) const {}
};

template <class Epi, class Sched, bool ALIGN_EPI = false, bool SP2 = false>
__device__ __forceinline__ void gemm_phase(PG8_LAS unsigned char* lds, const Gemm g, const Sched& S, const Epi& E) {
    const int tid = threadIdx.x, wid = __builtin_amdgcn_readfirstlane(tid >> 6), lane = tid & 63, wr = wid >> 2, wc = wid & 3, fr = lane & 15, fq = lane >> 4;
    const int K = g.K, nt = K / BK;
    unsigned voffA[2], voffB[2];
#pragma unroll
    for (int i = 0; i < 2; ++i) { int R, C; stage_rc(tid * 16 + i * 8192, R, C); const int Rb = Epi::PERM ? ((R & ~31) + perm32(R & 31)) : R;
        voffA[i] = (unsigned)(R * K + C) * 2u; voffB[i] = (unsigned)(Rb * K + C) * 2u; }
    const size_t kstep = (size_t)(BK * 2);
    const size_t hstep = (size_t)HALF * K * 2;
    const size_t tstep = 2 * hstep;
    const unsigned ldsw = (unsigned)wid * 1024u;
    const int aoff = lds_byte(wr * 64 + fr, fq * 8), boff = lds_byte(wc * 32 + fr, fq * 8);
#define PG8_SA(b, h) (((b) * 2 + (h)) * HTB)
#define PG8_SB(b, h) ((4 + (b) * 2 + (h)) * HTB)
#define PG8_STAGE(bufoff, gbase, voff) do { _Pragma("unroll") for (int _i = 0; _i < 2; ++_i) \
        __builtin_amdgcn_global_load_lds((const unsigned*)((const char*)(gbase) + (voff)[_i]), (PG8_LAS unsigned*)(lds + (bufoff) + ldsw + _i * 8192), 16, 0, 0); } while (0)
#define PG8_LDA(dst, b, h) do { _Pragma("unroll") for (int m = 0; m < 4; ++m) _Pragma("unroll") for (int k = 0; k < 2; ++k) dst[m][k] = *(const PG8_LAS bf16x8*)(lds + PG8_SA(b, h) + aoff + m * 2048 + k * 1024); } while (0)
#define PG8_LDB(dst, b, h) do { _Pragma("unroll") for (int n = 0; n < 2; ++n) _Pragma("unroll") for (int k = 0; k < 2; ++k) dst[n][k] = *(const PG8_LAS bf16x8*)(lds + PG8_SB(b, h) + boff + n * 2048 + k * 1024); } while (0)
#define PG8_MMA(ai, bj, At, Bt) do { __builtin_amdgcn_s_setprio(1); _Pragma("unroll") for (int m = 0; m < 4; ++m) _Pragma("unroll") for (int n = 0; n < 2; ++n) _Pragma("unroll") for (int k = 0; k < 2; ++k) \
        acc[ai][bj][m][n] = __builtin_amdgcn_mfma_f32_16x16x32_bf16(Bt[n][k], At[m][k], acc[ai][bj][m][n], 0, 0, 0); __builtin_amdgcn_s_setprio(0); } while (0)
#define PG8_WAIT_V(n) asm volatile("s_waitcnt vmcnt(" #n ")" ::: "memory")
#define PG8_WAIT_L(n) asm volatile("s_waitcnt lgkmcnt(" #n ")" ::: "memory")
#define PG8_BAR __builtin_amdgcn_s_barrier()
#define PG8_SCHED __builtin_amdgcn_sched_barrier(0)
    Unit cur, nxt; int ui = 0;
    if (!S.next(0, cur)) return;
    f32x4 acc[2][2][4][2];
#pragma unroll
    for (int a = 0; a < 2; ++a)
#pragma unroll
        for (int b = 0; b < 2; ++b)
#pragma unroll
            for (int m = 0; m < 4; ++m)
#pragma unroll
                for (int n = 0; n < 2; ++n) acc[a][b][m][n] = (f32x4){0.f, 0.f, 0.f, 0.f};
    bf16x8 At[4][2], B0[2][2], B1[2][2];
    const char* cA = (const char*)g.A + (size_t)cur.pm * tstep; const char* cB = (const char*)g.Bt + (size_t)cur.pn * tstep;
    S.a_ready(cur);
    if constexpr (SP2) {
        PG8_STAGE(PG8_SB(0, 0), cB, voffB); PG8_STAGE(PG8_SB(0, 1), cB + hstep, voffB); PG8_STAGE(PG8_SA(0, 0), cA, voffA); PG8_STAGE(PG8_SA(0, 1), cA + hstep, voffA);
        if (wr == 1) PG8_BAR;
        PG8_WAIT_V(2); PG8_BAR;
        PG8_STAGE(PG8_SB(1, 0), cB + kstep, voffB); PG8_STAGE(PG8_SA(1, 0), cA + kstep, voffA); PG8_STAGE(PG8_SB(1, 1), cB + hstep + kstep, voffB);
        PG8_WAIT_V(6); PG8_BAR;
    } else {
        PG8_STAGE(PG8_SB(0, 0), cB, voffB); PG8_STAGE(PG8_SA(0, 0), cA, voffA); PG8_STAGE(PG8_SB(0, 1), cB + hstep, voffB); PG8_STAGE(PG8_SA(0, 1), cA + hstep, voffA);
        if (wr == 1) PG8_BAR;
        PG8_WAIT_V(4); PG8_BAR;
        PG8_STAGE(PG8_SB(1, 0), cB + kstep, voffB); PG8_STAGE(PG8_SA(1, 0), cA + kstep, voffA); PG8_STAGE(PG8_SB(1, 1), cB + hstep + kstep, voffB);
        PG8_WAIT_V(6); PG8_BAR;
    }
    for (;;) {
        const bool has_next = S.next(ui + 1, nxt);
        const char* nA = has_next ? (const char*)g.A + (size_t)nxt.pm * tstep : cA; const char* nB = has_next ? (const char*)g.Bt + (size_t)nxt.pn * tstep : cB;
        for (int t = 0; t < nt; t += 2) {
            const bool last = (t == nt - 2);
            const char* a1 = cA + (size_t)(t + 1) * kstep;
            const char* a2 = last ? nA : cA + (size_t)(t + 2) * kstep; const char* b2 = last ? nB : cB + (size_t)(t + 2) * kstep;
            const char* a3 = a2 + kstep; const char* b3 = b2 + kstep;
            if (last && has_next) S.a_ready(nxt);
            if constexpr (SP2) {
            PG8_LDB(B0, 0, 0); PG8_LDB(B1, 0, 1); PG8_SCHED; PG8_LDA(At, 0, 0); PG8_STAGE(PG8_SA(1, 1), a1 + hstep, voffA);
            PG8_WAIT_V(8); PG8_WAIT_L(0); PG8_BAR; PG8_MMA(0, 0, At, B0); PG8_MMA(0, 1, At, B1); PG8_BAR; PG8_SCHED;
            PG8_LDA(At, 0, 1); PG8_STAGE(PG8_SB(0, 0), b2, voffB); PG8_STAGE(PG8_SB(0, 1), b2 + hstep, voffB); PG8_STAGE(PG8_SA(0, 0), a2, voffA);
            PG8_WAIT_V(8); PG8_WAIT_L(0); PG8_BAR; PG8_MMA(1, 0, At, B0); PG8_MMA(1, 1, At, B1); PG8_BAR; PG8_SCHED;
            PG8_LDB(B0, 1, 0); PG8_LDB(B1, 1, 1); PG8_SCHED; PG8_LDA(At, 1, 0); PG8_STAGE(PG8_SA(0, 1), a2 + hstep, voffA);
            PG8_WAIT_V(8); PG8_WAIT_L(0); PG8_BAR; PG8_MMA(0, 0, At, B0); PG8_MMA(0, 1, At, B1); PG8_BAR; PG8_SCHED;
            PG8_LDA(At, 1, 1); PG8_STAGE(PG8_SB(1, 0), b3, voffB); PG8_STAGE(PG8_SB(1, 1), b3 + hstep, voffB); PG8_STAGE(PG8_SA(1, 0), a3, voffA);
            PG8_WAIT_V(8); PG8_WAIT_L(0); PG8_BAR; PG8_MMA(1, 0, At, B0); PG8_MMA(1, 1, At, B1); PG8_BAR; PG8_SCHED;
            } else {
            PG8_LDB(B0, 0, 0); PG8_SCHED; PG8_LDA(At, 0, 0); PG8_STAGE(PG8_SA(1, 1), a1 + hstep, voffA);
            PG8_WAIT_L(8); PG8_BAR; PG8_WAIT_L(0); PG8_MMA(0, 0, At, B0); PG8_BAR; PG8_SCHED;
            PG8_LDB(B1, 0, 1); PG8_STAGE(PG8_SB(0, 0), b2, voffB);
            PG8_BAR; PG8_WAIT_L(0); PG8_MMA(0, 1, At, B1); PG8_BAR;
            PG8_LDA(At, 0, 1); PG8_STAGE(PG8_SA(0, 0), a2, voffA);
            PG8_BAR; PG8_WAIT_L(0); PG8_MMA(1, 0, At, B0); PG8_BAR; PG8_SCHED;
            PG8_STAGE(PG8_SB(0, 1), b2 + hstep, voffB);
            PG8_WAIT_V(6); PG8_BAR; PG8_MMA(1, 1, At, B1); PG8_BAR;
            PG8_LDB(B0, 1, 0); PG8_SCHED; PG8_LDA(At, 1, 0); PG8_STAGE(PG8_SA(0, 1), a2 + hstep, voffA);
            PG8_WAIT_L(8); PG8_BAR; PG8_WAIT_L(0); PG8_MMA(0, 0, At, B0); PG8_BAR; PG8_SCHED;
            PG8_LDB(B1, 1, 1); PG8_STAGE(PG8_SB(1, 0), b3, voffB);
            PG8_BAR; PG8_WAIT_L(0); PG8_MMA(0, 1, At, B1); PG8_BAR;
            PG8_LDA(At, 1, 1); PG8_STAGE(PG8_SA(1, 0), a3, voffA);
            PG8_BAR; PG8_WAIT_L(0); PG8_MMA(1, 0, At, B0); PG8_BAR; PG8_SCHED;
            PG8_STAGE(PG8_SB(1, 1), b3 + hstep, voffB);
            PG8_WAIT_V(6); PG8_BAR; PG8_MMA(1, 1, At, B1); PG8_BAR;
            }
        }
        if constexpr (ALIGN_EPI) { if (wr == 0) PG8_BAR; }
        if constexpr (!Epi::AFTER_DRAIN) { E(acc, cur, wr, wc, fr, fq); S.done(cur); }
        if (!has_next) break;
#pragma unroll
        for (int a = 0; a < 2; ++a)
#pragma unroll
            for (int b = 0; b < 2; ++b)
#pragma unroll
                for (int m = 0; m < 4; ++m)
#pragma unroll
                    for (int n = 0; n < 2; ++n) acc[a][b][m][n] = (f32x4){0.f, 0.f, 0.f, 0.f};
        cur = nxt; cA = nA; cB = nB; ++ui;
        if constexpr (ALIGN_EPI) { if (wr == 1) PG8_BAR; }
    }
    PG8_WAIT_V(0);
    if constexpr (!ALIGN_EPI) { if (wr == 0) PG8_BAR; }
    PG8_BAR;
    if constexpr (Epi::AFTER_DRAIN) { E.fused(acc, cur, wr, wc, fr, fq, lds, wid, lane); S.done(cur); }
#undef PG8_SA
#undef PG8_SB
#undef PG8_STAGE
#undef PG8_LDA
#undef PG8_LDB
#undef PG8_MMA
#undef PG8_WAIT_V
#undef PG8_WAIT_L
#undef PG8_BAR
#undef PG8_SCHED
}
}

#ifndef PG8_SP2
#define PG8_SP2 true
#endif
#ifndef PG8_ALIGN
#define PG8_ALIGN true
#endif
#ifndef MK_ONE_LAUNCH
#define MK_ONE_LAUNCH 0
#endif

constexpr int NWAVES = 8;
constexpr int DM = 4096, SEQ = 2048, NB = 4, DB = 128, DS = 8, MP = NB * SEQ, MS = DB * DS, M = MP + MS;
constexpr int DFF = 11008, NGRP = 256, NST = 64, NCH = 16, PBUF = 15;
constexpr float RMS_EPS = 1e-6f;
constexpr int N_PHASES = 13;
constexpr size_t O_YP = 0, O_YS = (size_t)MP * DM, O_SRP = O_YS + (size_t)MS * DM, O_SIP = O_SRP + (size_t)NB * NGRP * NST, O_PP = O_SIP + (size_t)NB * NGRP * NST,
                 O_SRS = O_PP + (size_t)NB * PBUF * DM, O_SIS = O_SRS + (size_t)DB * NGRP * NST, O_PS = O_SIS + (size_t)DB * NGRP * NST, O_END = O_PS + (size_t)DB * PBUF * DM;
constexpr size_t MiB = 1u << 20;
constexpr size_t WS_CTL = 0, CTL_ZERO_BYTES = 1 * MiB;
constexpr size_t WS_WGLU = 16 * MiB, WS_WGU0 = 80 * MiB, WS_WGU1 = 252 * MiB, WS_WDN0 = 424 * MiB, WS_WDN1 = 510 * MiB, WS_WPOOL = 596 * MiB;
constexpr size_t WS_XRES = 608 * MiB, WS_HA = 752 * MiB, WS_YSSM = 824 * MiB, WS_PPOOL = 896 * MiB, WS_HID = 968 * MiB, WS_SSMP = 1164 * MiB, WS_RSTD = 1169 * MiB, WS_END = 1170 * MiB;
static_assert(WS_WGLU + (size_t)2 * DM * DM * 2 <= WS_WGU0 && WS_WGU0 + (size_t)2 * DFF * DM * 2 <= WS_WGU1 && WS_WGU1 + (size_t)2 * DFF * DM * 2 <= WS_WDN0 && WS_WDN0 + (size_t)DM * DFF * 2 <= WS_WDN1 &&
              WS_WDN1 + (size_t)DM * DFF * 2 <= WS_WPOOL && WS_WPOOL + (size_t)4 * 1024 * 1024 * 2 <= WS_XRES && WS_XRES + (size_t)M * DM * 4 <= WS_HA && WS_HA + (size_t)M * DM * 2 <= WS_YSSM &&
              WS_YSSM + (size_t)M * DM * 2 <= WS_PPOOL && WS_PPOOL + (size_t)M * DM * 2 <= WS_HID && WS_HID + (size_t)M * DFF * 2 <= WS_SSMP, "d_ws map");
constexpr size_t SP_AR = 0, SP_AI = 16384, SP_BBR = 32768, SP_BBI = 32768 + 262144;
constexpr int CW_BAR = 4096;
constexpr int RING_OFF = 0, RING_BYTES = 131072;
constexpr int LDSCTL_OFF = RING_BYTES, MISC_OFF = LDSCTL_OFF + 320;
constexpr int LDS_BYTES = 147456;
static_assert(MISC_OFF + 128 <= LDS_BYTES, "LDS map");

#define GAS __attribute__((address_space(1)))
#define LAS __attribute__((address_space(3)))
typedef unsigned short bf16;
typedef unsigned v4u __attribute__((ext_vector_type(4)));
typedef float f32x4 __attribute__((ext_vector_type(4)));
typedef short bf16x8 __attribute__((ext_vector_type(8)));
typedef GAS unsigned gu32;
typedef GAS unsigned long long gu64;
#define RLX_AGENT __ATOMIC_RELAXED, __HIP_MEMORY_SCOPE_AGENT
#define LDS_WAIT() asm volatile("s_waitcnt lgkmcnt(0)" ::: "memory")
#define VM_WAIT() asm volatile("s_waitcnt vmcnt(0)" ::: "memory")
__device__ __forceinline__ unsigned long long rt() { return __builtin_amdgcn_s_memrealtime(); }
__device__ __forceinline__ unsigned f2bf(float f) { unsigned u = __builtin_bit_cast(unsigned, f); return (u + 0x7fffu + ((u >> 16) & 1u)) >> 16; }
__device__ __forceinline__ unsigned pk2(float lo, float hi) { return f2bf(lo) | (f2bf(hi) << 16); }

#define XB_TMO      128
#define XB_XCNT(j)  (256  + 64 * (j))
#define XB_XSUB(j)  (1280 + 64 * (j))
#define XB_XGEN(j)  (2304 + 64 * (j))
#define XB_TOP      3328
#define XB_TOPGEN   3392
#define XCD_BAR_WORDS 3456
#define XB_SPIN_CAP (1u << 18)

__device__ __forceinline__ unsigned xb_ld(unsigned* p)              { return __hip_atomic_load(p, __ATOMIC_RELAXED, __HIP_MEMORY_SCOPE_AGENT); }
__device__ __forceinline__ unsigned xb_add(unsigned* p, unsigned v) { return __hip_atomic_fetch_add(p, v, __ATOMIC_RELAXED, __HIP_MEMORY_SCOPE_AGENT); }
__device__ __forceinline__ unsigned xb_xcc_id() { return (unsigned)__builtin_amdgcn_s_getreg((3 << 11) | 20) & 0xFu; }
#define XB_SPIN(cond, bar) do { unsigned _sp = 0; while (cond) { __builtin_amdgcn_s_sleep(1); \
    if ((++_sp & 255u) == 0u) { if (xb_ld(&(bar)[XB_TMO])) break; if (_sp > XB_SPIN_CAP) { atomicAdd(&(bar)[XB_TMO], 1u); break; } } } } while (0)

struct XcdBarrier {
    unsigned* bar; unsigned x;
    volatile LAS unsigned* st;
};

__device__ __forceinline__ XcdBarrier xcd_barrier_post(unsigned* bar, volatile LAS unsigned* st) {
    XcdBarrier b; b.bar = bar; b.x = xb_xcc_id(); b.st = st;
    if (threadIdx.x == 0) (void)xb_add(&bar[XB_XCNT(b.x)], 1u);
    return b;
}
__device__ __forceinline__ void xcd_barrier_complete(unsigned* bar, unsigned x, unsigned& nloc, unsigned& nx) {
    const unsigned G = gridDim.x * gridDim.y * gridDim.z;
    unsigned sum, cnt, mine, sp = 0u;
    for (;;) {
        sum = 0u; cnt = 0u; mine = 0u;
#pragma unroll
        for (unsigned j = 0; j < 16; ++j) { const unsigned c = xb_ld(&bar[XB_XCNT(j)]); sum += c; cnt += (c > 0u) ? 1u : 0u; mine = (j == x) ? c : mine; }
        if (sum == G) break;
        __builtin_amdgcn_s_sleep(1);
        if ((++sp & 255u) == 0u) { if (xb_ld(&bar[XB_TMO])) break; if (sp > XB_SPIN_CAP) { atomicAdd(&bar[XB_TMO], 1u); break; } }
    }
    nloc = mine > 0u ? mine : 1u; nx = cnt > 0u ? cnt : 1u;
}

__device__ __forceinline__ void xcd_barrier(const XcdBarrier& b) {
    asm volatile("s_waitcnt vmcnt(0)" ::: "memory");
    __syncthreads();
    if (threadIdx.x == 0) {
        unsigned* bar = b.bar;
        __builtin_amdgcn_s_waitcnt(0);
        unsigned nloc = b.st[0], nx = b.st[1];
        if (nloc == 0u) { xcd_barrier_complete(bar, b.x, nloc, nx); b.st[0] = nloc; b.st[1] = nx; }
        const unsigned old = xb_add(&bar[XB_XSUB(b.x)], 1u);
        const unsigned gen = old / nloc;
        if (old + 1u == (gen + 1u) * nloc) {
            __builtin_amdgcn_fence(__ATOMIC_RELEASE, "agent");
            asm volatile("s_waitcnt vmcnt(0)" ::: "memory");
            const unsigned og = xb_add(&bar[XB_TOP], 1u);
            const unsigned tg = og / nx;
            if (og + 1u == (tg + 1u) * nx) xb_add(&bar[XB_TOPGEN], 1u);
            else XB_SPIN(xb_ld(&bar[XB_TOPGEN]) == tg, bar);
            __builtin_amdgcn_fence(__ATOMIC_ACQUIRE, "agent");
            xb_add(&bar[XB_XGEN(b.x)], 1u);
            asm volatile("s_waitcnt vmcnt(0)" ::: "memory");
        } else {
            XB_SPIN(xb_ld(&bar[XB_XGEN(b.x)]) == gen, bar);
            __builtin_amdgcn_fence(__ATOMIC_ACQUIRE, "agent");
            asm volatile("s_waitcnt vmcnt(0)" ::: "memory");
        }
    }
    __syncthreads();
}

struct Frame {
    LAS unsigned char* lds;
    volatile LAS unsigned* MISC;
    gu32* ctl;
    int tid, lane, wave;
    int vcu, G;
    const float* in[21];
    float* out;
    unsigned char* ws;
};
enum { I_XP = 0, I_XS, I_SRE, I_SIM, I_SPOOL, I_NMIX, I_NFFN, I_LRE, I_LIM, I_LSTEP, I_BRE, I_BIM, I_CRE, I_CIM, I_SD, I_WGLU, I_WPOOL, I_PSCALE, I_WGU, I_WDN, I_NFIN };

__device__ __forceinline__ float wave_sum(float v) {
#pragma unroll
    for (int o = 1; o < 64; o <<= 1) v += __shfl_xor(v, o);
    return v;
}
__device__ __forceinline__ unsigned cvtpk(float lo, float hi) { unsigned r; asm volatile("v_cvt_pk_bf16_f32 %0, %1, %2" : "=v"(r) : "v"(lo), "v"(hi)); return r; }
__device__ __forceinline__ const float* xrow_in(const Frame& F, int r) { return r < MP ? F.in[I_XP] + (size_t)r * DM : F.in[I_XS] + (size_t)(r - MP) * DM; }

__device__ __forceinline__ void tr_item(const float* W, int K, int N, bf16* WT, int k0, int n0, int drow0, int lane) {
    const int kq = lane >> 3, nq = lane & 7;
    f32x4 v[2][8];
#pragma unroll
    for (int h = 0; h < 2; ++h)
#pragma unroll
        for (int i = 0; i < 8; ++i) v[h][i] = *(const GAS f32x4*)(W + (size_t)(k0 + 8 * kq + i) * N + n0 + 32 * h + 4 * nq);
#pragma unroll
    for (int h = 0; h < 2; ++h)
#pragma unroll
        for (int j = 0; j < 4; ++j) { v4u o; o.x = cvtpk(v[h][0][j], v[h][1][j]); o.y = cvtpk(v[h][2][j], v[h][3][j]); o.z = cvtpk(v[h][4][j], v[h][5][j]); o.w = cvtpk(v[h][6][j], v[h][7][j]);
            *(GAS v4u*)(WT + (size_t)(drow0 + 32 * h + 4 * nq + j) * K + k0 + 8 * kq) = o; }
}
__device__ __forceinline__ int drow_pair(int n0, int NH) { const int half = n0 >= NH ? 1 : 0, nn = n0 - half * NH; return 256 * (nn >> 7) + 128 * half + (nn & 127); }

__device__ __forceinline__ double exp_d(double x) {
    const double k = __builtin_rint(x * 1.4426950408889634074); const double r = x - k * 0.69314718055994530942;
    double s = 1.0, t = 1.0;
#pragma unroll
    for (int i = 1; i <= 16; ++i) { t *= r / (double)i; s += t; }
    const long long e = (long long)k + 1023; return s * __builtin_bit_cast(double, (unsigned long long)e << 52);
}
__device__ __forceinline__ void sincos_d(double th, double& sn, double& cs) {
    const double n = __builtin_rint(th * 0.15915494309189533577); const double r = (th - n * 6.283185307179586232) - n * 2.4492935982947064e-16; const double r2 = r * r;
    double s = r, c = 1.0, ts = r, tc = 1.0;
#pragma unroll
    for (int i = 1; i <= 15; ++i) { tc *= -r2 / (double)((2 * i - 1) * (2 * i)); ts *= -r2 / (double)((2 * i) * (2 * i + 1)); c += tc; s += ts; }
    sn = s; cs = c;
}

__device__ __forceinline__ void p0_prologue(Frame& F) {
    const int gw = F.vcu * NWAVES + F.wave, NGW = F.G * NWAVES;
    constexpr int I_GLU = (DM / 64) * (2 * DM / 64), I_GU = (DM / 64) * (2 * DFF / 64), I_DN = (DFF / 64) * (DM / 64), I_PL = 4 * 16 * 16;
    constexpr int NITEMS = I_GLU + 2 * I_GU + 2 * I_DN + I_PL;
    for (int it = gw; it < NITEMS; it += NGW) {
        int r = it;
        if (r < I_GLU) { const int nb = r % (2 * DM / 64), kb = r / (2 * DM / 64); tr_item(F.in[I_WGLU], DM, 2 * DM, (bf16*)(F.ws + WS_WGLU), kb * 64, nb * 64, drow_pair(nb * 64, DM), F.lane); continue; } r -= I_GLU;
        if (r < 2 * I_GU) { const int l = r / I_GU; r -= l * I_GU; const int nb = r % (2 * DFF / 64), kb = r / (2 * DFF / 64);
            tr_item(F.in[I_WGU] + (size_t)l * DM * 2 * DFF, DM, 2 * DFF, (bf16*)(F.ws + (l ? WS_WGU1 : WS_WGU0)), kb * 64, nb * 64, drow_pair(nb * 64, DFF), F.lane); continue; } r -= 2 * I_GU;
        if (r < 2 * I_DN) { const int l = r / I_DN; r -= l * I_DN; const int nb = r % (DM / 64), kb = r / (DM / 64);
            tr_item(F.in[I_WDN] + (size_t)l * DFF * DM, DFF, DM, (bf16*)(F.ws + (l ? WS_WDN1 : WS_WDN0)), kb * 64, nb * 64, nb * 64, F.lane); continue; } r -= 2 * I_DN;
        { const int g = r / 256; r -= g * 256; const int nb = r % 16, kb = r / 16;
            tr_item(F.in[I_WPOOL] + (size_t)g * 1024 * 1024, 1024, 1024, (bf16*)(F.ws + WS_WPOOL) + (size_t)g * 1024 * 1024, kb * 64, nb * 64, nb * 64, F.lane); }
    }
    float* rstd0 = (float*)(F.ws + WS_RSTD);
    for (int r = gw; r < M; r += NGW) { const GAS f32x4* xr = (const GAS f32x4*)xrow_in(F, r) + F.lane; float s = 0.f;
#pragma unroll
        for (int j = 0; j < 16; ++j) { const f32x4 v = xr[64 * j]; s += (v.x * v.x + v.y * v.y) + (v.z * v.z + v.w * v.w); }
        s = wave_sum(s); if (F.lane == 0) rstd0[r] = 1.0f / sqrtf(s * (1.0f / DM) + RMS_EPS); }
    float* sp = (float*)(F.ws + WS_SSMP);
    for (int idx = F.vcu * (NWAVES * 64) + F.tid; idx < NGRP * NST; idx += F.G * NWAVES * 64) {
        const int g = idx >> 6;
        const double lr = (double)F.in[I_LRE][idx], li = (double)F.in[I_LIM][idx], dt = exp_d((double)F.in[I_LSTEP][g]);
        const double mag = exp_d(lr * dt); double sn, cs; sincos_d(li * dt, sn, cs);
        const double ar = mag * cs, ai = mag * sn, den = lr * lr + li * li;
        const double fr = ((ar - 1.0) * lr + ai * li) / den, fi = (ai * lr - (ar - 1.0) * li) / den;
        sp[SP_AR + idx] = (float)ar; sp[SP_AI + idx] = (float)ai;
#pragma unroll
        for (int c4 = 0; c4 < 4; ++c4) { const f32x4 br = *(const GAS f32x4*)(F.in[I_BRE] + (size_t)idx * 16 + 4 * c4), bi = *(const GAS f32x4*)(F.in[I_BIM] + (size_t)idx * 16 + 4 * c4); f32x4 orr, oi;
#pragma unroll
            for (int j = 0; j < 4; ++j) { orr[j] = (float)(fr * (double)br[j] - fi * (double)bi[j]); oi[j] = (float)(fr * (double)bi[j] + fi * (double)br[j]); }
            *(GAS f32x4*)(sp + SP_BBR + (size_t)idx * 16 + 4 * c4) = orr; *(GAS f32x4*)(sp + SP_BBI + (size_t)idx * 16 + 4 * c4) = oi; }
    }
}

__device__ __forceinline__ float gelu_tanh(float x) { const float z = 0.7978845608028654f * (x + 0.044715f * x * x * x); return x * __builtin_amdgcn_rcpf(1.0f + __expf(-2.0f * z)); }
__device__ __forceinline__ void ssm_task(Frame& F, int seq, int g) {
    const int lane = F.lane, cidx = (lane >> 2) & 15;
    const float* sp = (const float*)(F.ws + WS_SSMP); const float* rstd0 = (const float*)(F.ws + WS_RSTD);
    const int sidx = g * NST + lane;
    const float ar = sp[SP_AR + sidx], ai = sp[SP_AI + sidx];
    float bre[16], bim[16], cre[16], cim[16];
#pragma unroll
    for (int c4 = 0; c4 < 4; ++c4) { const f32x4 a = *(const GAS f32x4*)(sp + SP_BBR + (size_t)sidx * 16 + 4 * c4), b = *(const GAS f32x4*)(sp + SP_BBI + (size_t)sidx * 16 + 4 * c4);
#pragma unroll
        for (int j = 0; j < 4; ++j) { bre[4 * c4 + j] = a[j]; bim[4 * c4 + j] = b[j]; } }
#pragma unroll
    for (int c = 0; c < 16; ++c) { cre[c] = F.in[I_CRE][((size_t)g * 16 + c) * NST + lane]; cim[c] = F.in[I_CIM][((size_t)g * 16 + c) * NST + lane]; }
    const float gain = F.in[I_NMIX][g * 16 + cidx], dsk = F.in[I_SD][g * 16 + cidx];
    int row0, T; float xr, xi; float *ore, *oim;
    if (seq < NB) { row0 = seq * SEQ; T = SEQ; xr = 0.f; xi = 0.f; ore = F.out + O_SRP + ((size_t)seq * NGRP + g) * NST; oim = F.out + O_SIP + ((size_t)seq * NGRP + g) * NST; }
    else { const int b = seq - NB; row0 = MP + b * DS; T = DS; xr = F.in[I_SRE][((size_t)b * NGRP + g) * NST + lane]; xi = F.in[I_SIM][((size_t)b * NGRP + g) * NST + lane];
        ore = F.out + O_SRS + ((size_t)b * NGRP + g) * NST; oim = F.out + O_SIS + ((size_t)b * NGRP + g) * NST; }
    const float* xb = xrow_in(F, row0) + g * 16 + cidx;
    bf16* yb = (bf16*)(F.ws + WS_YSSM) + (size_t)row0 * DM + g * 16 + cidx;
    float xn = xb[0], rn = rstd0[row0];
    for (int t = 0; t < T; ++t) {
        const float uu = xn * rn * gain;
        if (t + 1 < T) { xn = xb[(size_t)(t + 1) * DM]; rn = rstd0[row0 + t + 1]; }
        float bur = 0.f, bui = 0.f;
#pragma unroll
        for (int c = 0; c < 16; ++c) { const float uc = __builtin_bit_cast(float, __builtin_amdgcn_readlane(__builtin_bit_cast(int, uu), 4 * c)); bur = fmaf(bre[c], uc, bur); bui = fmaf(bim[c], uc, bui); }
        const float nxr = fmaf(-ai, xi, fmaf(ar, xr, bur)), nxi = fmaf(ai, xr, fmaf(ar, xi, bui)); xr = nxr; xi = nxi;
        float v[16];
#pragma unroll
        for (int c = 0; c < 16; ++c) v[c] = fmaf(-xi, cim[c], xr * cre[c]);
#pragma unroll
        for (int i = 0; i < 8; ++i) { const bool hi = (lane & 32) != 0; const float send = hi ? v[i] : v[i + 8], keep = hi ? v[i + 8] : v[i]; v[i] = keep + __shfl_xor(send, 32); }
#pragma unroll
        for (int i = 0; i < 4; ++i) { const bool hi = (lane & 16) != 0; const float send = hi ? v[i] : v[i + 4], keep = hi ? v[i + 4] : v[i]; v[i] = keep + __shfl_xor(send, 16); }
#pragma unroll
        for (int i = 0; i < 2; ++i) { const bool hi = (lane & 8) != 0; const float send = hi ? v[i] : v[i + 2], keep = hi ? v[i + 2] : v[i]; v[i] = keep + __shfl_xor(send, 8); }
        { const bool hi = (lane & 4) != 0; const float send = hi ? v[0] : v[1], keep = hi ? v[1] : v[0]; v[0] = keep + __shfl_xor(send, 4); }
        float ys = v[0]; ys += __shfl_xor(ys, 2); ys += __shfl_xor(ys, 1);
        const float y = gelu_tanh(ys + dsk * uu);
        if ((lane & 3) == 0) yb[(size_t)t * DM] = (bf16)f2bf(y);
    }
    ore[lane] = xr; oim[lane] = xi;
}
__device__ __forceinline__ void p1_ssm(Frame& F) {
    if (F.wave < 4) {
        for (int task = F.vcu * 4 + F.wave; task < NB * NGRP; task += F.G * 4) ssm_task(F, task >> 8, task & 255);
    } else {
        for (int task = F.vcu * 4 + (F.wave - 4); task < DB * NGRP; task += F.G * 4) ssm_task(F, NB + (task >> 8), task & 255);
    }
}

__device__ __forceinline__ void norm_rows_bf16(Frame& F, const float* gain, bf16* dst) {
    const int gw = F.vcu * NWAVES + F.wave, NGW = F.G * NWAVES; const float* X = (const float*)(F.ws + WS_XRES);
    for (int r = gw; r < M; r += NGW) { const GAS f32x4* xr = (const GAS f32x4*)(X + (size_t)r * DM) + F.lane; f32x4 v[16]; float s = 0.f;
#pragma unroll
        for (int j = 0; j < 16; ++j) { v[j] = xr[64 * j]; s += (v[j].x * v[j].x + v[j].y * v[j].y) + (v[j].z * v[j].z + v[j].w * v[j].w); }
        const float rs = 1.0f / sqrtf(wave_sum(s) * (1.0f / DM) + RMS_EPS);
        GAS unsigned long long* o8 = (GAS unsigned long long*)(dst + (size_t)r * DM) + F.lane;
#pragma unroll
        for (int j = 0; j < 16; ++j) { const f32x4 gv = *((const GAS f32x4*)gain + F.lane + 64 * j);
            o8[64 * j] = (unsigned long long)cvtpk(v[j].x * rs * gv.x, v[j].y * rs * gv.y) | ((unsigned long long)cvtpk(v[j].z * rs * gv.z, v[j].w * rs * gv.w) << 32); } }
}
__device__ __forceinline__ void norm_rows_f32(Frame& F, const float* gain, float* dst) {
    const int gw = F.vcu * NWAVES + F.wave, NGW = F.G * NWAVES; const float* X = (const float*)(F.ws + WS_XRES);
    for (int r = gw; r < M; r += NGW) { const GAS f32x4* xr = (const GAS f32x4*)(X + (size_t)r * DM) + F.lane; f32x4 v[16]; float s = 0.f;
#pragma unroll
        for (int j = 0; j < 16; ++j) { v[j] = xr[64 * j]; s += (v[j].x * v[j].x + v[j].y * v[j].y) + (v[j].z * v[j].z + v[j].w * v[j].w); }
        const float rs = 1.0f / sqrtf(wave_sum(s) * (1.0f / DM) + RMS_EPS);
        GAS f32x4* o = (GAS f32x4*)(dst + (size_t)r * DM) + F.lane;
#pragma unroll
        for (int j = 0; j < 16; ++j) { const f32x4 gv = *((const GAS f32x4*)gain + F.lane + 64 * j); o[64 * j] = v[j] * rs * gv; } }
}
__device__ __forceinline__ void rstd_rows(Frame& F, float* rstd) {
    const int gw = F.vcu * NWAVES + F.wave, NGW = F.G * NWAVES; const float* X = (const float*)(F.ws + WS_XRES);
    for (int r = gw; r < M; r += NGW) { const GAS f32x4* xr = (const GAS f32x4*)(X + (size_t)r * DM) + F.lane; float s = 0.f;
#pragma unroll
        for (int j = 0; j < 16; ++j) { const f32x4 v = xr[64 * j]; s += (v.x * v.x + v.y * v.y) + (v.z * v.z + v.w * v.w); }
        s = wave_sum(s); if (F.lane == 0) rstd[r] = 1.0f / sqrtf(s * (1.0f / DM) + RMS_EPS); }
}
__device__ __forceinline__ void pool_elem(Frame& F) {
    const float* X = (const float*)(F.ws + WS_XRES); const float* rstd1 = (const float*)(F.ws + WS_RSTD) + M; const float* gain = F.in[I_NMIX] + DM;
    bf16* PP = (bf16*)(F.ws + WS_PPOOL);
    const size_t NT = (size_t)F.G * NWAVES * 64;
    for (size_t idx = (size_t)F.vcu * NWAVES * 64 + F.tid; idx < (size_t)M * (DM / 4); idx += NT) {
        const int r = (int)(idx >> 10), c4 = (int)(idx & 1023), c = 4 * c4, gi = c4 >> 8, w = 2 << gi;
        const f32x4 gv = *(const GAS f32x4*)(gain + c);
        const bool prompt = r < MP; const int t = prompt ? (r & (SEQ - 1)) : ((r - MP) & (DS - 1));
        const f32x4 h = *(const GAS f32x4*)(X + (size_t)r * DM + c) * rstd1[r] * gv;
        f32x4 s = h;
        for (int j = 1; j < w; ++j) { const int tt = t - j;
            if (tt >= 0) s += *(const GAS f32x4*)(X + (size_t)(r - j) * DM + c) * rstd1[r - j] * gv;
            else if (!prompt) s += *(const GAS f32x4*)(F.in[I_SPOOL] + ((size_t)((r - MP) >> 3) * PBUF + (PBUF + tt)) * DM + c); }
        const float cnt = prompt ? (float)((t + 1) < w ? (t + 1) : w) : (float)w;
        const f32x4 p = s / cnt - h;
        *(GAS unsigned long long*)(PP + ((size_t)gi * M + r) * 1024 + (c & 1023)) = (unsigned long long)cvtpk(p.x, p.y) | ((unsigned long long)cvtpk(p.z, p.w) << 32);
        if (prompt) { if (t >= SEQ - PBUF) *(GAS f32x4*)(F.out + O_PP + ((size_t)(r >> 11) * PBUF + (t - (SEQ - PBUF))) * DM + c) = h; }
        else { const int b = (r - MP) >> 3; float* ob = F.out + O_PS + (size_t)b * PBUF * DM + c;
            *(GAS f32x4*)(ob + (size_t)(PBUF - DS + t) * DM) = h;
            if (t < PBUF - DS) *(GAS f32x4*)(ob + (size_t)t * DM) = *(const GAS f32x4*)(F.in[I_SPOOL] + ((size_t)b * PBUF + DS + t) * DM + c); }
    }
}

struct Args { const float* in[21]; float* out; unsigned char* ws; int ph_lo, ph_hi; };
__global__ void __launch_bounds__(NWAVES * 64, 2) skel_fwd(Args args) {
    extern __shared__ __attribute__((aligned(16))) unsigned char lds[];
    Frame F;
    F.lds = (LAS unsigned char*)lds;
    F.MISC = (volatile LAS unsigned*)(F.lds + MISC_OFF);
    F.tid = threadIdx.x; F.lane = F.tid & 63; F.wave = __builtin_amdgcn_readfirstlane(F.tid >> 6);
    F.G = gridDim.x; { const int bx = blockIdx.x; F.vcu = (F.G % 8 == 0) ? (bx % 8) * (F.G / 8) + bx / 8 : bx; }
    unsigned char* ws = args.ws; F.ws = ws; F.out = args.out;
    F.ctl = (gu32*)(ws + WS_CTL);
#pragma unroll
    for (int i = 0; i < 21; ++i) F.in[i] = args.in[i];
    for (int u = F.tid; u < (LDS_BYTES - LDSCTL_OFF) / 4; u += NWAVES * 64) ((LAS unsigned*)(F.lds + LDSCTL_OFF))[u] = 0u;
    __syncthreads();
    const int lo = args.ph_lo, hi = args.ph_hi;
    const bool use_bar = (hi - lo) > 1;
    XcdBarrier bar; bar.bar = (unsigned*)(F.ctl + CW_BAR); bar.x = 0; bar.st = nullptr;
    if (use_bar) bar = xcd_barrier_post((unsigned*)(F.ctl + CW_BAR), F.MISC + 8);
#define IN(k) (lo <= (k) && (k) < hi)
#define SEAM(k) do { if (IN(k) && IN((k) + 1)) xcd_barrier(bar); } while (0)

    if (IN(0)) { p0_prologue(F); SEAM(0); }
    if (IN(1)) { p1_ssm(F); SEAM(1); }
    if (IN(2)) {
        pg8::Gemm g{(const pg8::bf16_t*)(ws + WS_YSSM), (const pg8::bf16_t*)(ws + WS_WGLU), M, 2 * DM, DM}; pg8::StaticOrder S; S.init(M, 2 * DM, F.G, (int)blockIdx.x);
        pg8::EpiGlu E{F.in[I_XP], F.in[I_XS], (float*)(ws + WS_XRES)};
        pg8::gemm_phase<pg8::EpiGlu, pg8::StaticOrder, PG8_ALIGN, PG8_SP2>(F.lds + RING_OFF, g, S, E);
        SEAM(2);
    }
    if (IN(3)) { norm_rows_bf16(F, F.in[I_NFFN], (bf16*)(ws + WS_HA)); SEAM(3); }
    if (IN(4)) {
        pg8::Gemm g{(const pg8::bf16_t*)(ws + WS_HA), (const pg8::bf16_t*)(ws + WS_WGU0), M, 2 * DFF, DM}; pg8::StaticOrder S; S.init(M, 2 * DFF, F.G, (int)blockIdx.x);
        pg8::EpiSwiglu E{(pg8::bf16_t*)(ws + WS_HID), DFF};
        pg8::gemm_phase<pg8::EpiSwiglu, pg8::StaticOrder, PG8_ALIGN, PG8_SP2>(F.lds + RING_OFF, g, S, E);
        SEAM(4);
    }
    if (IN(5)) {
        pg8::Gemm g{(const pg8::bf16_t*)(ws + WS_HID), (const pg8::bf16_t*)(ws + WS_WDN0), M, DM, DFF}; pg8::StaticOrder S; S.init(M, DM, F.G, (int)blockIdx.x);
        pg8::EpiResid<false> E{(float*)(ws + WS_XRES), nullptr};
        pg8::gemm_phase<pg8::EpiResid<false>, pg8::StaticOrder, PG8_ALIGN, PG8_SP2>(F.lds + RING_OFF, g, S, E);
        SEAM(5);
    }
    if (IN(6)) { rstd_rows(F, (float*)(ws + WS_RSTD) + M); SEAM(6); }
    if (IN(7)) { pool_elem(F); SEAM(7); }
    if (IN(8)) {
        pg8::Gemm g{(const pg8::bf16_t*)(ws + WS_PPOOL), (const pg8::bf16_t*)(ws + WS_WPOOL), 4 * M, 4096, 1024}; pg8::PoolOrder S{F.G, (int)blockIdx.x};
        pg8::EpiResid<true> E{(float*)(ws + WS_XRES), F.in[I_PSCALE]};
        pg8::gemm_phase<pg8::EpiResid<true>, pg8::PoolOrder, PG8_ALIGN, PG8_SP2>(F.lds + RING_OFF, g, S, E);
        SEAM(8);
    }
    if (IN(9)) { norm_rows_bf16(F, F.in[I_NFFN] + DM, (bf16*)(ws + WS_HA)); SEAM(9); }
    if (IN(10)) {
        pg8::Gemm g{(const pg8::bf16_t*)(ws + WS_HA), (const pg8::bf16_t*)(ws + WS_WGU1), M, 2 * DFF, DM}; pg8::StaticOrder S; S.init(M, 2 * DFF, F.G, (int)blockIdx.x);
        pg8::EpiSwiglu E{(pg8::bf16_t*)(ws + WS_HID), DFF};
        pg8::gemm_phase<pg8::EpiSwiglu, pg8::StaticOrder, PG8_ALIGN, PG8_SP2>(F.lds + RING_OFF, g, S, E);
        SEAM(10);
    }
    if (IN(11)) {
        pg8::Gemm g{(const pg8::bf16_t*)(ws + WS_HID), (const pg8::bf16_t*)(ws + WS_WDN1), M, DM, DFF}; pg8::StaticOrder S; S.init(M, DM, F.G, (int)blockIdx.x);
        pg8::EpiResid<false> E{(float*)(ws + WS_XRES), nullptr};
        pg8::gemm_phase<pg8::EpiResid<false>, pg8::StaticOrder, PG8_ALIGN, PG8_SP2>(F.lds + RING_OFF, g, S, E);
        SEAM(11);
    }
    if (IN(12)) { norm_rows_f32(F, F.in[I_NFIN], F.out + O_YP); }
#undef IN
#undef SEAM
}

extern "C" void kernel_launch(void* const* d_in, const int* in_sizes, int n_in, void* d_out, int out_size, void* d_ws, size_t ws_size, hipStream_t stream) {
    static int grid = 0;
    if (grid == 0) {
        if (n_in != 21 || in_sizes[0] != MP * DM || (size_t)out_size != O_END || ws_size < WS_END) { fprintf(stderr, "kernel_launch: unexpected shapes (n_in %d, in0 %d, out %d, ws %zu); nothing launched\n", n_in, n_in > 0 ? in_sizes[0] : -1, out_size, ws_size); grid = -1; return; }
        int dev = 0, cus = 0, per_cu = 0;
        if (hipGetDevice(&dev) != hipSuccess || hipDeviceGetAttribute(&cus, hipDeviceAttributeMultiprocessorCount, dev) != hipSuccess) { grid = -1; return; }
        if (hipFuncSetAttribute((const void*)skel_fwd, hipFuncAttributeMaxDynamicSharedMemorySize, LDS_BYTES) != hipSuccess) { fprintf(stderr, "kernel_launch: hipFuncSetAttribute failed\n"); grid = -1; return; }
        if (hipOccupancyMaxActiveBlocksPerMultiprocessor(&per_cu, (const void*)skel_fwd, NWAVES * 64, LDS_BYTES) != hipSuccess || per_cu < 1) { fprintf(stderr, "kernel_launch: occupancy query says %d blocks per CU\n", per_cu); }
        (void)hipGetLastError();
        grid = cus;
    }
    if (grid < 0) return;
    if (hipMemsetAsync((char*)d_ws + WS_CTL, 0, CTL_ZERO_BYTES, stream) != hipSuccess) return;
    Args a{};
    for (int i = 0; i < 21; ++i) a.in[i] = (const float*)d_in[i];
    a.out = (float*)d_out; a.ws = (unsigned char*)d_ws;
#if MK_ONE_LAUNCH
    a.ph_lo = 0; a.ph_hi = N_PHASES;
    hipLaunchKernelGGL(skel_fwd, dim3(grid), dim3(NWAVES * 64), LDS_BYTES, stream, a);
#else
    for (int ph = 0; ph < N_PHASES; ++ph) { a.ph_lo = ph; a.ph_hi = ph + 1; hipLaunchKernelGGL(skel_fwd, dim3(grid), dim3(NWAVES * 64), LDS_BYTES, stream, a); }
#endif
}
```

```cpp
#include <hip/hip_runtime.h>
#include <cstdio>
#include <cstdint>
namespace pg8 {
#define PG8_LAS __attribute__((address_space(3)))
typedef unsigned short bf16_t;
typedef short bf16x8 __attribute__((ext_vector_type(8)));
typedef float f32x4 __attribute__((ext_vector_type(4)));
typedef unsigned u32x4 __attribute__((ext_vector_type(4)));
constexpr int BM = 256, BK = 64, HALF = 128, HTB = HALF * BK * 2  , STAGE_BYTES = 8 * HTB, NXCD = 8, WGM = 8;

__host__ __device__ __forceinline__ int lds_byte(int r, int c) { const int st = (r >> 4) * 2 + (c >> 5), rr = r & 15, cc = c & 31, ob = rr * 64 + cc * 2; return st * 1024 + (ob ^ (((ob >> 9) & 1) << 5)); }
__host__ __device__ __forceinline__ void stage_rc(int b, int& R, int& C) { const int st = b / 1024, sb = b % 1024, swz = sb ^ (((sb >> 9) & 1) << 5); R = (st >> 1) * 16 + swz / 64; C = (st & 1) * 32 + (swz % 64) / 2; }
__host__ __device__ __forceinline__ int perm32(int rho) { const int n = rho >> 4, i = rho & 15; return 8 * (i >> 2) + 4 * n + (i & 3); }

struct Unit { int pm, pn; };
struct Gemm { const bf16_t* A; const bf16_t* Bt; int M, N, K; int nt; };

struct StaticOrder {
    int nM, nN, nwg, G, c;
    __host__ __device__ void init(int M, int N, int G_, int c_, int bm = BM) { nM = M / bm; nN = N / BM; nwg = nM * nN; G = G_; c = c_; }
    __host__ __device__ bool next(int i, Unit& u) const {
        const long L = (long)i * G + c; if (L >= nwg) return false;
        int wgid = (int)L; { const int q = nwg / NXCD, r = nwg % NXCD, xcd = wgid % NXCD, off = wgid / NXCD; wgid = (xcd < r ? xcd * (q + 1) : r * (q + 1) + (xcd - r) * q) + off; }
        const int nig = WGM * nN, gid = wgid / nig, fm = gid * WGM, gsz = (nM - fm) < WGM ? (nM - fm) : WGM;
        u.pm = fm + ((wgid % nig) % gsz); u.pn = (wgid % nig) / gsz; return true;
    }
    __device__ __forceinline__ void a_ready(const Unit&) const {}
    __device__ __forceinline__ void done(const Unit&) const {}
};

struct MallOrder {
    int nM, nN, G, c, XR, maxr;
    __host__ __device__ void init(int M, int N, int G_, int c_, int bm, int XR_, int maxr_ = 1 << 20) { nM = M / bm; nN = N / BM; G = G_; c = c_; XR = XR_; maxr = maxr_; }
    __host__ __device__ bool next(int i, Unit& u) const {
        constexpr int CW = 32; if (i >= maxr) return false;
        const int XC = NXCD / XR, x = c % NXCD, xr = x / XC, xc = x % XC;
        int q = i * (G / NXCD) + c / NXCD;
        for (int ch = 0; ch * CW < nN; ++ch) {
            const int cw = (nN - ch * CW) < CW ? (nN - ch * CW) : CW;
            for (int g = 0; g * XR * 8 < nM; ++g) {
                const int fm = (g * XR + xr) * 8, left = nM - fm, gsz = left < 0 ? 0 : (left < 8 ? left : 8), perg = gsz * cw / XC;
                if (q < perg) { const int uu = xc * perg + q; u.pm = fm + uu % gsz; u.pn = ch * CW + uu / gsz; return true; }
                q -= perg;
            }
        }
        return false;
    }
    __device__ __forceinline__ void a_ready(const Unit&) const {}
    __device__ __forceinline__ void done(const Unit&) const {}
};

struct TailOrder {
    MallOrder base; int nt, round;
    __host__ __device__ bool next(int i, Unit& u) const {
        if (i != 0 || base.c >= 2 * nt) return false;
        MallOrder b = base; b.c = base.c % nt; b.maxr = 1 << 20; Unit v; if (!b.next(round, v)) return false;
        u.pm = 2 * v.pm + base.c / nt; u.pn = v.pn; return true;
    }
    __device__ __forceinline__ void a_ready(const Unit&) const {}
    __device__ __forceinline__ void done(const Unit&) const {}
};


__device__ __forceinline__ unsigned cvt_pk_bf16(float lo, float hi) { unsigned r; asm volatile("v_cvt_pk_bf16_f32 %0, %1, %2" : "=v"(r) : "v"(lo), "v"(hi)); return r; }
__device__ __forceinline__ float sigmoid_f(float x) { return __builtin_amdgcn_rcpf(1.0f + __expf(-x)); }

__device__ __forceinline__ void ssq_add(float* ssq, int row, float s, int fq) {
    s += __shfl_xor(s, 16); s += __shfl_xor(s, 32);
    if (fq == 0) unsafeAtomicAdd(ssq + row, s);
}
__device__ __forceinline__ float rstd_of(const float* ssq, int row) { return __builtin_amdgcn_rsqf(ssq[row] * (1.0f / 4096.0f) + 1e-6f); }
struct EpiGlu {
    static constexpr bool PERM = false, AFTER_DRAIN = false;
    const float* xin_p; const float* xin_s; float* xout; bf16_t* xb; float* ssq;
    template <int MQ> __device__ __forceinline__ void operator()(const f32x4 (&acc)[2][2][MQ][2], const Unit& u, int wr, int wc, int fr, int fq) const {
        constexpr int MHALF = 32 * MQ; const int row0 = u.pm * (2 * MHALF) + wr * (16 * MQ) + fr, col0 = u.pn * HALF + wc * 32 + 4 * fq;
        const float* xi = (row0 < 8192) ? xin_p + (size_t)row0 * 4096 : xin_s + (size_t)(row0 - 8192) * 4096;
        float* ob = xout + (size_t)row0 * 4096; bf16_t* bb = xb + (size_t)row0 * 4096;
#pragma unroll
        for (int ai = 0; ai < 2; ++ai)
#pragma unroll
            for (int m = 0; m < MQ; ++m) { const size_t off = (size_t)(ai * MHALF + m * 16) * 4096 + col0; float sq = 0.f;
#pragma unroll
                for (int n = 0; n < 2; ++n) { const f32x4 xv = *(const f32x4*)(xi + off + 16 * n); const f32x4 a = acc[ai][0][m][n], b = acc[ai][1][m][n]; f32x4 o;
#pragma unroll
                    for (int j = 0; j < 4; ++j) { o[j] = xv[j] + a[j] * sigmoid_f(b[j]); sq = fmaf(o[j], o[j], sq); }
                    *(f32x4*)(ob + off + 16 * n) = o;
                    *(unsigned long long*)(bb + off + 16 * n) = (unsigned long long)cvt_pk_bf16(o[0], o[1]) | ((unsigned long long)cvt_pk_bf16(o[2], o[3]) << 32); }
                ssq_add(ssq, row0 + ai * MHALF + m * 16, sq, fq); }
    }
};
struct EpiSwiglu {
    static constexpr bool PERM = true, AFTER_DRAIN = false;
    bf16_t* O; int ldc; const float* ssq;
    template <int MQ> __device__ __forceinline__ void operator()(const f32x4 (&acc)[2][2][MQ][2], const Unit& u, int wr, int wc, int fr, int fq) const {
        constexpr int MHALF = 32 * MQ; const int row0 = u.pm * (2 * MHALF) + wr * (16 * MQ) + fr, col0 = u.pn * HALF + wc * 32 + 8 * fq;
#pragma unroll
        for (int ai = 0; ai < 2; ++ai)
#pragma unroll
            for (int m = 0; m < MQ; ++m) { const int r = row0 + ai * MHALF + m * 16; bf16_t* rowp = O + (size_t)r * ldc + col0; const float rs = rstd_of(ssq, r);
                f32x4 h[2];
#pragma unroll
                for (int n = 0; n < 2; ++n) { const f32x4 g = acc[ai][0][m][n] * rs, v = acc[ai][1][m][n] * rs;
#pragma unroll
                    for (int j = 0; j < 4; ++j) h[n][j] = g[j] * sigmoid_f(g[j]) * v[j]; }
                u32x4 w; w.x = cvt_pk_bf16(h[0][0], h[0][1]); w.y = cvt_pk_bf16(h[0][2], h[0][3]); w.z = cvt_pk_bf16(h[1][0], h[1][1]); w.w = cvt_pk_bf16(h[1][2], h[1][3]);
                *(u32x4*)rowp = w; }
    }
};
template <bool POOL> struct EpiResid {
    static constexpr bool PERM = false, AFTER_DRAIN = false;
    float* x; const float* scale; bf16_t* xb; float* ssq; int npm;
    template <int MQ> __device__ __forceinline__ void operator()(const f32x4 (&acc)[2][2][MQ][2], const Unit& u, int wr, int wc, int fr, int fq) const {
        constexpr int MHALF = 32 * MQ; const int pm = POOL ? (u.pm % npm) : u.pm;
        const int row0 = pm * (2 * MHALF) + wr * (16 * MQ) + fr, col0 = u.pn * BM + wc * 32 + 4 * fq;
        f32x4 sv[2][2];
#pragma unroll
        for (int bj = 0; bj < 2; ++bj)
#pragma unroll
            for (int n = 0; n < 2; ++n) sv[bj][n] = POOL ? *(const f32x4*)(scale + col0 + bj * HALF + n * 16) : (f32x4){1.f, 1.f, 1.f, 1.f};
#pragma unroll
        for (int ai = 0; ai < 2; ++ai)
#pragma unroll
            for (int m = 0; m < MQ; ++m) { const int r = row0 + ai * MHALF + m * 16; float* rowp = x + (size_t)r * 4096 + col0; float sq = 0.f;
#pragma unroll
                for (int bj = 0; bj < 2; ++bj)
#pragma unroll
                    for (int n = 0; n < 2; ++n) { const f32x4 xv = *(const f32x4*)(rowp + bj * HALF + n * 16);
                        const f32x4 o = POOL ? xv + acc[ai][bj][m][n] * sv[bj][n] : xv + acc[ai][bj][m][n];
                        sq += (o[0] * o[0] + o[1] * o[1]) + (o[2] * o[2] + o[3] * o[3]);
                        *(f32x4*)(rowp + bj * HALF + n * 16) = o;
                        if (POOL) *(unsigned long long*)(xb + (size_t)r * 4096 + col0 + bj * HALF + n * 16) = (unsigned long long)cvt_pk_bf16(o[0], o[1]) | ((unsigned long long)cvt_pk_bf16(o[2], o[3]) << 32); }
                ssq_add(ssq, r, sq, fq); }
    }
};
struct EpiResidSplit {
    static constexpr bool PERM = false, AFTER_DRAIN = false;
    float* x; float* ssq; float* slab; unsigned* ctr; int part;
    template <int MQ> __device__ __forceinline__ void operator()(const f32x4 (&acc)[2][2][MQ][2], const Unit& u, int wr, int wc, int fr, int fq) const {
        static_assert(MQ == 4, "split tail: 256-row tiles");
        const int tid = threadIdx.x;
        if (part != 0) {
            f32x4* sp = (f32x4*)slab + (size_t)(part - 1) * 16384 + tid;
#pragma unroll
            for (int ai = 0; ai < 2; ++ai)
#pragma unroll
                for (int bj = 0; bj < 2; ++bj)
#pragma unroll
                    for (int m = 0; m < 4; ++m)
#pragma unroll
                        for (int n = 0; n < 2; ++n) sp[(((ai * 2 + bj) * 4 + m) * 2 + n) * 512] = acc[ai][bj][m][n];
            return;
        }
        { unsigned sp = 0; while (__hip_atomic_load(ctr, __ATOMIC_RELAXED, __HIP_MEMORY_SCOPE_AGENT) < 3u && ++sp < (1u << 22)) __builtin_amdgcn_s_sleep(2); }
        __builtin_amdgcn_fence(__ATOMIC_ACQUIRE, "agent");
        const f32x4* sp = (const f32x4*)slab + tid;
        const int row0 = u.pm * 256 + wr * 64 + fr, col0 = u.pn * BM + wc * 32 + 4 * fq;
#pragma unroll
        for (int ai = 0; ai < 2; ++ai)
#pragma unroll
            for (int m = 0; m < 4; ++m) { const int r = row0 + ai * 128 + m * 16; float* rowp = x + (size_t)r * 4096 + col0; float sq = 0.f;
#pragma unroll
                for (int bj = 0; bj < 2; ++bj)
#pragma unroll
                    for (int n = 0; n < 2; ++n) { const int idx = (((ai * 2 + bj) * 4 + m) * 2 + n) * 512;
                        const f32x4 xv = *(const f32x4*)(rowp + bj * HALF + n * 16);
                        const f32x4 o = (xv + acc[ai][bj][m][n]) + ((sp[idx] + sp[16384 + idx]) + sp[32768 + idx]);
                        sq += (o[0] * o[0] + o[1] * o[1]) + (o[2] * o[2] + o[3] * o[3]);
                        *(f32x4*)(rowp + bj * HALF + n * 16) = o; }
                ssq_add(ssq, r, sq, fq); }
    }
};
struct SplitOrder {
    int c, pm0;
    __device__ bool next(int i, Unit& u) const { if (i != 0) return false; const int slot = (c >> 3) & 7; u.pm = pm0 + (slot & 3); u.pn = 2 * (c & 7) + (slot >> 2); return true; }
    __device__ __forceinline__ void a_ready(const Unit&) const {}
    __device__ __forceinline__ void done(const Unit&) const {}
};
struct PoolOrder {
    int G, c, npm;
    __device__ bool next(int i, Unit& u) const {
        const int per = npm * 4, L = i * G + c; if (L >= 4 * per) return false;
        const int grp = L / per, rem = L % per; u.pm = grp * npm + rem % npm; u.pn = grp * 4 + rem / npm; return true;
    }
    __device__ __forceinline__ void a_ready(const Unit&) const {}
    __device__ __forceinline__ void done(const Unit&) const {}
};

template <class Epi, class Sched, bool ALIGN_EPI = false, bool SP2 = false, int MQ = 4>
__device__ __forceinline__ void gemm_phase(PG8_LAS unsigned char* lds, const Gemm g, const Sched& S, const Epi& E) {
    const int tid = threadIdx.x, wid = __builtin_amdgcn_readfirstlane(tid >> 6), lane = tid & 63, wr = wid >> 2, wc = wid & 3, fr = lane & 15, fq = lane >> 4;
    static_assert(MQ == 4 || ((MQ == 3 || MQ == 2) && SP2), "192- and 128-row tiles: only the SP2 loop carries the wave-group-specific waits");
    const int K = g.K, nt = g.nt ? g.nt : K / BK;
    unsigned voffA[2], voffB[2];
#pragma unroll
    for (int i = 0; i < 2; ++i) { int R, C; stage_rc(tid * 16 + i * 8192, R, C); const int Rb = Epi::PERM ? ((R & ~31) + perm32(R & 31)) : R;
        voffA[i] = (unsigned)(R * K + C) * 2u; voffB[i] = (unsigned)(Rb * K + C) * 2u; }
    const size_t kstep = (size_t)(BK * 2);
    const size_t hstep = (size_t)HALF * K * 2, hstepA = (size_t)(32 * MQ) * K * 2;
    const size_t tstep = 2 * hstep, tstepA = 2 * hstepA;
    const unsigned ldsw = (unsigned)wid * 1024u;
    const int aoff = lds_byte(wr * (16 * MQ) + fr, fq * 8), boff = lds_byte(wc * 32 + fr, fq * 8);
#define PG8_SA(b, h) (((b) * 2 + (h)) * HTB)
#define PG8_SB(b, h) ((4 + (b) * 2 + (h)) * HTB)
#define PG8_STAGE(bufoff, gbase, voff) do { _Pragma("unroll") for (int _i = 0; _i < 2; ++_i) \
        __builtin_amdgcn_global_load_lds((const unsigned*)((const char*)(gbase) + (voff)[_i]), (PG8_LAS unsigned*)(lds + (bufoff) + ldsw + _i * 8192), 16, 0, 0); } while (0)
#define PG8_STAGE_A(bufoff, gbase) do { __builtin_amdgcn_global_load_lds((const unsigned*)((const char*)(gbase) + voffA[0]), (PG8_LAS unsigned*)(lds + (bufoff) + ldsw), 16, 0, 0); \
        if (MQ == 4 || (MQ == 3 && wid < 4)) __builtin_amdgcn_global_load_lds((const unsigned*)((const char*)(gbase) + voffA[1]), (PG8_LAS unsigned*)(lds + (bufoff) + ldsw + 8192), 16, 0, 0); } while (0)
#define PG8_LDA(dst, b, h) do { _Pragma("unroll") for (int m = 0; m < MQ; ++m) _Pragma("unroll") for (int k = 0; k < 2; ++k) dst[m][k] = *(const PG8_LAS bf16x8*)(lds + PG8_SA(b, h) + aoff + m * 2048 + k * 1024); } while (0)
#define PG8_LDB(dst, b, h) do { _Pragma("unroll") for (int n = 0; n < 2; ++n) _Pragma("unroll") for (int k = 0; k < 2; ++k) dst[n][k] = *(const PG8_LAS bf16x8*)(lds + PG8_SB(b, h) + boff + n * 2048 + k * 1024); } while (0)
#define PG8_MMA(ai, bj, At, Bt) do { __builtin_amdgcn_s_setprio(1); _Pragma("unroll") for (int m = 0; m < MQ; ++m) _Pragma("unroll") for (int n = 0; n < 2; ++n) _Pragma("unroll") for (int k = 0; k < 2; ++k) \
        acc[ai][bj][m][n] = __builtin_amdgcn_mfma_f32_16x16x32_bf16(Bt[n][k], At[m][k], acc[ai][bj][m][n], 0, 0, 0); __builtin_amdgcn_s_setprio(0); } while (0)
#define PG8_WAIT_V(n) asm volatile("s_waitcnt vmcnt(" #n ")" ::: "memory")
#define PG8_WAIT_V8 do { if (MQ == 2 || (MQ == 3 && wid >= 4)) PG8_WAIT_V(6); else PG8_WAIT_V(8); } while (0)
#define PG8_WAIT_L(n) asm volatile("s_waitcnt lgkmcnt(" #n ")" ::: "memory")
#define PG8_BAR __builtin_amdgcn_s_barrier()
#define PG8_SCHED __builtin_amdgcn_sched_barrier(0)
    Unit cur, nxt; int ui = 0;
    if (!S.next(0, cur)) return;
    f32x4 acc[2][2][MQ][2];
#pragma unroll
    for (int a = 0; a < 2; ++a)
#pragma unroll
        for (int b = 0; b < 2; ++b)
#pragma unroll
            for (int m = 0; m < MQ; ++m)
#pragma unroll
                for (int n = 0; n < 2; ++n) acc[a][b][m][n] = (f32x4){0.f, 0.f, 0.f, 0.f};
    bf16x8 At[MQ][2], B0[2][2], B1[2][2];
    const char* cA = (const char*)g.A + (size_t)cur.pm * tstepA; const char* cB = (const char*)g.Bt + (size_t)cur.pn * tstep;
    S.a_ready(cur);
    if constexpr (SP2) {
        PG8_STAGE(PG8_SB(0, 0), cB, voffB); PG8_STAGE(PG8_SB(0, 1), cB + hstep, voffB); PG8_STAGE_A(PG8_SA(0, 0), cA); PG8_STAGE_A(PG8_SA(0, 1), cA + hstepA);
        if (wr == 1) PG8_BAR;
        if (MQ == 2 || (MQ == 3 && wid >= 4)) PG8_WAIT_V(1); else PG8_WAIT_V(2);
        PG8_BAR;
        PG8_STAGE(PG8_SB(1, 0), cB + kstep, voffB); PG8_STAGE_A(PG8_SA(1, 0), cA + kstep); PG8_STAGE(PG8_SB(1, 1), cB + hstep + kstep, voffB);
        if (MQ == 2 || (MQ == 3 && wid >= 4)) PG8_WAIT_V(5); else PG8_WAIT_V(6);
        PG8_BAR;
    } else {
        PG8_STAGE(PG8_SB(0, 0), cB, voffB); PG8_STAGE_A(PG8_SA(0, 0), cA); PG8_STAGE(PG8_SB(0, 1), cB + hstep, voffB); PG8_STAGE_A(PG8_SA(0, 1), cA + hstepA);
        if (wr == 1) PG8_BAR;
        PG8_WAIT_V(4); PG8_BAR;
        PG8_STAGE(PG8_SB(1, 0), cB + kstep, voffB); PG8_STAGE_A(PG8_SA(1, 0), cA + kstep); PG8_STAGE(PG8_SB(1, 1), cB + hstep + kstep, voffB);
        PG8_WAIT_V(6); PG8_BAR;
    }
    for (;;) {
        const bool has_next = S.next(ui + 1, nxt);
        const char* nA = has_next ? (const char*)g.A + (size_t)nxt.pm * tstepA : cA; const char* nB = has_next ? (const char*)g.Bt + (size_t)nxt.pn * tstep : cB;
        for (int t = 0; t < nt; t += 2) {
            const bool last = (t == nt - 2);
            const char* a1 = cA + (size_t)(t + 1) * kstep;
            const char* a2 = last ? nA : cA + (size_t)(t + 2) * kstep; const char* b2 = last ? nB : cB + (size_t)(t + 2) * kstep;
            const char* a3 = a2 + kstep; const char* b3 = b2 + kstep;
            if (last && has_next) S.a_ready(nxt);
            if constexpr (SP2) {
            PG8_LDB(B0, 0, 0); PG8_LDB(B1, 0, 1); PG8_SCHED; PG8_LDA(At, 0, 0); PG8_STAGE_A(PG8_SA(1, 1), a1 + hstepA);
            PG8_WAIT_V8; PG8_WAIT_L(0); PG8_BAR; PG8_MMA(0, 0, At, B0); PG8_MMA(0, 1, At, B1); PG8_BAR; PG8_SCHED;
            PG8_LDA(At, 0, 1); PG8_STAGE(PG8_SB(0, 0), b2, voffB); PG8_STAGE(PG8_SB(0, 1), b2 + hstep, voffB); PG8_STAGE_A(PG8_SA(0, 0), a2);
            PG8_WAIT_V8; PG8_WAIT_L(0); PG8_BAR; PG8_MMA(1, 0, At, B0); PG8_MMA(1, 1, At, B1); PG8_BAR; PG8_SCHED;
            PG8_LDB(B0, 1, 0); PG8_LDB(B1, 1, 1); PG8_SCHED; PG8_LDA(At, 1, 0); PG8_STAGE_A(PG8_SA(0, 1), a2 + hstepA);
            PG8_WAIT_V8; PG8_WAIT_L(0); PG8_BAR; PG8_MMA(0, 0, At, B0); PG8_MMA(0, 1, At, B1); PG8_BAR; PG8_SCHED;
            PG8_LDA(At, 1, 1); PG8_STAGE(PG8_SB(1, 0), b3, voffB); PG8_STAGE(PG8_SB(1, 1), b3 + hstep, voffB); PG8_STAGE_A(PG8_SA(1, 0), a3);
            PG8_WAIT_V8; PG8_WAIT_L(0); PG8_BAR; PG8_MMA(1, 0, At, B0); PG8_MMA(1, 1, At, B1); PG8_BAR; PG8_SCHED;
            } else {
            PG8_LDB(B0, 0, 0); PG8_SCHED; PG8_LDA(At, 0, 0); PG8_STAGE_A(PG8_SA(1, 1), a1 + hstepA);
            PG8_WAIT_L(8); PG8_BAR; PG8_WAIT_L(0); PG8_MMA(0, 0, At, B0); PG8_BAR; PG8_SCHED;
            PG8_LDB(B1, 0, 1); PG8_STAGE(PG8_SB(0, 0), b2, voffB);
            PG8_BAR; PG8_WAIT_L(0); PG8_MMA(0, 1, At, B1); PG8_BAR;
            PG8_LDA(At, 0, 1); PG8_STAGE_A(PG8_SA(0, 0), a2);
            PG8_BAR; PG8_WAIT_L(0); PG8_MMA(1, 0, At, B0); PG8_BAR; PG8_SCHED;
            PG8_STAGE(PG8_SB(0, 1), b2 + hstep, voffB);
            PG8_WAIT_V(6); PG8_BAR; PG8_MMA(1, 1, At, B1); PG8_BAR;
            PG8_LDB(B0, 1, 0); PG8_SCHED; PG8_LDA(At, 1, 0); PG8_STAGE_A(PG8_SA(0, 1), a2 + hstepA);
            PG8_WAIT_L(8); PG8_BAR; PG8_WAIT_L(0); PG8_MMA(0, 0, At, B0); PG8_BAR; PG8_SCHED;
            PG8_LDB(B1, 1, 1); PG8_STAGE(PG8_SB(1, 0), b3, voffB);
            PG8_BAR; PG8_WAIT_L(0); PG8_MMA(0, 1, At, B1); PG8_BAR;
            PG8_LDA(At, 1, 1); PG8_STAGE_A(PG8_SA(1, 0), a3);
            PG8_BAR; PG8_WAIT_L(0); PG8_MMA(1, 0, At, B0); PG8_BAR; PG8_SCHED;
            PG8_STAGE(PG8_SB(1, 1), b3 + hstep, voffB);
            PG8_WAIT_V(6); PG8_BAR; PG8_MMA(1, 1, At, B1); PG8_BAR;
            }
        }
        if constexpr (ALIGN_EPI) { if (wr == 0) PG8_BAR; }
        if constexpr (!Epi::AFTER_DRAIN) { E(acc, cur, wr, wc, fr, fq); S.done(cur); }
        if (!has_next) break;
#pragma unroll
        for (int a = 0; a < 2; ++a)
#pragma unroll
            for (int b = 0; b < 2; ++b)
#pragma unroll
                for (int m = 0; m < MQ; ++m)
#pragma unroll
                    for (int n = 0; n < 2; ++n) acc[a][b][m][n] = (f32x4){0.f, 0.f, 0.f, 0.f};
        cur = nxt; cA = nA; cB = nB; ++ui;
        if constexpr (ALIGN_EPI) { if (wr == 1) PG8_BAR; }
    }
    PG8_WAIT_V(0);
    if constexpr (!ALIGN_EPI) { if (wr == 0) PG8_BAR; }
    PG8_BAR;
    if constexpr (Epi::AFTER_DRAIN) { E.fused(acc, cur, wr, wc, fr, fq, lds, wid, lane); S.done(cur); }
#undef PG8_SA
#undef PG8_SB
#undef PG8_STAGE
#undef PG8_LDA
#undef PG8_LDB
#undef PG8_MMA
#undef PG8_WAIT_V
#undef PG8_WAIT_V8
#undef PG8_STAGE_A
#undef PG8_WAIT_L
#undef PG8_BAR
#undef PG8_SCHED
}
}

#ifndef PG8_SP2
#define PG8_SP2 true
#endif
#ifndef PG8_ALIGN
#define PG8_ALIGN true
#endif
#ifndef MK_ONE_LAUNCH
#define MK_ONE_LAUNCH 1
#endif

constexpr int NWAVES = 8;
constexpr int DM = 4096, SEQ = 2048, NB = 4, DB = 128, DS = 8, MP = NB * SEQ, MS = DB * DS, M = MP + MS;
constexpr int DFF = 11008, NGRP = 256, NST = 64, NCH = 16, PBUF = 15;
constexpr float RMS_EPS = 1e-6f;
constexpr int N_PHASES = 10;
constexpr size_t O_YP = 0, O_YS = (size_t)MP * DM, O_SRP = O_YS + (size_t)MS * DM, O_SIP = O_SRP + (size_t)NB * NGRP * NST, O_PP = O_SIP + (size_t)NB * NGRP * NST,
                 O_SRS = O_PP + (size_t)NB * PBUF * DM, O_SIS = O_SRS + (size_t)DB * NGRP * NST, O_PS = O_SIS + (size_t)DB * NGRP * NST, O_END = O_PS + (size_t)DB * PBUF * DM;
constexpr size_t MiB = 1u << 20;
constexpr size_t WS_CTL = 0, CTL_ZERO_BYTES = 1 * MiB;
constexpr size_t WS_WGLU = 16 * MiB, WS_WGU0 = 80 * MiB, WS_WGU1 = 252 * MiB, WS_WDN0 = 424 * MiB, WS_WDN1 = 510 * MiB, WS_WPOOL = 596 * MiB;
constexpr size_t WS_XRES = 608 * MiB, WS_HA = 752 * MiB, WS_YSSM = 824 * MiB, WS_PPOOL = 896 * MiB, WS_HID = 968 * MiB, WS_SSMP = 1164 * MiB, WS_RSTD = 1169 * MiB, WS_END = 1170 * MiB;
static_assert(WS_WGLU + (size_t)2 * DM * DM * 2 <= WS_WGU0 && WS_WGU0 + (size_t)2 * DFF * DM * 2 <= WS_WGU1 && WS_WGU1 + (size_t)2 * DFF * DM * 2 <= WS_WDN0 && WS_WDN0 + (size_t)DM * DFF * 2 <= WS_WDN1 &&
              WS_WDN1 + (size_t)DM * DFF * 2 <= WS_WPOOL && WS_WPOOL + (size_t)4 * 1024 * 1024 * 2 <= WS_XRES && WS_XRES + (size_t)M * DM * 4 <= WS_HA && WS_HA + (size_t)M * DM * 2 <= WS_YSSM &&
              WS_YSSM + (size_t)M * DM * 2 <= WS_PPOOL && WS_PPOOL + (size_t)M * DM * 2 <= WS_HID && WS_HID + (size_t)M * DFF * 2 <= WS_SSMP, "d_ws map");
constexpr size_t SPB_AR = 0, SPB_AI = 65536, SPB_BF = 131072, SPB_CF = 131072 + 1048576;
constexpr int CW_BAR = 4096;
constexpr int CW_SPLIT = 65536;
constexpr int CW_SSQ = 16384;
constexpr int RING_OFF = 0, RING_BYTES = 131072;
constexpr int LDSCTL_OFF = RING_BYTES, MISC_OFF = LDSCTL_OFF + 320;
constexpr int LDS_BYTES = 147456;
static_assert(MISC_OFF + 128 <= LDS_BYTES, "LDS map");

#define GAS __attribute__((address_space(1)))
#define LAS __attribute__((address_space(3)))
typedef unsigned short bf16;
typedef unsigned v4u __attribute__((ext_vector_type(4)));
typedef float f32x4 __attribute__((ext_vector_type(4)));
typedef short bf16x8 __attribute__((ext_vector_type(8)));
typedef GAS unsigned gu32;
typedef GAS unsigned long long gu64;
#define RLX_AGENT __ATOMIC_RELAXED, __HIP_MEMORY_SCOPE_AGENT
#define LDS_WAIT() asm volatile("s_waitcnt lgkmcnt(0)" ::: "memory")
#define VM_WAIT() asm volatile("s_waitcnt vmcnt(0)" ::: "memory")
__device__ __forceinline__ unsigned long long rt() { return __builtin_amdgcn_s_memrealtime(); }
__device__ __forceinline__ unsigned f2bf(float f) { unsigned u = __builtin_bit_cast(unsigned, f); return (u + 0x7fffu + ((u >> 16) & 1u)) >> 16; }
__device__ __forceinline__ unsigned pk2(float lo, float hi) { return f2bf(lo) | (f2bf(hi) << 16); }

#define XB_TMO      128
#define XB_XCNT(j)  (256  + 64 * (j))
#define XB_XSUB(j)  (1280 + 64 * (j))
#define XB_XGEN(j)  (2304 + 64 * (j))
#define XB_TOP      3328
#define XB_TOPGEN   3392
#define XCD_BAR_WORDS 3456
#define XB_SPIN_CAP (1u << 18)

__device__ __forceinline__ unsigned xb_ld(unsigned* p)              { return __hip_atomic_load(p, __ATOMIC_RELAXED, __HIP_MEMORY_SCOPE_AGENT); }
__device__ __forceinline__ unsigned xb_add(unsigned* p, unsigned v) { return __hip_atomic_fetch_add(p, v, __ATOMIC_RELAXED, __HIP_MEMORY_SCOPE_AGENT); }
__device__ __forceinline__ unsigned xb_xcc_id() { return (unsigned)__builtin_amdgcn_s_getreg((3 << 11) | 20) & 0xFu; }
#define XB_SPIN(cond, bar) do { unsigned _sp = 0; while (cond) { __builtin_amdgcn_s_sleep(1); \
    if ((++_sp & 255u) == 0u) { if (xb_ld(&(bar)[XB_TMO])) break; if (_sp > XB_SPIN_CAP) { atomicAdd(&(bar)[XB_TMO], 1u); break; } } } } while (0)

struct XcdBarrier {
    unsigned* bar; unsigned x;
    volatile LAS unsigned* st;
};

__device__ __forceinline__ XcdBarrier xcd_barrier_post(unsigned* bar, volatile LAS unsigned* st) {
    XcdBarrier b; b.bar = bar; b.x = xb_xcc_id(); b.st = st;
    if (threadIdx.x == 0) (void)xb_add(&bar[XB_XCNT(b.x)], 1u);
    return b;
}
__device__ __forceinline__ void xcd_barrier_complete(unsigned* bar, unsigned x, unsigned& nloc, unsigned& nx) {
    const unsigned G = gridDim.x * gridDim.y * gridDim.z;
    unsigned sum, cnt, mine, sp = 0u;
    for (;;) {
        sum = 0u; cnt = 0u; mine = 0u;
#pragma unroll
        for (unsigned j = 0; j < 16; ++j) { const unsigned c = xb_ld(&bar[XB_XCNT(j)]); sum += c; cnt += (c > 0u) ? 1u : 0u; mine = (j == x) ? c : mine; }
        if (sum == G) break;
        __builtin_amdgcn_s_sleep(1);
        if ((++sp & 255u) == 0u) { if (xb_ld(&bar[XB_TMO])) break; if (sp > XB_SPIN_CAP) { atomicAdd(&bar[XB_TMO], 1u); break; } }
    }
    nloc = mine > 0u ? mine : 1u; nx = cnt > 0u ? cnt : 1u;
}

__device__ __forceinline__ void xcd_barrier(const XcdBarrier& b) {
    asm volatile("s_waitcnt vmcnt(0)" ::: "memory");
    __syncthreads();
    if (threadIdx.x == 0) {
        unsigned* bar = b.bar;
        __builtin_amdgcn_s_waitcnt(0);
        unsigned nloc = b.st[0], nx = b.st[1];
        if (nloc == 0u) { xcd_barrier_complete(bar, b.x, nloc, nx); b.st[0] = nloc; b.st[1] = nx; }
        const unsigned old = xb_add(&bar[XB_XSUB(b.x)], 1u);
        const unsigned gen = old / nloc;
        if (old + 1u == (gen + 1u) * nloc) {
            __builtin_amdgcn_fence(__ATOMIC_RELEASE, "agent");
            asm volatile("s_waitcnt vmcnt(0)" ::: "memory");
            const unsigned og = xb_add(&bar[XB_TOP], 1u);
            const unsigned tg = og / nx;
            if (og + 1u == (tg + 1u) * nx) xb_add(&bar[XB_TOPGEN], 1u);
            else XB_SPIN(xb_ld(&bar[XB_TOPGEN]) == tg, bar);
            __builtin_amdgcn_fence(__ATOMIC_ACQUIRE, "agent");
            xb_add(&bar[XB_XGEN(b.x)], 1u);
            asm volatile("s_waitcnt vmcnt(0)" ::: "memory");
        } else {
            XB_SPIN(xb_ld(&bar[XB_XGEN(b.x)]) == gen, bar);
            __builtin_amdgcn_fence(__ATOMIC_ACQUIRE, "agent");
            asm volatile("s_waitcnt vmcnt(0)" ::: "memory");
        }
    }
    __syncthreads();
}

struct Frame {
    LAS unsigned char* lds;
    volatile LAS unsigned* MISC;
    gu32* ctl;
    int tid, lane, wave;
    int vcu, G;
    const float* in[21];
    float* out;
    unsigned char* ws;
};
enum { I_XP = 0, I_XS, I_SRE, I_SIM, I_SPOOL, I_NMIX, I_NFFN, I_LRE, I_LIM, I_LSTEP, I_BRE, I_BIM, I_CRE, I_CIM, I_SD, I_WGLU, I_WPOOL, I_PSCALE, I_WGU, I_WDN, I_NFIN };

__device__ __forceinline__ float wave_sum(float v) {
#pragma unroll
    for (int o = 1; o < 64; o <<= 1) v += __shfl_xor(v, o);
    return v;
}
typedef float f32x2_t __attribute__((ext_vector_type(2)));
typedef __bf16 b16x2_t __attribute__((ext_vector_type(2)));
typedef float f32x16 __attribute__((ext_vector_type(16)));
__device__ __forceinline__ unsigned cvtpk(float lo, float hi) { return __builtin_bit_cast(unsigned, __builtin_convertvector((f32x2_t){lo, hi}, b16x2_t)); }
__device__ __forceinline__ const float* xrow_in(const Frame& F, int r) { return r < MP ? F.in[I_XP] + (size_t)r * DM : F.in[I_XS] + (size_t)(r - MP) * DM; }

__device__ __forceinline__ void tr_item(const float* W, int K, int N, bf16* WT, int k0, int n0, int drow0, int lane, const float* kgain = nullptr) {
    const int kq = lane >> 3, nq = lane & 7;
    f32x4 v[2][8];
#pragma unroll
    for (int h = 0; h < 2; ++h)
#pragma unroll
        for (int i = 0; i < 8; ++i) v[h][i] = *(const GAS f32x4*)(W + (size_t)(k0 + 8 * kq + i) * N + n0 + 32 * h + 4 * nq);
    if (kgain) {
        const f32x4 g0 = *(const GAS f32x4*)(kgain + k0 + 8 * kq), g1 = *(const GAS f32x4*)(kgain + k0 + 8 * kq + 4);
#pragma unroll
        for (int h = 0; h < 2; ++h)
#pragma unroll
            for (int i = 0; i < 8; ++i) v[h][i] = v[h][i] * (i < 4 ? g0[i & 3] : g1[i & 3]);
    }
#pragma unroll
    for (int h = 0; h < 2; ++h)
#pragma unroll
        for (int j = 0; j < 4; ++j) { v4u o; o.x = cvtpk(v[h][0][j], v[h][1][j]); o.y = cvtpk(v[h][2][j], v[h][3][j]); o.z = cvtpk(v[h][4][j], v[h][5][j]); o.w = cvtpk(v[h][6][j], v[h][7][j]);
            *(GAS v4u*)(WT + (size_t)(drow0 + 32 * h + 4 * nq + j) * K + k0 + 8 * kq) = o; }
}
__device__ __forceinline__ int drow_pair(int n0, int NH) { const int half = n0 >= NH ? 1 : 0, nn = n0 - half * NH; return 256 * (nn >> 7) + 128 * half + (nn & 127); }

__device__ __forceinline__ double exp_d(double x) {
    const double k = __builtin_rint(x * 1.4426950408889634074); const double r = x - k * 0.69314718055994530942;
    double s = 1.0, t = 1.0;
#pragma unroll
    for (int i = 1; i <= 16; ++i) { t *= r * (1.0 / (double)i); s += t; }
    const long long e = (long long)k + 1023; return s * __builtin_bit_cast(double, (unsigned long long)e << 52);
}
__device__ __forceinline__ void sincos_d(double th, double& sn, double& cs) {
    const double n = __builtin_rint(th * 0.15915494309189533577); const double r = (th - n * 6.283185307179586232) - n * 2.4492935982947064e-16; const double r2 = r * r;
    double s = r, c = 1.0, ts = r, tc = 1.0;
#pragma unroll
    for (int i = 1; i <= 15; ++i) { tc *= r2 * (-1.0 / (double)((2 * i - 1) * (2 * i))); ts *= r2 * (-1.0 / (double)((2 * i) * (2 * i + 1))); c += tc; s += ts; }
    sn = s; cs = c;
}

constexpr int CI_GLU = (DM / 64) * (2 * DM / 64), CI_GU = (DM / 64) * (2 * DFF / 64), CI_DN = (DFF / 64) * (DM / 64), CI_PL = 4 * 16 * 16;
constexpr int CI_L0 = CI_GLU + CI_GU + CI_DN, CI_ALL = CI_L0 + CI_GU + CI_DN + CI_PL;
__device__ __forceinline__ void convert_weights(Frame& F, int lo, int hi, int first, int step) {
    LAS unsigned* ctr = (LAS unsigned*)(F.lds + MISC_OFF + 80);
    for (;;) {
        unsigned k = 0; if (F.lane == 0) k = __hip_atomic_fetch_add(ctr, 1u, __ATOMIC_RELAXED, __HIP_MEMORY_SCOPE_WORKGROUP);
        k = (unsigned)__builtin_amdgcn_readfirstlane((int)k);
        const long itl = (long)lo + first + (long)step * k; if (itl >= hi) break;
        int r = (int)itl;
        if (r < CI_GLU) { const int nb = r % (2 * DM / 64), kb = r / (2 * DM / 64); tr_item(F.in[I_WGLU], DM, 2 * DM, (bf16*)(F.ws + WS_WGLU), kb * 64, nb * 64, drow_pair(nb * 64, DM), F.lane); continue; } r -= CI_GLU;
        if (r >= 2 * CI_GU + CI_DN && r < 2 * CI_GU + CI_DN + CI_PL) { r -= 2 * CI_GU + CI_DN; const int g = r / 256; r -= g * 256; const int nb = r % 16, kb = r / 16;
            tr_item(F.in[I_WPOOL] + (size_t)g * 1024 * 1024, 1024, 1024, (bf16*)(F.ws + WS_WPOOL) + (size_t)g * 1024 * 1024, kb * 64, nb * 64, nb * 64, F.lane); continue; }
        int l, isdn;
        if (r < CI_GU) { l = 0; isdn = 0; } else if (r < CI_GU + CI_DN) { r -= CI_GU; l = 0; isdn = 1; } else if (r < 2 * CI_GU + CI_DN) { r -= CI_GU + CI_DN; l = 1; isdn = 0; } else { r -= 2 * CI_GU + CI_DN + CI_PL; l = 1; isdn = 1; }
        if (!isdn) { const int nb = r % (2 * DFF / 64), kb = r / (2 * DFF / 64);
            tr_item(F.in[I_WGU] + (size_t)l * DM * 2 * DFF, DM, 2 * DFF, (bf16*)(F.ws + (l ? WS_WGU1 : WS_WGU0)), kb * 64, nb * 64, drow_pair(nb * 64, DFF), F.lane, F.in[I_NFFN] + l * DM); continue; }
        { const int nb = r % (DM / 64), kb = r / (DM / 64);
            tr_item(F.in[I_WDN] + (size_t)l * DFF * DM, DFF, DM, (bf16*)(F.ws + (l ? WS_WDN1 : WS_WDN0)), kb * 64, nb * 64, nb * 64, F.lane); }
    }
}
__device__ __forceinline__ void convert_reset(Frame& F) { __syncthreads(); if (F.tid == 0) *(LAS unsigned*)(F.lds + MISC_OFF + 80) = 0u; __syncthreads(); }
__device__ __forceinline__ void p0_prologue(Frame& F) {
    const int gw = F.vcu * NWAVES + F.wave, NGW = F.G * NWAVES;
    float* rstd0 = (float*)(F.ws + WS_RSTD);
    for (int r = gw; r < M; r += NGW) { const GAS f32x4* xr = (const GAS f32x4*)xrow_in(F, r) + F.lane; float s = 0.f;
#pragma unroll
        for (int j = 0; j < 16; ++j) { const f32x4 v = xr[64 * j]; s += (v.x * v.x + v.y * v.y) + (v.z * v.z + v.w * v.w); }
        s = wave_sum(s); if (F.lane == 0) rstd0[r] = 1.0f / sqrtf(s * (1.0f / DM) + RMS_EPS); }
    unsigned char* spb = F.ws + WS_SSMP;
    for (int idx = F.vcu * (NWAVES * 64) + F.tid; idx < NGRP * NST; idx += F.G * NWAVES * 64) {
        const int g = idx >> 6, p = idx & 63, ti = p >> 5, sl = p & 31;
        const double lr = (double)F.in[I_LRE][idx], li = (double)F.in[I_LIM][idx], dt = exp_d((double)F.in[I_LSTEP][g]);
        const double mag = exp_d(lr * dt); double sn, cs; sincos_d(li * dt, sn, cs);
        const double ar = mag * cs, ai = mag * sn, den = lr * lr + li * li;
        const double fr = ((ar - 1.0) * lr + ai * li) / den, fi = (ai * lr - (ar - 1.0) * li) / den;
        ((float*)(spb + SPB_AR))[idx] = (float)ar; ((float*)(spb + SPB_AI))[idx] = (float)ai;
#pragma unroll
        for (int hl = 0; hl < 2; ++hl) { float re[8], im[8];
#pragma unroll
            for (int c4 = 0; c4 < 2; ++c4) { const f32x4 br = *(const GAS f32x4*)(F.in[I_BRE] + (size_t)idx * 16 + 8 * hl + 4 * c4), bi = *(const GAS f32x4*)(F.in[I_BIM] + (size_t)idx * 16 + 8 * hl + 4 * c4);
                const f32x4 gn = *(const GAS f32x4*)(F.in[I_NMIX] + g * 16 + 8 * hl + 4 * c4);
#pragma unroll
                for (int j = 0; j < 4; ++j) { re[4 * c4 + j] = (float)((fr * (double)br[j] - fi * (double)bi[j]) * (double)gn[j]); im[4 * c4 + j] = (float)((fr * (double)bi[j] + fi * (double)br[j]) * (double)gn[j]); } }
            const int ln = 32 * hl + sl; v4u o;
            o.x = cvtpk(re[0], re[1]); o.y = cvtpk(re[2], re[3]); o.z = cvtpk(re[4], re[5]); o.w = cvtpk(re[6], re[7]);
            *(GAS v4u*)(spb + SPB_BF + ((size_t)(((g * 2 + ti) * 2 + 0) * 64 + ln)) * 16) = o;
            o.x = cvtpk(im[0], im[1]); o.y = cvtpk(im[2], im[3]); o.z = cvtpk(im[4], im[5]); o.w = cvtpk(im[6], im[7]);
            *(GAS v4u*)(spb + SPB_BF + ((size_t)(((g * 2 + ti) * 2 + 1) * 64 + ln)) * 16) = o; }
    }
    for (int idx = F.vcu * (NWAVES * 64) + F.tid; idx < NGRP * 4 * 64; idx += F.G * NWAVES * 64) {
        const int g = idx >> 8, ks = (idx >> 6) & 3, ln = idx & 63, q = ln >> 4, c = ln & 15, p0 = 16 * ks + 4 * q;
        const f32x4 cr = *(const GAS f32x4*)(F.in[I_CRE] + ((size_t)g * 16 + c) * NST + p0), ci = *(const GAS f32x4*)(F.in[I_CIM] + ((size_t)g * 16 + c) * NST + p0);
        v4u o; o.x = cvtpk(cr[0], -ci[0]); o.y = cvtpk(cr[1], -ci[1]); o.z = cvtpk(cr[2], -ci[2]); o.w = cvtpk(cr[3], -ci[3]);
        *(GAS v4u*)(spb + SPB_CF + (size_t)idx * 16) = o;
    }
}

__device__ __forceinline__ float gelu_tanh(float x) { const float z = 0.7978845608028654f * (x + 0.044715f * x * x * x); return x * __builtin_amdgcn_rcpf(1.0f + __expf(-2.0f * z)); }
template <bool SAMPLE>
__device__ __forceinline__ void ssm_run(Frame& F, int g, int sel) {
    const int lane = F.lane, hl = lane >> 5, sl = lane & 31, q = lane >> 4, cl = lane & 15;
    const unsigned char* spb = F.ws + WS_SSMP; const float* rstd0 = (const float*)(F.ws + WS_RSTD);
    bf16x8 bfr[2][2], cfr[4];
#pragma unroll
    for (int ti = 0; ti < 2; ++ti)
#pragma unroll
        for (int part = 0; part < 2; ++part) bfr[ti][part] = *(const GAS bf16x8*)(spb + SPB_BF + ((size_t)(((g * 2 + ti) * 2 + part) * 64 + lane)) * 16);
#pragma unroll
    for (int ks = 0; ks < 4; ++ks) cfr[ks] = *(const GAS bf16x8*)(spb + SPB_CF + ((size_t)((g * 4 + ks) * 64 + lane)) * 16);
    float ar[2], ai[2];
#pragma unroll
    for (int ti = 0; ti < 2; ++ti) { ar[ti] = ((const float*)(spb + SPB_AR))[g * NST + 32 * ti + sl]; ai[ti] = ((const float*)(spb + SPB_AI))[g * NST + 32 * ti + sl]; }
    const f32x4 dg = *(const GAS f32x4*)(F.in[I_SD] + g * 16 + 4 * q) * *(const GAS f32x4*)(F.in[I_NMIX] + g * 16 + 4 * q);
    const int hA = (sl >> 2) & 1, rA = (sl & 3) + 4 * (sl >> 3);
    const int hE = (cl >> 2) & 1, rE = (cl & 3) + 4 * (cl >> 3);
    LAS unsigned char* xl = F.lds + RING_OFF + F.wave * 8704;
    LAS unsigned* xw = (LAS unsigned*)(xl + hl * (4 * 272) + sl * 4);
    const LAS unsigned char* xrd = xl + cl * 272 + q * 16;
    int rowA, rowE[2], nch; float xr[2], xi[2], xr2[2], xi2[2]; float *o1r, *o1i, *o2r = nullptr, *o2i = nullptr;
    if constexpr (SAMPLE) { const int b0 = 4 * sel; nch = 1;
        rowA = MP + (b0 + 2 * hA + (rA >> 3)) * DS + (rA & 7); rowE[0] = MP + (b0 + 2 * hE) * DS + rE; rowE[1] = MP + (b0 + 2 * hE + 1) * DS + rE;
        const size_t s1 = ((size_t)(b0 + 2 * hl) * NGRP + g) * NST + sl, s2 = s1 + (size_t)NGRP * NST;
#pragma unroll
        for (int ti = 0; ti < 2; ++ti) { xr[ti] = F.in[I_SRE][s1 + 32 * ti]; xi[ti] = F.in[I_SIM][s1 + 32 * ti]; xr2[ti] = F.in[I_SRE][s2 + 32 * ti]; xi2[ti] = F.in[I_SIM][s2 + 32 * ti]; }
        o1r = F.out + O_SRS + s1; o1i = F.out + O_SIS + s1; o2r = F.out + O_SRS + s2; o2i = F.out + O_SIS + s2;
    } else { const int seq0 = 2 * sel; nch = SEQ / 16;
        rowA = (seq0 + hA) * SEQ + rA; rowE[0] = (seq0 + hE) * SEQ + rE; rowE[1] = rowE[0] + 8;
#pragma unroll
        for (int ti = 0; ti < 2; ++ti) { xr[ti] = 0.f; xi[ti] = 0.f; xr2[ti] = 0.f; xi2[ti] = 0.f; }
        const size_t s1 = ((size_t)(seq0 + hl) * NGRP + g) * NST + sl; o1r = F.out + O_SRP + s1; o1i = F.out + O_SIP + s1;
    }
    f32x16 zero16;
#pragma unroll
    for (int i = 0; i < 16; ++i) zero16[i] = 0.f;
    f32x4 nx0, nx1, nxe[2]; float nrs, nre[2];
    { const float* xp = xrow_in(F, rowA) + g * 16 + 8 * hl; nx0 = *(const GAS f32x4*)xp; nx1 = *(const GAS f32x4*)(xp + 4); nrs = rstd0[rowA];
#pragma unroll
      for (int rt = 0; rt < 2; ++rt) { nxe[rt] = *(const GAS f32x4*)(xrow_in(F, rowE[rt]) + g * 16 + 4 * q); nre[rt] = rstd0[rowE[rt]]; } }
    for (int ch = 0; ch < nch; ++ch) {
        const f32x4 x0 = nx0, x1 = nx1; const float rs = nrs;
        f32x4 xe[2]; float re[2];
#pragma unroll
        for (int rt = 0; rt < 2; ++rt) { xe[rt] = nxe[rt]; re[rt] = nre[rt]; }
        if (ch + 1 < nch) { const int ra = rowA + 16 * (ch + 1); const float* xp = xrow_in(F, ra) + g * 16 + 8 * hl; nx0 = *(const GAS f32x4*)xp; nx1 = *(const GAS f32x4*)(xp + 4); nrs = rstd0[ra];
#pragma unroll
            for (int rt = 0; rt < 2; ++rt) { const int r = rowE[rt] + 16 * (ch + 1); nxe[rt] = *(const GAS f32x4*)(xrow_in(F, r) + g * 16 + 4 * q); nre[rt] = rstd0[r]; } }
        v4u au; au.x = cvtpk(x0[0] * rs, x0[1] * rs); au.y = cvtpk(x0[2] * rs, x0[3] * rs); au.z = cvtpk(x1[0] * rs, x1[1] * rs); au.w = cvtpk(x1[2] * rs, x1[3] * rs);
        const bf16x8 afr = __builtin_bit_cast(bf16x8, au);
#pragma unroll
        for (int ti = 0; ti < 2; ++ti) {
            f32x16 dr = __builtin_amdgcn_mfma_f32_32x32x16_bf16(afr, bfr[ti][0], zero16, 0, 0, 0);
            f32x16 di = __builtin_amdgcn_mfma_f32_32x32x16_bf16(afr, bfr[ti][1], zero16, 0, 0, 0);
            float sr = xr[ti], si = xi[ti];
#pragma unroll
            for (int r = 0; r < 16; ++r) {
                if (SAMPLE && r == 8) { o1r[32 * ti] = sr; o1i[32 * ti] = si; sr = xr2[ti]; si = xi2[ti]; }
                const float nr = fmaf(-ai[ti], si, fmaf(ar[ti], sr, dr[r])), ni = fmaf(ai[ti], sr, fmaf(ar[ti], si, di[r])); sr = nr; si = ni;
                xw[(((r & 3) + 8 * (r >> 2)) * 272 + ti * 128) / 4] = cvtpk(sr, si);
            }
            xr[ti] = sr; xi[ti] = si;
        }
        asm volatile("s_waitcnt lgkmcnt(0)" ::: "memory"); __builtin_amdgcn_sched_barrier(0);
        f32x4 y[2];
#pragma unroll
        for (int rt = 0; rt < 2; ++rt) { y[rt] = (f32x4){0.f, 0.f, 0.f, 0.f};
#pragma unroll
            for (int ks = 0; ks < 4; ++ks) { const bf16x8 xf = *(const LAS bf16x8*)(xrd + rt * (16 * 272) + ks * 64); y[rt] = __builtin_amdgcn_mfma_f32_16x16x32_bf16(cfr[ks], xf, y[rt], 0, 0, 0); } }
        asm volatile("s_waitcnt lgkmcnt(0)" ::: "memory"); __builtin_amdgcn_sched_barrier(0);
#pragma unroll
        for (int rt = 0; rt < 2; ++rt) { const int r = rowE[rt] + 16 * ch; f32x4 v;
#pragma unroll
            for (int j = 0; j < 4; ++j) v[j] = gelu_tanh(y[rt][j] + dg[j] * (xe[rt][j] * re[rt]));
            *(GAS unsigned long long*)((bf16*)(F.ws + WS_YSSM) + (size_t)r * DM + g * 16 + 4 * q) = (unsigned long long)cvtpk(v[0], v[1]) | ((unsigned long long)cvtpk(v[2], v[3]) << 32); }
    }
    if constexpr (SAMPLE) {
#pragma unroll
        for (int ti = 0; ti < 2; ++ti) { o2r[32 * ti] = xr[ti]; o2i[32 * ti] = xi[ti]; }
    } else {
#pragma unroll
        for (int ti = 0; ti < 2; ++ti) { o1r[32 * ti] = xr[ti]; o1i[32 * ti] = xi[ti]; }
    }
}
__device__ __forceinline__ void p1_ssm(Frame& F) {
    if (F.wave < 2) {
        for (int task = F.vcu * 2 + F.wave; task < 2 * NGRP; task += F.G * 2) ssm_run<false>(F, task & 255, task >> 8);
    } else {
        for (int task = F.vcu * 6 + (F.wave - 2); task < 32 * NGRP; task += F.G * 6) ssm_run<true>(F, task & 255, task >> 8);
    }
    convert_weights(F, 0, F.G == 256 ? CI_GLU + CI_GU : CI_L0, F.vcu, F.G);
}

__device__ __forceinline__ void final_norm(Frame& F, const float* gain, const float* ssq, float* dst) {
    const float* X = (const float*)(F.ws + WS_XRES); const size_t NT = (size_t)F.G * NWAVES * 64, TOT = (size_t)M * (DM / 4);
    for (size_t base = (size_t)F.vcu * NWAVES * 64 + F.tid; base < TOT; base += 8 * NT) {
        f32x4 xv[8]; float sv[8];
#pragma unroll
        for (int u = 0; u < 8; ++u) { const size_t idx = base + u * NT; if (idx < TOT) { const int r = (int)(idx >> 10), c = 4 * (int)(idx & 1023); xv[u] = *(const GAS f32x4*)(X + (size_t)r * DM + c); sv[u] = ssq[r]; } }
#pragma unroll
        for (int u = 0; u < 8; ++u) { const size_t idx = base + u * NT; if (idx < TOT) { const int r = (int)(idx >> 10), c = 4 * (int)(idx & 1023);
            *(GAS f32x4*)(dst + (size_t)r * DM + c) = xv[u] * __builtin_amdgcn_rsqf(sv[u] * (1.0f / DM) + RMS_EPS) * *(const GAS f32x4*)(gain + c); } }
    }
}
template <int GI> __device__ __forceinline__ void pool_elem_g(Frame& F) {
    constexpr int W = 2 << GI, R = 8, NH = R + W - 1;
    const float* X = (const float*)(F.ws + WS_XRES); const float* ssq1 = (const float*)(F.ctl + CW_SSQ) + M; const float* gain = F.in[I_NMIX] + DM;
    bf16* PP = (bf16*)(F.ws + WS_PPOOL);
    const size_t NT = (size_t)F.G * NWAVES * 64;
    for (size_t idx = (size_t)F.vcu * NWAVES * 64 + F.tid; idx < (size_t)(M / R) * 256; idx += NT) {
        const int r0 = (int)(idx >> 8) * R, q = (int)(idx & 255), c = GI * 1024 + 4 * q;
        const f32x4 gv = *(const GAS f32x4*)(gain + c);
        const bool prompt = r0 < MP; const int t0 = prompt ? (r0 & (SEQ - 1)) : 0; const int b = (r0 - MP) >> 3;
        f32x4 hv[NH]; float sq[NH];
#pragma unroll
        for (int k = 0; k < NH; ++k) { const int d = k - (W - 1), tt = t0 + d; const bool inseq = tt >= 0;
            const float* src = inseq ? X + (size_t)(r0 + d) * DM + c : (prompt ? X + (size_t)r0 * DM + c : F.in[I_SPOOL] + ((size_t)b * PBUF + (PBUF + tt)) * DM + c);
            hv[k] = *(const GAS f32x4*)src; sq[k] = ssq1[inseq ? r0 + d : r0]; }
#pragma unroll
        for (int k = 0; k < NH; ++k) { const bool inseq = (t0 + k - (W - 1)) >= 0; const float rs = __builtin_amdgcn_rsqf(sq[k] * (1.0f / DM) + RMS_EPS);
            hv[k] = hv[k] * (inseq ? gv * rs : (prompt ? (f32x4){0.f, 0.f, 0.f, 0.f} : (f32x4){1.f, 1.f, 1.f, 1.f})); }
#pragma unroll
        for (int i = 0; i < R; ++i) { const int r = r0 + i, t = t0 + i; const f32x4 h = hv[i + W - 1]; f32x4 s = h;
#pragma unroll
            for (int j = 1; j < W; ++j) s += hv[i + W - 1 - j];
            const float cnt = prompt ? (float)((t + 1) < W ? (t + 1) : W) : (float)W;
            const f32x4 p = s / cnt - h;
            *(GAS unsigned long long*)(PP + ((size_t)GI * M + r) * 1024 + 4 * q) = (unsigned long long)cvtpk(p.x, p.y) | ((unsigned long long)cvtpk(p.z, p.w) << 32);
            if (prompt) { if (t >= SEQ - PBUF) *(GAS f32x4*)(F.out + O_PP + ((size_t)(r >> 11) * PBUF + (t - (SEQ - PBUF))) * DM + c) = h; }
            else { float* ob = F.out + O_PS + (size_t)b * PBUF * DM + c;
                *(GAS f32x4*)(ob + (size_t)(PBUF - DS + t) * DM) = h;
                if (t < PBUF - DS) *(GAS f32x4*)(ob + (size_t)t * DM) = *(const GAS f32x4*)(F.in[I_SPOOL] + ((size_t)b * PBUF + DS + t) * DM + c); } }
    }
}
__device__ __forceinline__ void pool_elem(Frame& F) { pool_elem_g<0>(F); pool_elem_g<1>(F); pool_elem_g<2>(F); pool_elem_g<3>(F); }

__device__ __forceinline__ void down_phase(Frame& F, const unsigned char* wdn, float* ssq_l, int layer) {
    unsigned char* ws = F.ws;
    if (F.G == 256) {
        { pg8::Gemm g{(const pg8::bf16_t*)(ws + WS_HID), (const pg8::bf16_t*)wdn, MP, DM, DFF, 0}; pg8::MallOrder S; S.init(MP, DM, F.G, (int)blockIdx.x, 256, 2);
          pg8::EpiResid<false> E{(float*)(ws + WS_XRES), nullptr, nullptr, ssq_l, 36};
          pg8::gemm_phase<pg8::EpiResid<false>, pg8::MallOrder, PG8_ALIGN, PG8_SP2>(F.lds + RING_OFF, g, S, E); }
        const int c = (int)blockIdx.x, part = c >> 6, unit = (c & 7) * 8 + ((c >> 3) & 7);
        const int kt0 = part == 0 ? 0 : part == 1 ? 36 : part == 2 ? 82 : 128, ntp = part == 0 ? 36 : part == 3 ? 44 : 46;
        pg8::Gemm g{(const pg8::bf16_t*)(ws + WS_HID) + kt0 * 64, (const pg8::bf16_t*)wdn + kt0 * 64, M, DM, DFF, ntp};
        unsigned* ctr = (unsigned*)(F.ctl + CW_SPLIT) + (layer * 64 + unit) * 16;
        pg8::EpiResidSplit E{(float*)(ws + WS_XRES), ssq_l, (float*)(ws + WS_YSSM) + (size_t)unit * 3 * 65536, ctr, part};
        pg8::SplitOrder S{c, 32};
        pg8::gemm_phase<pg8::EpiResidSplit, pg8::SplitOrder, PG8_ALIGN, PG8_SP2>(F.lds + RING_OFF, g, S, E);
        if (part != 0) { __syncthreads();
            if (F.tid == 0) { __builtin_amdgcn_fence(__ATOMIC_RELEASE, "agent"); asm volatile("s_waitcnt vmcnt(0)" ::: "memory"); (void)__hip_atomic_fetch_add(ctr, 1u, __ATOMIC_RELAXED, __HIP_MEMORY_SCOPE_AGENT); } }
    } else {
        pg8::Gemm g{(const pg8::bf16_t*)(ws + WS_HID), (const pg8::bf16_t*)wdn, M, DM, DFF, 0}; pg8::MallOrder S; S.init(M, DM, F.G, (int)blockIdx.x, 192, 2);
        pg8::EpiResid<false> E{(float*)(ws + WS_XRES), nullptr, nullptr, ssq_l, 36};
        pg8::gemm_phase<pg8::EpiResid<false>, pg8::MallOrder, PG8_ALIGN, PG8_SP2, 3>(F.lds + RING_OFF, g, S, E);
    }
}

struct Args { const float* in[21]; float* out; unsigned char* ws; int ph_lo, ph_hi; };
__global__ void __launch_bounds__(NWAVES * 64, 2) skel_fwd(Args args) {
    extern __shared__ __attribute__((aligned(16))) unsigned char lds[];
    Frame F;
    F.lds = (LAS unsigned char*)lds;
    F.MISC = (volatile LAS unsigned*)(F.lds + MISC_OFF);
    F.tid = threadIdx.x; F.lane = F.tid & 63; F.wave = __builtin_amdgcn_readfirstlane(F.tid >> 6);
    F.G = gridDim.x; { const int bx = blockIdx.x; F.vcu = (F.G % 8 == 0) ? (bx % 8) * (F.G / 8) + bx / 8 : bx; }
    unsigned char* ws = args.ws; F.ws = ws; F.out = args.out;
    F.ctl = (gu32*)(ws + WS_CTL);
#pragma unroll
    for (int i = 0; i < 21; ++i) F.in[i] = args.in[i];
    for (int u = F.tid; u < (LDS_BYTES - LDSCTL_OFF) / 4; u += NWAVES * 64) ((LAS unsigned*)(F.lds + LDSCTL_OFF))[u] = 0u;
    __syncthreads();
    const int lo = args.ph_lo, hi = args.ph_hi;
    const bool use_bar = (hi - lo) > 1;
    XcdBarrier bar; bar.bar = (unsigned*)(F.ctl + CW_BAR); bar.x = 0; bar.st = nullptr;
    if (use_bar) bar = xcd_barrier_post((unsigned*)(F.ctl + CW_BAR), F.MISC + 8);
#define IN(k) (lo <= (k) && (k) < hi)
#define SEAM(k) do { if (IN(k) && IN((k) + 1)) xcd_barrier(bar); } while (0)

    float* ssq = (float*)(F.ctl + CW_SSQ);
    if (IN(0)) { p0_prologue(F); SEAM(0); }
    if (IN(1)) { p1_ssm(F); SEAM(1); }
    if (IN(2)) {
        pg8::Gemm g{(const pg8::bf16_t*)(ws + WS_YSSM), (const pg8::bf16_t*)(ws + WS_WGLU), M, 2 * DM, DM}; pg8::MallOrder S; S.init(M, 2 * DM, F.G, (int)blockIdx.x, 256, 1);
        pg8::EpiGlu E{F.in[I_XP], F.in[I_XS], (float*)(ws + WS_XRES), (pg8::bf16_t*)(ws + WS_HA), ssq};
        pg8::gemm_phase<pg8::EpiGlu, pg8::MallOrder, PG8_ALIGN, PG8_SP2>(F.lds + RING_OFF, g, S, E);
        { constexpr int NIDLE = 256 - (36 * 32) % 256, QUOTA = 60; const int j = (int)blockIdx.x - (256 - NIDLE);
          if (F.G == 256 && j >= 0) { convert_reset(F); convert_weights(F, CI_GLU + CI_GU, CI_L0, j, NIDLE); } }
        SEAM(2);
    }
    if (IN(3)) {
        pg8::Gemm g{(const pg8::bf16_t*)(ws + WS_HA), (const pg8::bf16_t*)(ws + WS_WGU0), M, 2 * DFF, DM}; pg8::MallOrder S; S.init(M, 2 * DFF, F.G, (int)blockIdx.x, 256, 1);
        pg8::EpiSwiglu E{(pg8::bf16_t*)(ws + WS_HID), DFF, ssq};
        pg8::gemm_phase<pg8::EpiSwiglu, pg8::MallOrder, PG8_ALIGN, PG8_SP2>(F.lds + RING_OFF, g, S, E);
        { constexpr int NIDLE = 256 - (36 * 86) % 256, LO = CI_L0 + 128 * 60, HI = CI_ALL - CI_DN; const int j = (int)blockIdx.x - (256 - NIDLE);
          if (F.G == 256) { if (j >= 0) { convert_reset(F); convert_weights(F, CI_L0, HI, j, NIDLE); } }
          else { convert_reset(F); convert_weights(F, CI_L0, HI, F.vcu, F.G); } }
        SEAM(3);
    }
    if (IN(4)) { down_phase(F, ws + WS_WDN0, ssq + M, 0); SEAM(4); }
    if (IN(5)) { pool_elem(F); SEAM(5); }
    if (IN(6)) {
        pg8::Gemm g{(const pg8::bf16_t*)(ws + WS_PPOOL), (const pg8::bf16_t*)(ws + WS_WPOOL), 4 * M, 4096, 1024}; pg8::PoolOrder S{F.G, (int)blockIdx.x, 48};
        pg8::EpiResid<true> E{(float*)(ws + WS_XRES), F.in[I_PSCALE], (pg8::bf16_t*)(ws + WS_HA), ssq + 2 * M, 48};
        pg8::gemm_phase<pg8::EpiResid<true>, pg8::PoolOrder, PG8_ALIGN, PG8_SP2, 3>(F.lds + RING_OFF, g, S, E);
        SEAM(6);
    }
    if (IN(7)) {
        pg8::Gemm g{(const pg8::bf16_t*)(ws + WS_HA), (const pg8::bf16_t*)(ws + WS_WGU1), M, 2 * DFF, DM};
        pg8::EpiSwiglu E{(pg8::bf16_t*)(ws + WS_HID), DFF, ssq + 2 * M};
        constexpr int NU = 36 * 86, NT = NU % 256;
        if (F.G == 256) {
            pg8::MallOrder S; S.init(M, 2 * DFF, F.G, (int)blockIdx.x, 256, 1, NU / 256);
            pg8::gemm_phase<pg8::EpiSwiglu, pg8::MallOrder, PG8_ALIGN, PG8_SP2>(F.lds + RING_OFF, g, S, E);
            pg8::TailOrder T{S, NT, NU / 256};
            pg8::gemm_phase<pg8::EpiSwiglu, pg8::TailOrder, PG8_ALIGN, PG8_SP2, 2>(F.lds + RING_OFF, g, T, E);
            const int j = (int)blockIdx.x - 2 * NT;
            if (j >= 0) { convert_reset(F); convert_weights(F, CI_ALL - CI_DN, CI_ALL, j, 256 - 2 * NT); }
        } else {
            pg8::MallOrder S; S.init(M, 2 * DFF, F.G, (int)blockIdx.x, 256, 1);
            pg8::gemm_phase<pg8::EpiSwiglu, pg8::MallOrder, PG8_ALIGN, PG8_SP2>(F.lds + RING_OFF, g, S, E);
            convert_reset(F); convert_weights(F, CI_ALL - CI_DN, CI_ALL, F.vcu, F.G);
        }
        SEAM(7);
    }
    if (IN(8)) { down_phase(F, ws + WS_WDN1, ssq + 3 * M, 1); SEAM(8); }
    if (IN(9)) { final_norm(F, F.in[I_NFIN], ssq + 3 * M, F.out + O_YP); }
#undef IN
#undef SEAM
}

extern "C" void kernel_launch(void* const* d_in, const int* in_sizes, int n_in, void* d_out, int out_size, void* d_ws, size_t ws_size, hipStream_t stream) {
    static int grid = 0;
    if (grid == 0) {
        if (n_in != 21 || in_sizes[0] != MP * DM || (size_t)out_size != O_END || ws_size < WS_END) { fprintf(stderr, "kernel_launch: unexpected shapes (n_in %d, in0 %d, out %d, ws %zu); nothing launched\n", n_in, n_in > 0 ? in_sizes[0] : -1, out_size, ws_size); grid = -1; return; }
        int dev = 0, cus = 0, per_cu = 0;
        if (hipGetDevice(&dev) != hipSuccess || hipDeviceGetAttribute(&cus, hipDeviceAttributeMultiprocessorCount, dev) != hipSuccess) { grid = -1; return; }
        if (hipFuncSetAttribute((const void*)skel_fwd, hipFuncAttributeMaxDynamicSharedMemorySize, LDS_BYTES) != hipSuccess) { fprintf(stderr, "kernel_launch: hipFuncSetAttribute failed\n"); grid = -1; return; }
        if (hipOccupancyMaxActiveBlocksPerMultiprocessor(&per_cu, (const void*)skel_fwd, NWAVES * 64, LDS_BYTES) != hipSuccess || per_cu < 1) { fprintf(stderr, "kernel_launch: occupancy query says %d blocks per CU\n", per_cu); }
        (void)hipGetLastError();
        grid = cus;
    }
    if (grid < 0) return;
    if (hipMemsetAsync((char*)d_ws + WS_CTL, 0, CTL_ZERO_BYTES, stream) != hipSuccess) return;
    Args a{};
    for (int i = 0; i < 21; ++i) a.in[i] = (const float*)d_in[i];
    a.out = (float*)d_out; a.ws = (unsigned char*)d_ws;
#if MK_ONE_LAUNCH
    a.ph_lo = 0; a.ph_hi = N_PHASES;
    hipLaunchKernelGGL(skel_fwd, dim3(grid), dim3(NWAVES * 64), LDS_BYTES, stream, a);
#else
    for (int ph = 0; ph < N_PHASES; ++ph) { a.ph_lo = ph; a.ph_hi = ph + 1; hipLaunchKernelGGL(skel_fwd, dim3(grid), dim3(NWAVES * 64), LDS_BYTES, stream, a); }
#endif
}
```

```cpp
#include <hip/hip_runtime.h>
#include <cstdio>
#include <cstdint>
namespace pg8 {
#define PG8_LAS __attribute__((address_space(3)))
typedef unsigned short bf16_t;
typedef short bf16x8 __attribute__((ext_vector_type(8)));
typedef float f32x4 __attribute__((ext_vector_type(4)));
typedef unsigned u32x4 __attribute__((ext_vector_type(4)));
constexpr int BM = 256, BK = 64, HALF = 128, HTB = HALF * BK * 2  , STAGE_BYTES = 8 * HTB, NXCD = 8, WGM = 8;

__host__ __device__ __forceinline__ int lds_byte(int r, int c) { const int st = (r >> 4) * 2 + (c >> 5), rr = r & 15, cc = c & 31, ob = rr * 64 + cc * 2; return st * 1024 + (ob ^ (((ob >> 9) & 1) << 5)); }
__host__ __device__ __forceinline__ void stage_rc(int b, int& R, int& C) { const int st = b / 1024, sb = b % 1024, swz = sb ^ (((sb >> 9) & 1) << 5); R = (st >> 1) * 16 + swz / 64; C = (st & 1) * 32 + (swz % 64) / 2; }
__host__ __device__ __forceinline__ int perm32(int rho) { const int n = rho >> 4, i = rho & 15; return 8 * (i >> 2) + 4 * n + (i & 3); }

struct Unit { int pm, pn; };
struct Gemm { const bf16_t* A; const bf16_t* Bt; int M, N, K; int nt; };

struct StaticOrder {
    int nM, nN, nwg, G, c;
    __host__ __device__ void init(int M, int N, int G_, int c_, int bm = BM) { nM = M / bm; nN = N / BM; nwg = nM * nN; G = G_; c = c_; }
    __host__ __device__ bool next(int i, Unit& u) const {
        const long L = (long)i * G + c; if (L >= nwg) return false;
        int wgid = (int)L; { const int q = nwg / NXCD, r = nwg % NXCD, xcd = wgid % NXCD, off = wgid / NXCD; wgid = (xcd < r ? xcd * (q + 1) : r * (q + 1) + (xcd - r) * q) + off; }
        const int nig = WGM * nN, gid = wgid / nig, fm = gid * WGM, gsz = (nM - fm) < WGM ? (nM - fm) : WGM;
        u.pm = fm + ((wgid % nig) % gsz); u.pn = (wgid % nig) / gsz; return true;
    }
    __device__ __forceinline__ void a_ready(const Unit&) const {}
    __device__ __forceinline__ void done(const Unit&) const {}
};

struct MallOrder {
    int nM, nN, G, c, XR, maxr;
    __host__ __device__ void init(int M, int N, int G_, int c_, int bm, int XR_, int maxr_ = 1 << 20) { nM = M / bm; nN = N / BM; G = G_; c = c_; XR = XR_; maxr = maxr_; }
    __host__ __device__ bool next(int i, Unit& u) const {
        constexpr int CW = 32; if (i >= maxr) return false;
        const int XC = NXCD / XR, x = c % NXCD, xr = x / XC, xc = x % XC;
        int q = i * (G / NXCD) + c / NXCD;
        for (int ch = 0; ch * CW < nN; ++ch) {
            const int cw = (nN - ch * CW) < CW ? (nN - ch * CW) : CW;
            for (int g = 0; g * XR * 8 < nM; ++g) {
                const int fm = (g * XR + xr) * 8, left = nM - fm, gsz = left < 0 ? 0 : (left < 8 ? left : 8), perg = gsz * cw / XC;
                if (q < perg) { const int uu = xc * perg + q; u.pm = fm + uu % gsz; u.pn = ch * CW + uu / gsz; return true; }
                q -= perg;
            }
        }
        return false;
    }
    __device__ __forceinline__ void a_ready(const Unit&) const {}
    __device__ __forceinline__ void done(const Unit&) const {}
};

struct TailOrder {
    MallOrder base; int nt, round;
    __host__ __device__ bool next(int i, Unit& u) const {
        if (i != 0 || base.c >= 2 * nt) return false;
        MallOrder b = base; b.c = base.c % nt; b.maxr = 1 << 20; Unit v; if (!b.next(round, v)) return false;
        u.pm = 2 * v.pm + base.c / nt; u.pn = v.pn; return true;
    }
    __device__ __forceinline__ void a_ready(const Unit&) const {}
    __device__ __forceinline__ void done(const Unit&) const {}
};


__device__ __forceinline__ unsigned cvt_pk_bf16(float lo, float hi) { unsigned r; asm volatile("v_cvt_pk_bf16_f32 %0, %1, %2" : "=v"(r) : "v"(lo), "v"(hi)); return r; }
__device__ __forceinline__ float sigmoid_f(float x) { return __builtin_amdgcn_rcpf(1.0f + __expf(-x)); }

__device__ __forceinline__ void ssq_add(float* ssq, int row, float s, int fq) {
    s += __shfl_xor(s, 16); s += __shfl_xor(s, 32);
    if (fq == 0) unsafeAtomicAdd(ssq + row, s);
}
__device__ __forceinline__ float rstd_of(const float* ssq, int row) { return __builtin_amdgcn_rsqf(ssq[row] * (1.0f / 4096.0f) + 1e-6f); }
struct EpiGlu {
    static constexpr bool PERM = false, AFTER_DRAIN = false;
    const float* xin_p; const float* xin_s; float* xout; bf16_t* xb; float* ssq;
    template <int MQ> __device__ __forceinline__ void operator()(const f32x4 (&acc)[2][2][MQ][2], const Unit& u, int wr, int wc, int fr, int fq) const {
        constexpr int MHALF = 32 * MQ; const int row0 = u.pm * (2 * MHALF) + wr * (16 * MQ) + fr, col0 = u.pn * HALF + wc * 32 + 4 * fq;
        const float* xi = (row0 < 8192) ? xin_p + (size_t)row0 * 4096 : xin_s + (size_t)(row0 - 8192) * 4096;
        float* ob = xout + (size_t)row0 * 4096; bf16_t* bb = xb + (size_t)row0 * 4096;
#pragma unroll
        for (int ai = 0; ai < 2; ++ai)
#pragma unroll
            for (int m = 0; m < MQ; ++m) { const size_t off = (size_t)(ai * MHALF + m * 16) * 4096 + col0; float sq = 0.f;
#pragma unroll
                for (int n = 0; n < 2; ++n) { const f32x4 xv = *(const f32x4*)(xi + off + 16 * n); const f32x4 a = acc[ai][0][m][n], b = acc[ai][1][m][n]; f32x4 o;
#pragma unroll
                    for (int j = 0; j < 4; ++j) { o[j] = xv[j] + a[j] * sigmoid_f(b[j]); sq = fmaf(o[j], o[j], sq); }
                    *(f32x4*)(ob + off + 16 * n) = o;
                    *(unsigned long long*)(bb + off + 16 * n) = (unsigned long long)cvt_pk_bf16(o[0], o[1]) | ((unsigned long long)cvt_pk_bf16(o[2], o[3]) << 32); }
                ssq_add(ssq, row0 + ai * MHALF + m * 16, sq, fq); }
    }
};
struct EpiSwiglu {
    static constexpr bool PERM = true, AFTER_DRAIN = false;
    bf16_t* O; int ldc; const float* ssq;
    template <int MQ> __device__ __forceinline__ void operator()(const f32x4 (&acc)[2][2][MQ][2], const Unit& u, int wr, int wc, int fr, int fq) const {
        constexpr int MHALF = 32 * MQ; const int row0 = u.pm * (2 * MHALF) + wr * (16 * MQ) + fr, col0 = u.pn * HALF + wc * 32 + 8 * fq;
#pragma unroll
        for (int ai = 0; ai < 2; ++ai)
#pragma unroll
            for (int m = 0; m < MQ; ++m) { const int r = row0 + ai * MHALF + m * 16; bf16_t* rowp = O + (size_t)r * ldc + col0; const float rs = rstd_of(ssq, r);
                f32x4 h[2];
#pragma unroll
                for (int n = 0; n < 2; ++n) { const f32x4 g = acc[ai][0][m][n] * rs, v = acc[ai][1][m][n] * rs;
#pragma unroll
                    for (int j = 0; j < 4; ++j) h[n][j] = g[j] * sigmoid_f(g[j]) * v[j]; }
                u32x4 w; w.x = cvt_pk_bf16(h[0][0], h[0][1]); w.y = cvt_pk_bf16(h[0][2], h[0][3]); w.z = cvt_pk_bf16(h[1][0], h[1][1]); w.w = cvt_pk_bf16(h[1][2], h[1][3]);
                *(u32x4*)rowp = w; }
    }
};
template <bool POOL> struct EpiResid {
    static constexpr bool PERM = false, AFTER_DRAIN = false;
    float* x; const float* scale; bf16_t* xb; float* ssq; int npm;
    template <int MQ> __device__ __forceinline__ void operator()(const f32x4 (&acc)[2][2][MQ][2], const Unit& u, int wr, int wc, int fr, int fq) const {
        constexpr int MHALF = 32 * MQ; const int pm = POOL ? (u.pm % npm) : u.pm;
        const int row0 = pm * (2 * MHALF) + wr * (16 * MQ) + fr, col0 = u.pn * BM + wc * 32 + 4 * fq;
        f32x4 sv[2][2];
#pragma unroll
        for (int bj = 0; bj < 2; ++bj)
#pragma unroll
            for (int n = 0; n < 2; ++n) sv[bj][n] = POOL ? *(const f32x4*)(scale + col0 + bj * HALF + n * 16) : (f32x4){1.f, 1.f, 1.f, 1.f};
#pragma unroll
        for (int ai = 0; ai < 2; ++ai)
#pragma unroll
            for (int m = 0; m < MQ; ++m) { const int r = row0 + ai * MHALF + m * 16; float* rowp = x + (size_t)r * 4096 + col0; float sq = 0.f;
#pragma unroll
                for (int bj = 0; bj < 2; ++bj)
#pragma unroll
                    for (int n = 0; n < 2; ++n) { const f32x4 xv = *(const f32x4*)(rowp + bj * HALF + n * 16);
                        const f32x4 o = POOL ? xv + acc[ai][bj][m][n] * sv[bj][n] : xv + acc[ai][bj][m][n];
                        sq += (o[0] * o[0] + o[1] * o[1]) + (o[2] * o[2] + o[3] * o[3]);
                        *(f32x4*)(rowp + bj * HALF + n * 16) = o;
                        if (POOL) *(unsigned long long*)(xb + (size_t)r * 4096 + col0 + bj * HALF + n * 16) = (unsigned long long)cvt_pk_bf16(o[0], o[1]) | ((unsigned long long)cvt_pk_bf16(o[2], o[3]) << 32); }
                ssq_add(ssq, r, sq, fq); }
    }
};
struct EpiResidSplit {
    static constexpr bool PERM = false, AFTER_DRAIN = false;
    float* x; float* ssq; float* slab; unsigned* ctr; int part;
    template <int MQ> __device__ __forceinline__ void operator()(const f32x4 (&acc)[2][2][MQ][2], const Unit& u, int wr, int wc, int fr, int fq) const {
        static_assert(MQ == 4, "split tail: 256-row tiles");
        const int tid = threadIdx.x;
        if (part != 0) {
            f32x4* sp = (f32x4*)slab + (size_t)(part - 1) * 16384 + tid;
#pragma unroll
            for (int ai = 0; ai < 2; ++ai)
#pragma unroll
                for (int bj = 0; bj < 2; ++bj)
#pragma unroll
                    for (int m = 0; m < 4; ++m)
#pragma unroll
                        for (int n = 0; n < 2; ++n) sp[(((ai * 2 + bj) * 4 + m) * 2 + n) * 512] = acc[ai][bj][m][n];
            return;
        }
        { unsigned sp = 0; while (__hip_atomic_load(ctr, __ATOMIC_RELAXED, __HIP_MEMORY_SCOPE_AGENT) < 3u && ++sp < (1u << 22)) __builtin_amdgcn_s_sleep(2); }
        __builtin_amdgcn_fence(__ATOMIC_ACQUIRE, "agent");
        const f32x4* sp = (const f32x4*)slab + tid;
        const int row0 = u.pm * 256 + wr * 64 + fr, col0 = u.pn * BM + wc * 32 + 4 * fq;
#pragma unroll
        for (int ai = 0; ai < 2; ++ai)
#pragma unroll
            for (int m = 0; m < 4; ++m) { const int r = row0 + ai * 128 + m * 16; float* rowp = x + (size_t)r * 4096 + col0; float sq = 0.f;
#pragma unroll
                for (int bj = 0; bj < 2; ++bj)
#pragma unroll
                    for (int n = 0; n < 2; ++n) { const int idx = (((ai * 2 + bj) * 4 + m) * 2 + n) * 512;
                        const f32x4 xv = *(const f32x4*)(rowp + bj * HALF + n * 16);
                        const f32x4 o = (xv + acc[ai][bj][m][n]) + ((sp[idx] + sp[16384 + idx]) + sp[32768 + idx]);
                        sq += (o[0] * o[0] + o[1] * o[1]) + (o[2] * o[2] + o[3] * o[3]);
                        *(f32x4*)(rowp + bj * HALF + n * 16) = o; }
                ssq_add(ssq, r, sq, fq); }
    }
};
struct SplitOrder {
    int c, pm0;
    __device__ bool next(int i, Unit& u) const { if (i != 0) return false; const int slot = (c >> 3) & 7; u.pm = pm0 + (slot & 3); u.pn = 2 * (c & 7) + (slot >> 2); return true; }
    __device__ __forceinline__ void a_ready(const Unit&) const {}
    __device__ __forceinline__ void done(const Unit&) const {}
};
struct PoolOrder {
    int G, c, npm;
    __device__ bool next(int i, Unit& u) const {
        const int per = npm * 4, L = i * G + c; if (L >= 4 * per) return false;
        const int grp = L / per, rem = L % per; u.pm = grp * npm + rem % npm; u.pn = grp * 4 + rem / npm; return true;
    }
    __device__ __forceinline__ void a_ready(const Unit&) const {}
    __device__ __forceinline__ void done(const Unit&) const {}
};

template <class Epi, class Sched, bool ALIGN_EPI = false, bool SP2 = false, int MQ = 4>
__device__ __forceinline__ void gemm_phase(PG8_LAS unsigned char* lds, const Gemm g, const Sched& S, const Epi& E) {
    const int tid = threadIdx.x, wid = __builtin_amdgcn_readfirstlane(tid >> 6), lane = tid & 63, wr = wid >> 2, wc = wid & 3, fr = lane & 15, fq = lane >> 4;
    static_assert(MQ == 4 || ((MQ == 3 || MQ == 2) && SP2), "192- and 128-row tiles: only the SP2 loop carries the wave-group-specific waits");
    const int K = g.K, nt = g.nt ? g.nt : K / BK;
    unsigned voffA[2], voffB[2];
#pragma unroll
    for (int i = 0; i < 2; ++i) { int R, C; stage_rc(tid * 16 + i * 8192, R, C); const int Rb = Epi::PERM ? ((R & ~31) + perm32(R & 31)) : R;
        voffA[i] = (unsigned)(R * K + C) * 2u; voffB[i] = (unsigned)(Rb * K + C) * 2u; }
    const size_t kstep = (size_t)(BK * 2);
    const size_t hstep = (size_t)HALF * K * 2, hstepA = (size_t)(32 * MQ) * K * 2;
    const size_t tstep = 2 * hstep, tstepA = 2 * hstepA;
    const unsigned ldsw = (unsigned)wid * 1024u;
    const int aoff = lds_byte(wr * (16 * MQ) + fr, fq * 8), boff = lds_byte(wc * 32 + fr, fq * 8);
#define PG8_SA(b, h) (((b) * 2 + (h)) * HTB)
#define PG8_SB(b, h) ((4 + (b) * 2 + (h)) * HTB)
#define PG8_STAGE(bufoff, gbase, voff) do { _Pragma("unroll") for (int _i = 0; _i < 2; ++_i) \
        __builtin_amdgcn_global_load_lds((const unsigned*)((const char*)(gbase) + (voff)[_i]), (PG8_LAS unsigned*)(lds + (bufoff) + ldsw + _i * 8192), 16, 0, 0); } while (0)
#define PG8_STAGE_A(bufoff, gbase) do { __builtin_amdgcn_global_load_lds((const unsigned*)((const char*)(gbase) + voffA[0]), (PG8_LAS unsigned*)(lds + (bufoff) + ldsw), 16, 0, 0); \
        if (MQ == 4 || (MQ == 3 && wid < 4)) __builtin_amdgcn_global_load_lds((const unsigned*)((const char*)(gbase) + voffA[1]), (PG8_LAS unsigned*)(lds + (bufoff) + ldsw + 8192), 16, 0, 0); } while (0)
#define PG8_LDA(dst, b, h) do { _Pragma("unroll") for (int m = 0; m < MQ; ++m) _Pragma("unroll") for (int k = 0; k < 2; ++k) dst[m][k] = *(const PG8_LAS bf16x8*)(lds + PG8_SA(b, h) + aoff + m * 2048 + k * 1024); } while (0)
#define PG8_LDB(dst, b, h) do { _Pragma("unroll") for (int n = 0; n < 2; ++n) _Pragma("unroll") for (int k = 0; k < 2; ++k) dst[n][k] = *(const PG8_LAS bf16x8*)(lds + PG8_SB(b, h) + boff + n * 2048 + k * 1024); } while (0)
#define PG8_MMA(ai, bj, At, Bt) do { __builtin_amdgcn_s_setprio(1); _Pragma("unroll") for (int m = 0; m < MQ; ++m) _Pragma("unroll") for (int n = 0; n < 2; ++n) _Pragma("unroll") for (int k = 0; k < 2; ++k) \
        acc[ai][bj][m][n] = __builtin_amdgcn_mfma_f32_16x16x32_bf16(Bt[n][k], At[m][k], acc[ai][bj][m][n], 0, 0, 0); __builtin_amdgcn_s_setprio(0); } while (0)
#define PG8_WAIT_V(n) asm volatile("s_waitcnt vmcnt(" #n ")" ::: "memory")
#define PG8_WAIT_V8 do { if (MQ == 2 || (MQ == 3 && wid >= 4)) PG8_WAIT_V(6); else PG8_WAIT_V(8); } while (0)
#define PG8_WAIT_L(n) asm volatile("s_waitcnt lgkmcnt(" #n ")" ::: "memory")
#define PG8_BAR __builtin_amdgcn_s_barrier()
#define PG8_SCHED __builtin_amdgcn_sched_barrier(0)
    Unit cur, nxt; int ui = 0;
    if (!S.next(0, cur)) return;
    f32x4 acc[2][2][MQ][2];
#pragma unroll
    for (int a = 0; a < 2; ++a)
#pragma unroll
        for (int b = 0; b < 2; ++b)
#pragma unroll
            for (int m = 0; m < MQ; ++m)
#pragma unroll
                for (int n = 0; n < 2; ++n) acc[a][b][m][n] = (f32x4){0.f, 0.f, 0.f, 0.f};
    bf16x8 At[MQ][2], B0[2][2], B1[2][2];
    const char* cA = (const char*)g.A + (size_t)cur.pm * tstepA; const char* cB = (const char*)g.Bt + (size_t)cur.pn * tstep;
    S.a_ready(cur);
    if constexpr (SP2) {
        PG8_STAGE(PG8_SB(0, 0), cB, voffB); PG8_STAGE(PG8_SB(0, 1), cB + hstep, voffB); PG8_STAGE_A(PG8_SA(0, 0), cA); PG8_STAGE_A(PG8_SA(0, 1), cA + hstepA);
        if (wr == 1) PG8_BAR;
        if (MQ == 2 || (MQ == 3 && wid >= 4)) PG8_WAIT_V(1); else PG8_WAIT_V(2);
        PG8_BAR;
        PG8_STAGE(PG8_SB(1, 0), cB + kstep, voffB); PG8_STAGE_A(PG8_SA(1, 0), cA + kstep); PG8_STAGE(PG8_SB(1, 1), cB + hstep + kstep, voffB);
        if (MQ == 2 || (MQ == 3 && wid >= 4)) PG8_WAIT_V(5); else PG8_WAIT_V(6);
        PG8_BAR;
    } else {
        PG8_STAGE(PG8_SB(0, 0), cB, voffB); PG8_STAGE_A(PG8_SA(0, 0), cA); PG8_STAGE(PG8_SB(0, 1), cB + hstep, voffB); PG8_STAGE_A(PG8_SA(0, 1), cA + hstepA);
        if (wr == 1) PG8_BAR;
        PG8_WAIT_V(4); PG8_BAR;
        PG8_STAGE(PG8_SB(1, 0), cB + kstep, voffB); PG8_STAGE_A(PG8_SA(1, 0), cA + kstep); PG8_STAGE(PG8_SB(1, 1), cB + hstep + kstep, voffB);
        PG8_WAIT_V(6); PG8_BAR;
    }
    for (;;) {
        const bool has_next = S.next(ui + 1, nxt);
        const char* nA = has_next ? (const char*)g.A + (size_t)nxt.pm * tstepA : cA; const char* nB = has_next ? (const char*)g.Bt + (size_t)nxt.pn * tstep : cB;
        for (int t = 0; t < nt; t += 2) {
            const bool last = (t == nt - 2);
            const char* a1 = cA + (size_t)(t + 1) * kstep;
            const char* a2 = last ? nA : cA + (size_t)(t + 2) * kstep; const char* b2 = last ? nB : cB + (size_t)(t + 2) * kstep;
            const char* a3 = a2 + kstep; const char* b3 = b2 + kstep;
            if (last && has_next) S.a_ready(nxt);
            if constexpr (SP2) {
            PG8_LDB(B0, 0, 0); PG8_LDB(B1, 0, 1); PG8_SCHED; PG8_LDA(At, 0, 0); PG8_STAGE_A(PG8_SA(1, 1), a1 + hstepA);
            PG8_WAIT_V8; PG8_WAIT_L(0); PG8_BAR; PG8_MMA(0, 0, At, B0); PG8_MMA(0, 1, At, B1); PG8_BAR; PG8_SCHED;
            PG8_LDA(At, 0, 1); PG8_STAGE(PG8_SB(0, 0), b2, voffB); PG8_STAGE(PG8_SB(0, 1), b2 + hstep, voffB); PG8_STAGE_A(PG8_SA(0, 0), a2);
            PG8_WAIT_V8; PG8_WAIT_L(0); PG8_BAR; PG8_MMA(1, 0, At, B0); PG8_MMA(1, 1, At, B1); PG8_BAR; PG8_SCHED;
            PG8_LDB(B0, 1, 0); PG8_LDB(B1, 1, 1); PG8_SCHED; PG8_LDA(At, 1, 0); PG8_STAGE_A(PG8_SA(0, 1), a2 + hstepA);
            PG8_WAIT_V8; PG8_WAIT_L(0); PG8_BAR; PG8_MMA(0, 0, At, B0); PG8_MMA(0, 1, At, B1); PG8_BAR; PG8_SCHED;
            PG8_LDA(At, 1, 1); PG8_STAGE(PG8_SB(1, 0), b3, voffB); PG8_STAGE(PG8_SB(1, 1), b3 + hstep, voffB); PG8_STAGE_A(PG8_SA(1, 0), a3);
            PG8_WAIT_V8; PG8_WAIT_L(0); PG8_BAR; PG8_MMA(1, 0, At, B0); PG8_MMA(1, 1, At, B1); PG8_BAR; PG8_SCHED;
            } else {
            PG8_LDB(B0, 0, 0); PG8_SCHED; PG8_LDA(At, 0, 0); PG8_STAGE_A(PG8_SA(1, 1), a1 + hstepA);
            PG8_WAIT_L(8); PG8_BAR; PG8_WAIT_L(0); PG8_MMA(0, 0, At, B0); PG8_BAR; PG8_SCHED;
            PG8_LDB(B1, 0, 1); PG8_STAGE(PG8_SB(0, 0), b2, voffB);
            PG8_BAR; PG8_WAIT_L(0); PG8_MMA(0, 1, At, B1); PG8_BAR;
            PG8_LDA(At, 0, 1); PG8_STAGE_A(PG8_SA(0, 0), a2);
            PG8_BAR; PG8_WAIT_L(0); PG8_MMA(1, 0, At, B0); PG8_BAR; PG8_SCHED;
            PG8_STAGE(PG8_SB(0, 1), b2 + hstep, voffB);
            PG8_WAIT_V(6); PG8_BAR; PG8_MMA(1, 1, At, B1); PG8_BAR;
            PG8_LDB(B0, 1, 0); PG8_SCHED; PG8_LDA(At, 1, 0); PG8_STAGE_A(PG8_SA(0, 1), a2 + hstepA);
            PG8_WAIT_L(8); PG8_BAR; PG8_WAIT_L(0); PG8_MMA(0, 0, At, B0); PG8_BAR; PG8_SCHED;
            PG8_LDB(B1, 1, 1); PG8_STAGE(PG8_SB(1, 0), b3, voffB);
            PG8_BAR; PG8_WAIT_L(0); PG8_MMA(0, 1, At, B1); PG8_BAR;
            PG8_LDA(At, 1, 1); PG8_STAGE_A(PG8_SA(1, 0), a3);
            PG8_BAR; PG8_WAIT_L(0); PG8_MMA(1, 0, At, B0); PG8_BAR; PG8_SCHED;
            PG8_STAGE(PG8_SB(1, 1), b3 + hstep, voffB);
            PG8_WAIT_V(6); PG8_BAR; PG8_MMA(1, 1, At, B1); PG8_BAR;
            }
        }
        if constexpr (ALIGN_EPI) { if (wr == 0) PG8_BAR; }
        if constexpr (!Epi::AFTER_DRAIN) { E(acc, cur, wr, wc, fr, fq); S.done(cur); }
        if (!has_next) break;
#pragma unroll
        for (int a = 0; a < 2; ++a)
#pragma unroll
            for (int b = 0; b < 2; ++b)
#pragma unroll
                for (int m = 0; m < MQ; ++m)
#pragma unroll
                    for (int n = 0; n < 2; ++n) acc[a][b][m][n] = (f32x4){0.f, 0.f, 0.f, 0.f};
        cur = nxt; cA = nA; cB = nB; ++ui;
        if constexpr (ALIGN_EPI) { if (wr == 1) PG8_BAR; }
    }
    PG8_WAIT_V(0);
    if constexpr (!ALIGN_EPI) { if (wr == 0) PG8_BAR; }
    PG8_BAR;
    if constexpr (Epi::AFTER_DRAIN) { E.fused(acc, cur, wr, wc, fr, fq, lds, wid, lane); S.done(cur); }
#undef PG8_SA
#undef PG8_SB
#undef PG8_STAGE
#undef PG8_LDA
#undef PG8_LDB
#undef PG8_MMA
#undef PG8_WAIT_V
#undef PG8_WAIT_V8
#undef PG8_STAGE_A
#undef PG8_WAIT_L
#undef PG8_BAR
#undef PG8_SCHED
}
}

#ifndef PG8_SP2
#define PG8_SP2 true
#endif
#ifndef PG8_ALIGN
#define PG8_ALIGN true
#endif
#ifndef MK_ONE_LAUNCH
#define MK_ONE_LAUNCH 1
#endif

constexpr int NWAVES = 8;
constexpr int DM = 4096, SEQ = 2048, NB = 4, DB = 128, DS = 8, MP = NB * SEQ, MS = DB * DS, M = MP + MS;
constexpr int DFF = 11008, NGRP = 256, NST = 64, NCH = 16, PBUF = 15;
constexpr float RMS_EPS = 1e-6f;
constexpr int N_PHASES = 10;
constexpr size_t O_YP = 0, O_YS = (size_t)MP * DM, O_SRP = O_YS + (size_t)MS * DM, O_SIP = O_SRP + (size_t)NB * NGRP * NST, O_PP = O_SIP + (size_t)NB * NGRP * NST,
                 O_SRS = O_PP + (size_t)NB * PBUF * DM, O_SIS = O_SRS + (size_t)DB * NGRP * NST, O_PS = O_SIS + (size_t)DB * NGRP * NST, O_END = O_PS + (size_t)DB * PBUF * DM;
constexpr size_t MiB = 1u << 20;
constexpr size_t WS_CTL = 0, CTL_ZERO_BYTES = 1 * MiB;
constexpr size_t WS_WGLU = 16 * MiB, WS_WGU0 = 80 * MiB, WS_WGU1 = 252 * MiB, WS_WDN0 = 424 * MiB, WS_WDN1 = 510 * MiB, WS_WPOOL = 596 * MiB;
constexpr size_t WS_XRES = 608 * MiB, WS_HA = 752 * MiB, WS_YSSM = 824 * MiB, WS_PPOOL = 896 * MiB, WS_HID = 968 * MiB, WS_SSMP = 1164 * MiB, WS_RSTD = 1169 * MiB, WS_END = 1170 * MiB;
static_assert(WS_WGLU + (size_t)2 * DM * DM * 2 <= WS_WGU0 && WS_WGU0 + (size_t)2 * DFF * DM * 2 <= WS_WGU1 && WS_WGU1 + (size_t)2 * DFF * DM * 2 <= WS_WDN0 && WS_WDN0 + (size_t)DM * DFF * 2 <= WS_WDN1 &&
              WS_WDN1 + (size_t)DM * DFF * 2 <= WS_WPOOL && WS_WPOOL + (size_t)4 * 1024 * 1024 * 2 <= WS_XRES && WS_XRES + (size_t)M * DM * 4 <= WS_HA && WS_HA + (size_t)M * DM * 2 <= WS_YSSM &&
              WS_YSSM + (size_t)M * DM * 2 <= WS_PPOOL && WS_PPOOL + (size_t)M * DM * 2 <= WS_HID && WS_HID + (size_t)M * DFF * 2 <= WS_SSMP, "d_ws map");
constexpr size_t SPB_AR = 0, SPB_AI = 65536, SPB_BF = 131072, SPB_CF = 131072 + 1048576;
constexpr int CW_BAR = 4096;
constexpr int CW_SPLIT = 65536;
constexpr int CW_SSQ = 16384;
constexpr int RING_OFF = 0, RING_BYTES = 131072;
constexpr int LDSCTL_OFF = RING_BYTES, MISC_OFF = LDSCTL_OFF + 320;
constexpr int LDS_BYTES = 147456;
static_assert(MISC_OFF + 128 <= LDS_BYTES, "LDS map");

#define GAS __attribute__((address_space(1)))
#define LAS __attribute__((address_space(3)))
typedef unsigned short bf16;
typedef unsigned v4u __attribute__((ext_vector_type(4)));
typedef float f32x4 __attribute__((ext_vector_type(4)));
typedef short bf16x8 __attribute__((ext_vector_type(8)));
typedef GAS unsigned gu32;
typedef GAS unsigned long long gu64;
#define RLX_AGENT __ATOMIC_RELAXED, __HIP_MEMORY_SCOPE_AGENT
#define LDS_WAIT() asm volatile("s_waitcnt lgkmcnt(0)" ::: "memory")
#define VM_WAIT() asm volatile("s_waitcnt vmcnt(0)" ::: "memory")
__device__ __forceinline__ unsigned long long rt() { return __builtin_amdgcn_s_memrealtime(); }
__device__ __forceinline__ unsigned f2bf(float f) { unsigned u = __builtin_bit_cast(unsigned, f); return (u + 0x7fffu + ((u >> 16) & 1u)) >> 16; }
__device__ __forceinline__ unsigned pk2(float lo, float hi) { return f2bf(lo) | (f2bf(hi) << 16); }

#define XB_TMO      128
#define XB_XCNT(j)  (256  + 64 * (j))
#define XB_XSUB(j)  (1280 + 64 * (j))
#define XB_XGEN(j)  (2304 + 64 * (j))
#define XB_TOP      3328
#define XB_TOPGEN   3392
#define XCD_BAR_WORDS 3456
#define XB_SPIN_CAP (1u << 18)

__device__ __forceinline__ unsigned xb_ld(unsigned* p)              { return __hip_atomic_load(p, __ATOMIC_RELAXED, __HIP_MEMORY_SCOPE_AGENT); }
__device__ __forceinline__ unsigned xb_add(unsigned* p, unsigned v) { return __hip_atomic_fetch_add(p, v, __ATOMIC_RELAXED, __HIP_MEMORY_SCOPE_AGENT); }
__device__ __forceinline__ unsigned xb_xcc_id() { return (unsigned)__builtin_amdgcn_s_getreg((3 << 11) | 20) & 0xFu; }
#define XB_SPIN(cond, bar) do { unsigned _sp = 0; while (cond) { __builtin_amdgcn_s_sleep(1); \
    if ((++_sp & 255u) == 0u) { if (xb_ld(&(bar)[XB_TMO])) break; if (_sp > XB_SPIN_CAP) { atomicAdd(&(bar)[XB_TMO], 1u); break; } } } } while (0)

struct XcdBarrier {
    unsigned* bar; unsigned x;
    volatile LAS unsigned* st;
};

__device__ __forceinline__ XcdBarrier xcd_barrier_post(unsigned* bar, volatile LAS unsigned* st) {
    XcdBarrier b; b.bar = bar; b.x = xb_xcc_id(); b.st = st;
    if (threadIdx.x == 0) (void)xb_add(&bar[XB_XCNT(b.x)], 1u);
    return b;
}
__device__ __forceinline__ void xcd_barrier_complete(unsigned* bar, unsigned x, unsigned& nloc, unsigned& nx) {
    const unsigned G = gridDim.x * gridDim.y * gridDim.z;
    unsigned sum, cnt, mine, sp = 0u;
    for (;;) {
        sum = 0u; cnt = 0u; mine = 0u;
#pragma unroll
        for (unsigned j = 0; j < 16; ++j) { const unsigned c = xb_ld(&bar[XB_XCNT(j)]); sum += c; cnt += (c > 0u) ? 1u : 0u; mine = (j == x) ? c : mine; }
        if (sum == G) break;
        __builtin_amdgcn_s_sleep(1);
        if ((++sp & 255u) == 0u) { if (xb_ld(&bar[XB_TMO])) break; if (sp > XB_SPIN_CAP) { atomicAdd(&bar[XB_TMO], 1u); break; } }
    }
    nloc = mine > 0u ? mine : 1u; nx = cnt > 0u ? cnt : 1u;
}

__device__ __forceinline__ void xcd_barrier(const XcdBarrier& b) {
    asm volatile("s_waitcnt vmcnt(0)" ::: "memory");
    __syncthreads();
    if (threadIdx.x == 0) {
        unsigned* bar = b.bar;
        __builtin_amdgcn_s_waitcnt(0);
        unsigned nloc = b.st[0], nx = b.st[1];
        if (nloc == 0u) { xcd_barrier_complete(bar, b.x, nloc, nx); b.st[0] = nloc; b.st[1] = nx; }
        const unsigned old = xb_add(&bar[XB_XSUB(b.x)], 1u);
        const unsigned gen = old / nloc;
        if (old + 1u == (gen + 1u) * nloc) {
            __builtin_amdgcn_fence(__ATOMIC_RELEASE, "agent");
            asm volatile("s_waitcnt vmcnt(0)" ::: "memory");
            const unsigned og = xb_add(&bar[XB_TOP], 1u);
            const unsigned tg = og / nx;
            if (og + 1u == (tg + 1u) * nx) xb_add(&bar[XB_TOPGEN], 1u);
            else XB_SPIN(xb_ld(&bar[XB_TOPGEN]) == tg, bar);
            __builtin_amdgcn_fence(__ATOMIC_ACQUIRE, "agent");
            xb_add(&bar[XB_XGEN(b.x)], 1u);
            asm volatile("s_waitcnt vmcnt(0)" ::: "memory");
        } else {
            XB_SPIN(xb_ld(&bar[XB_XGEN(b.x)]) == gen, bar);
            __builtin_amdgcn_fence(__ATOMIC_ACQUIRE, "agent");
            asm volatile("s_waitcnt vmcnt(0)" ::: "memory");
        }
    }
    __syncthreads();
}

struct Frame {
    LAS unsigned char* lds;
    volatile LAS unsigned* MISC;
    gu32* ctl;
    int tid, lane, wave;
    int vcu, G;
    const float* in[21];
    float* out;
    unsigned char* ws;
};
enum { I_XP = 0, I_XS, I_SRE, I_SIM, I_SPOOL, I_NMIX, I_NFFN, I_LRE, I_LIM, I_LSTEP, I_BRE, I_BIM, I_CRE, I_CIM, I_SD, I_WGLU, I_WPOOL, I_PSCALE, I_WGU, I_WDN, I_NFIN };

__device__ __forceinline__ float wave_sum(float v) {
#pragma unroll
    for (int o = 1; o < 64; o <<= 1) v += __shfl_xor(v, o);
    return v;
}
typedef float f32x2_t __attribute__((ext_vector_type(2)));
typedef __bf16 b16x2_t __attribute__((ext_vector_type(2)));
typedef float f32x16 __attribute__((ext_vector_type(16)));
__device__ __forceinline__ unsigned cvtpk(float lo, float hi) { return __builtin_bit_cast(unsigned, __builtin_convertvector((f32x2_t){lo, hi}, b16x2_t)); }
__device__ __forceinline__ const float* xrow_in(const Frame& F, int r) { return r < MP ? F.in[I_XP] + (size_t)r * DM : F.in[I_XS] + (size_t)(r - MP) * DM; }

__device__ __forceinline__ void tr_item(const float* W, int K, int N, bf16* WT, int k0, int n0, int drow0, int lane, const float* kgain = nullptr) {
    const int kq = lane >> 3, nq = lane & 7;
    f32x4 v[2][8];
#pragma unroll
    for (int h = 0; h < 2; ++h)
#pragma unroll
        for (int i = 0; i < 8; ++i) v[h][i] = *(const GAS f32x4*)(W + (size_t)(k0 + 8 * kq + i) * N + n0 + 32 * h + 4 * nq);
    if (kgain) {
        const f32x4 g0 = *(const GAS f32x4*)(kgain + k0 + 8 * kq), g1 = *(const GAS f32x4*)(kgain + k0 + 8 * kq + 4);
#pragma unroll
        for (int h = 0; h < 2; ++h)
#pragma unroll
            for (int i = 0; i < 8; ++i) v[h][i] = v[h][i] * (i < 4 ? g0[i & 3] : g1[i & 3]);
    }
#pragma unroll
    for (int h = 0; h < 2; ++h)
#pragma unroll
        for (int j = 0; j < 4; ++j) { v4u o; o.x = cvtpk(v[h][0][j], v[h][1][j]); o.y = cvtpk(v[h][2][j], v[h][3][j]); o.z = cvtpk(v[h][4][j], v[h][5][j]); o.w = cvtpk(v[h][6][j], v[h][7][j]);
            *(GAS v4u*)(WT + (size_t)(drow0 + 32 * h + 4 * nq + j) * K + k0 + 8 * kq) = o; }
}
__device__ __forceinline__ int drow_pair(int n0, int NH) { const int half = n0 >= NH ? 1 : 0, nn = n0 - half * NH; return 256 * (nn >> 7) + 128 * half + (nn & 127); }

__device__ __forceinline__ double exp_d(double x) {
    const double k = __builtin_rint(x * 1.4426950408889634074); const double r = x - k * 0.69314718055994530942;
    double s = 1.0, t = 1.0;
#pragma unroll
    for (int i = 1; i <= 16; ++i) { t *= r * (1.0 / (double)i); s += t; }
    const long long e = (long long)k + 1023; return s * __builtin_bit_cast(double, (unsigned long long)e << 52);
}
__device__ __forceinline__ void sincos_d(double th, double& sn, double& cs) {
    const double n = __builtin_rint(th * 0.15915494309189533577); const double r = (th - n * 6.283185307179586232) - n * 2.4492935982947064e-16; const double r2 = r * r;
    double s = r, c = 1.0, ts = r, tc = 1.0;
#pragma unroll
    for (int i = 1; i <= 15; ++i) { tc *= r2 * (-1.0 / (double)((2 * i - 1) * (2 * i))); ts *= r2 * (-1.0 / (double)((2 * i) * (2 * i + 1))); c += tc; s += ts; }
    sn = s; cs = c;
}

constexpr int CI_GLU = (DM / 64) * (2 * DM / 64), CI_GU = (DM / 64) * (2 * DFF / 64), CI_DN = (DFF / 64) * (DM / 64), CI_PL = 4 * 16 * 16;
constexpr int CI_L0 = CI_GLU + CI_GU + CI_DN, CI_ALL = CI_L0 + CI_GU + CI_DN + CI_PL;
__device__ __forceinline__ void convert_weights(Frame& F, int lo, int hi, int first, int step) {
    LAS unsigned* ctr = (LAS unsigned*)(F.lds + MISC_OFF + 80);
    for (;;) {
        unsigned k = 0; if (F.lane == 0) k = __hip_atomic_fetch_add(ctr, 1u, __ATOMIC_RELAXED, __HIP_MEMORY_SCOPE_WORKGROUP);
        k = (unsigned)__builtin_amdgcn_readfirstlane((int)k);
        const long itl = (long)lo + first + (long)step * k; if (itl >= hi) break;
        int r = (int)itl;
        if (r < CI_GLU) { const int nb = r % (2 * DM / 64), kb = r / (2 * DM / 64); tr_item(F.in[I_WGLU], DM, 2 * DM, (bf16*)(F.ws + WS_WGLU), kb * 64, nb * 64, drow_pair(nb * 64, DM), F.lane); continue; } r -= CI_GLU;
        if (r >= 2 * CI_GU + CI_DN && r < 2 * CI_GU + CI_DN + CI_PL) { r -= 2 * CI_GU + CI_DN; const int g = r / 256; r -= g * 256; const int nb = r % 16, kb = r / 16;
            tr_item(F.in[I_WPOOL] + (size_t)g * 1024 * 1024, 1024, 1024, (bf16*)(F.ws + WS_WPOOL) + (size_t)g * 1024 * 1024, kb * 64, nb * 64, nb * 64, F.lane); continue; }
        int l, isdn;
        if (r < CI_GU) { l = 0; isdn = 0; } else if (r < CI_GU + CI_DN) { r -= CI_GU; l = 0; isdn = 1; } else if (r < 2 * CI_GU + CI_DN) { r -= CI_GU + CI_DN; l = 1; isdn = 0; } else { r -= 2 * CI_GU + CI_DN + CI_PL; l = 1; isdn = 1; }
        if (!isdn) { const int nb = r % (2 * DFF / 64), kb = r / (2 * DFF / 64);
            tr_item(F.in[I_WGU] + (size_t)l * DM * 2 * DFF, DM, 2 * DFF, (bf16*)(F.ws + (l ? WS_WGU1 : WS_WGU0)), kb * 64, nb * 64, drow_pair(nb * 64, DFF), F.lane, F.in[I_NFFN] + l * DM); continue; }
        { const int nb = r % (DM / 64), kb = r / (DM / 64);
            tr_item(F.in[I_WDN] + (size_t)l * DFF * DM, DFF, DM, (bf16*)(F.ws + (l ? WS_WDN1 : WS_WDN0)), kb * 64, nb * 64, nb * 64, F.lane); }
    }
}
__device__ __forceinline__ void convert_reset(Frame& F) { __syncthreads(); if (F.tid == 0) *(LAS unsigned*)(F.lds + MISC_OFF + 80) = 0u; __syncthreads(); }
__device__ __forceinline__ void p0_prologue(Frame& F) {
    const int gw = F.vcu * NWAVES + F.wave, NGW = F.G * NWAVES;
    float* rstd0 = (float*)(F.ws + WS_RSTD);
    for (int r = gw; r < M; r += NGW) { const GAS f32x4* xr = (const GAS f32x4*)xrow_in(F, r) + F.lane; float s = 0.f;
#pragma unroll
        for (int j = 0; j < 16; ++j) { const f32x4 v = xr[64 * j]; s += (v.x * v.x + v.y * v.y) + (v.z * v.z + v.w * v.w); }
        s = wave_sum(s); if (F.lane == 0) rstd0[r] = 1.0f / sqrtf(s * (1.0f / DM) + RMS_EPS); }
    unsigned char* spb = F.ws + WS_SSMP;
    for (int idx = F.vcu * (NWAVES * 64) + F.tid; idx < NGRP * NST; idx += F.G * NWAVES * 64) {
        const int g = idx >> 6, p = idx & 63, ti = p >> 5, sl = p & 31;
        const double lr = (double)F.in[I_LRE][idx], li = (double)F.in[I_LIM][idx], dt = exp_d((double)F.in[I_LSTEP][g]);
        const double mag = exp_d(lr * dt); double sn, cs; sincos_d(li * dt, sn, cs);
        const double ar = mag * cs, ai = mag * sn, den = lr * lr + li * li;
        const double fr = ((ar - 1.0) * lr + ai * li) / den, fi = (ai * lr - (ar - 1.0) * li) / den;
        ((float*)(spb + SPB_AR))[idx] = (float)ar; ((float*)(spb + SPB_AI))[idx] = (float)ai;
#pragma unroll
        for (int hl = 0; hl < 2; ++hl) { float re[8], im[8];
#pragma unroll
            for (int c4 = 0; c4 < 2; ++c4) { const f32x4 br = *(const GAS f32x4*)(F.in[I_BRE] + (size_t)idx * 16 + 8 * hl + 4 * c4), bi = *(const GAS f32x4*)(F.in[I_BIM] + (size_t)idx * 16 + 8 * hl + 4 * c4);
                const f32x4 gn = *(const GAS f32x4*)(F.in[I_NMIX] + g * 16 + 8 * hl + 4 * c4);
#pragma unroll
                for (int j = 0; j < 4; ++j) { re[4 * c4 + j] = (float)((fr * (double)br[j] - fi * (double)bi[j]) * (double)gn[j]); im[4 * c4 + j] = (float)((fr * (double)bi[j] + fi * (double)br[j]) * (double)gn[j]); } }
            const int ln = 32 * hl + sl; v4u o;
            o.x = cvtpk(re[0], re[1]); o.y = cvtpk(re[2], re[3]); o.z = cvtpk(re[4], re[5]); o.w = cvtpk(re[6], re[7]);
            *(GAS v4u*)(spb + SPB_BF + ((size_t)(((g * 2 + ti) * 2 + 0) * 64 + ln)) * 16) = o;
            o.x = cvtpk(im[0], im[1]); o.y = cvtpk(im[2], im[3]); o.z = cvtpk(im[4], im[5]); o.w = cvtpk(im[6], im[7]);
            *(GAS v4u*)(spb + SPB_BF + ((size_t)(((g * 2 + ti) * 2 + 1) * 64 + ln)) * 16) = o; }
    }
    for (int idx = F.vcu * (NWAVES * 64) + F.tid; idx < NGRP * 4 * 64; idx += F.G * NWAVES * 64) {
        const int g = idx >> 8, ks = (idx >> 6) & 3, ln = idx & 63, q = ln >> 4, c = ln & 15, p0 = 16 * ks + 4 * q;
        const f32x4 cr = *(const GAS f32x4*)(F.in[I_CRE] + ((size_t)g * 16 + c) * NST + p0), ci = *(const GAS f32x4*)(F.in[I_CIM] + ((size_t)g * 16 + c) * NST + p0);
        v4u o; o.x = cvtpk(cr[0], -ci[0]); o.y = cvtpk(cr[1], -ci[1]); o.z = cvtpk(cr[2], -ci[2]); o.w = cvtpk(cr[3], -ci[3]);
        *(GAS v4u*)(spb + SPB_CF + (size_t)idx * 16) = o;
    }
}

__device__ __forceinline__ float gelu_tanh(float x) { const float z = 0.7978845608028654f * (x + 0.044715f * x * x * x); return x * __builtin_amdgcn_rcpf(1.0f + __expf(-2.0f * z)); }
template <bool SAMPLE>
__device__ __forceinline__ void ssm_run(Frame& F, int g, int sel) {
    const int lane = F.lane, hl = lane >> 5, sl = lane & 31, q = lane >> 4, cl = lane & 15;
    const unsigned char* spb = F.ws + WS_SSMP; const float* rstd0 = (const float*)(F.ws + WS_RSTD);
    bf16x8 bfr[2][2], cfr[4];
#pragma unroll
    for (int ti = 0; ti < 2; ++ti)
#pragma unroll
        for (int part = 0; part < 2; ++part) bfr[ti][part] = *(const GAS bf16x8*)(spb + SPB_BF + ((size_t)(((g * 2 + ti) * 2 + part) * 64 + lane)) * 16);
#pragma unroll
    for (int ks = 0; ks < 4; ++ks) cfr[ks] = *(const GAS bf16x8*)(spb + SPB_CF + ((size_t)((g * 4 + ks) * 64 + lane)) * 16);
    float ar[2], ai[2];
#pragma unroll
    for (int ti = 0; ti < 2; ++ti) { ar[ti] = ((const float*)(spb + SPB_AR))[g * NST + 32 * ti + sl]; ai[ti] = ((const float*)(spb + SPB_AI))[g * NST + 32 * ti + sl]; }
    const f32x4 dg = *(const GAS f32x4*)(F.in[I_SD] + g * 16 + 4 * q) * *(const GAS f32x4*)(F.in[I_NMIX] + g * 16 + 4 * q);
    const int hA = (sl >> 2) & 1, rA = (sl & 3) + 4 * (sl >> 3);
    const int hE = (cl >> 2) & 1, rE = (cl & 3) + 4 * (cl >> 3);
    LAS unsigned char* xl = F.lds + RING_OFF + F.wave * 8704;
    LAS unsigned* xw = (LAS unsigned*)(xl + hl * (4 * 272) + sl * 4);
    const LAS unsigned char* xrd = xl + cl * 272 + q * 16;
    int rowA, rowE[2], nch; float xr[2], xi[2], xr2[2], xi2[2]; float *o1r, *o1i, *o2r = nullptr, *o2i = nullptr;
    if constexpr (SAMPLE) { const int b0 = 4 * sel; nch = 1;
        rowA = MP + (b0 + 2 * hA + (rA >> 3)) * DS + (rA & 7); rowE[0] = MP + (b0 + 2 * hE) * DS + rE; rowE[1] = MP + (b0 + 2 * hE + 1) * DS + rE;
        const size_t s1 = ((size_t)(b0 + 2 * hl) * NGRP + g) * NST + sl, s2 = s1 + (size_t)NGRP * NST;
#pragma unroll
        for (int ti = 0; ti < 2; ++ti) { xr[ti] = F.in[I_SRE][s1 + 32 * ti]; xi[ti] = F.in[I_SIM][s1 + 32 * ti]; xr2[ti] = F.in[I_SRE][s2 + 32 * ti]; xi2[ti] = F.in[I_SIM][s2 + 32 * ti]; }
        o1r = F.out + O_SRS + s1; o1i = F.out + O_SIS + s1; o2r = F.out + O_SRS + s2; o2i = F.out + O_SIS + s2;
    } else { const int seq0 = 2 * sel; nch = SEQ / 16;
        rowA = (seq0 + hA) * SEQ + rA; rowE[0] = (seq0 + hE) * SEQ + rE; rowE[1] = rowE[0] + 8;
#pragma unroll
        for (int ti = 0; ti < 2; ++ti) { xr[ti] = 0.f; xi[ti] = 0.f; xr2[ti] = 0.f; xi2[ti] = 0.f; }
        const size_t s1 = ((size_t)(seq0 + hl) * NGRP + g) * NST + sl; o1r = F.out + O_SRP + s1; o1i = F.out + O_SIP + s1;
    }
    f32x16 zero16;
#pragma unroll
    for (int i = 0; i < 16; ++i) zero16[i] = 0.f;
    f32x4 nx0, nx1, nxe[2]; float nrs, nre[2];
    { const float* xp = xrow_in(F, rowA) + g * 16 + 8 * hl; nx0 = *(const GAS f32x4*)xp; nx1 = *(const GAS f32x4*)(xp + 4); nrs = rstd0[rowA];
#pragma unroll
      for (int rt = 0; rt < 2; ++rt) { nxe[rt] = *(const GAS f32x4*)(xrow_in(F, rowE[rt]) + g * 16 + 4 * q); nre[rt] = rstd0[rowE[rt]]; } }
    for (int ch = 0; ch < nch; ++ch) {
        const f32x4 x0 = nx0, x1 = nx1; const float rs = nrs;
        f32x4 xe[2]; float re[2];
#pragma unroll
        for (int rt = 0; rt < 2; ++rt) { xe[rt] = nxe[rt]; re[rt] = nre[rt]; }
        if (ch + 1 < nch) { const int ra = rowA + 16 * (ch + 1); const float* xp = xrow_in(F, ra) + g * 16 + 8 * hl; nx0 = *(const GAS f32x4*)xp; nx1 = *(const GAS f32x4*)(xp + 4); nrs = rstd0[ra];
#pragma unroll
            for (int rt = 0; rt < 2; ++rt) { const int r = rowE[rt] + 16 * (ch + 1); nxe[rt] = *(const GAS f32x4*)(xrow_in(F, r) + g * 16 + 4 * q); nre[rt] = rstd0[r]; } }
        v4u au; au.x = cvtpk(x0[0] * rs, x0[1] * rs); au.y = cvtpk(x0[2] * rs, x0[3] * rs); au.z = cvtpk(x1[0] * rs, x1[1] * rs); au.w = cvtpk(x1[2] * rs, x1[3] * rs);
        const bf16x8 afr = __builtin_bit_cast(bf16x8, au);
#pragma unroll
        for (int ti = 0; ti < 2; ++ti) {
            f32x16 dr = __builtin_amdgcn_mfma_f32_32x32x16_bf16(afr, bfr[ti][0], zero16, 0, 0, 0);
            f32x16 di = __builtin_amdgcn_mfma_f32_32x32x16_bf16(afr, bfr[ti][1], zero16, 0, 0, 0);
            float sr = xr[ti], si = xi[ti];
#pragma unroll
            for (int r = 0; r < 16; ++r) {
                if (SAMPLE && r == 8) { o1r[32 * ti] = sr; o1i[32 * ti] = si; sr = xr2[ti]; si = xi2[ti]; }
                const float nr = fmaf(-ai[ti], si, fmaf(ar[ti], sr, dr[r])), ni = fmaf(ai[ti], sr, fmaf(ar[ti], si, di[r])); sr = nr; si = ni;
                xw[(((r & 3) + 8 * (r >> 2)) * 272 + ti * 128) / 4] = cvtpk(sr, si);
            }
            xr[ti] = sr; xi[ti] = si;
        }
        asm volatile("s_waitcnt lgkmcnt(0)" ::: "memory"); __builtin_amdgcn_sched_barrier(0);
        f32x4 y[2];
#pragma unroll
        for (int rt = 0; rt < 2; ++rt) { y[rt] = (f32x4){0.f, 0.f, 0.f, 0.f};
#pragma unroll
            for (int ks = 0; ks < 4; ++ks) { const bf16x8 xf = *(const LAS bf16x8*)(xrd + rt * (16 * 272) + ks * 64); y[rt] = __builtin_amdgcn_mfma_f32_16x16x32_bf16(cfr[ks], xf, y[rt], 0, 0, 0); } }
        asm volatile("s_waitcnt lgkmcnt(0)" ::: "memory"); __builtin_amdgcn_sched_barrier(0);
#pragma unroll
        for (int rt = 0; rt < 2; ++rt) { const int r = rowE[rt] + 16 * ch; f32x4 v;
#pragma unroll
            for (int j = 0; j < 4; ++j) v[j] = gelu_tanh(y[rt][j] + dg[j] * (xe[rt][j] * re[rt]));
            *(GAS unsigned long long*)((bf16*)(F.ws + WS_YSSM) + (size_t)r * DM + g * 16 + 4 * q) = (unsigned long long)cvtpk(v[0], v[1]) | ((unsigned long long)cvtpk(v[2], v[3]) << 32); }
    }
    if constexpr (SAMPLE) {
#pragma unroll
        for (int ti = 0; ti < 2; ++ti) { o2r[32 * ti] = xr[ti]; o2i[32 * ti] = xi[ti]; }
    } else {
#pragma unroll
        for (int ti = 0; ti < 2; ++ti) { o1r[32 * ti] = xr[ti]; o1i[32 * ti] = xi[ti]; }
    }
}
__device__ __forceinline__ void p1_ssm(Frame& F) {
    if (F.wave < 2) {
        for (int task = F.vcu * 2 + F.wave; task < 2 * NGRP; task += F.G * 2) ssm_run<false>(F, task & 255, task >> 8);
    } else {
        for (int task = F.vcu * 6 + (F.wave - 2); task < 32 * NGRP; task += F.G * 6) ssm_run<true>(F, task & 255, task >> 8);
    }
    convert_weights(F, 0, F.G == 256 ? CI_GLU + CI_GU : CI_L0, F.vcu, F.G);
}

__device__ __forceinline__ void final_norm(Frame& F, const float* gain, const float* ssq, float* dst) {
    const float* X = (const float*)(F.ws + WS_XRES); const size_t NT = (size_t)F.G * NWAVES * 64, TOT = (size_t)M * (DM / 4);
    for (size_t base = (size_t)F.vcu * NWAVES * 64 + F.tid; base < TOT; base += 8 * NT) {
        f32x4 xv[8]; float sv[8];
#pragma unroll
        for (int u = 0; u < 8; ++u) { const size_t idx = base + u * NT; if (idx < TOT) { const int r = (int)(idx >> 10), c = 4 * (int)(idx & 1023); xv[u] = *(const GAS f32x4*)(X + (size_t)r * DM + c); sv[u] = ssq[r]; } }
#pragma unroll
        for (int u = 0; u < 8; ++u) { const size_t idx = base + u * NT; if (idx < TOT) { const int r = (int)(idx >> 10), c = 4 * (int)(idx & 1023);
            *(GAS f32x4*)(dst + (size_t)r * DM + c) = xv[u] * __builtin_amdgcn_rsqf(sv[u] * (1.0f / DM) + RMS_EPS) * *(const GAS f32x4*)(gain + c); } }
    }
}
template <int GI, int R, bool PROMPT> __device__ __forceinline__ void pool_elem_g(Frame& F) {
    constexpr int W = 2 << GI, NH = R + W - 1, RBASE = PROMPT ? 0 : MP, NROWS = PROMPT ? MP : MS;
    const float* X = (const float*)(F.ws + WS_XRES); const float* ssq1 = (const float*)(F.ctl + CW_SSQ) + M; const float* gain = F.in[I_NMIX] + DM;
    bf16* PP = (bf16*)(F.ws + WS_PPOOL);
    const size_t NT = (size_t)F.G * NWAVES * 64;
    static_assert(PROMPT || R == DS, "a sample sequence is exactly one strip");
    for (size_t idx = (size_t)F.vcu * NWAVES * 64 + F.tid; idx < (size_t)(NROWS / R) * 256; idx += NT) {
        const int r0 = RBASE + (int)(idx >> 8) * R, q = (int)(idx & 255), c = GI * 1024 + 4 * q;
        const f32x4 gv = *(const GAS f32x4*)(gain + c);
        constexpr bool prompt = PROMPT; const int t0 = prompt ? (r0 & (SEQ - 1)) : 0; const int b = (r0 - MP) >> 3;
        f32x4 hv[NH]; float sq[NH];
#pragma unroll
        for (int k = 0; k < NH; ++k) { const int d = k - (W - 1), tt = t0 + d; const bool inseq = tt >= 0;
            const float* src = inseq ? X + (size_t)(r0 + d) * DM + c : (prompt ? X + (size_t)r0 * DM + c : F.in[I_SPOOL] + ((size_t)b * PBUF + (PBUF + tt)) * DM + c);
            hv[k] = *(const GAS f32x4*)src; sq[k] = ssq1[inseq ? r0 + d : r0]; }
#pragma unroll
        for (int k = 0; k < NH; ++k) { const bool inseq = (t0 + k - (W - 1)) >= 0; const float rs = __builtin_amdgcn_rsqf(sq[k] * (1.0f / DM) + RMS_EPS);
            hv[k] = hv[k] * (inseq ? gv * rs : (prompt ? (f32x4){0.f, 0.f, 0.f, 0.f} : (f32x4){1.f, 1.f, 1.f, 1.f})); }
#pragma unroll
        for (int i = 0; i < R; ++i) { const int r = r0 + i, t = t0 + i; const f32x4 h = hv[i + W - 1]; f32x4 s = h;
#pragma unroll
            for (int j = 1; j < W; ++j) s += hv[i + W - 1 - j];
            const float cnt = prompt ? (float)((t + 1) < W ? (t + 1) : W) : (float)W;
            const f32x4 p = s / cnt - h;
            *(GAS unsigned long long*)(PP + ((size_t)GI * M + r) * 1024 + 4 * q) = (unsigned long long)cvtpk(p.x, p.y) | ((unsigned long long)cvtpk(p.z, p.w) << 32);
            if (prompt) { if (t >= SEQ - PBUF) *(GAS f32x4*)(F.out + O_PP + ((size_t)(r >> 11) * PBUF + (t - (SEQ - PBUF))) * DM + c) = h; }
            else { float* ob = F.out + O_PS + (size_t)b * PBUF * DM + c;
                *(GAS f32x4*)(ob + (size_t)(PBUF - DS + t) * DM) = h;
                if (t < PBUF - DS) *(GAS f32x4*)(ob + (size_t)t * DM) = *(const GAS f32x4*)(F.in[I_SPOOL] + ((size_t)b * PBUF + DS + t) * DM + c); } }
    }
}
__device__ __forceinline__ void pool_elem(Frame& F) { pool_elem_g<3, 8, true>(F); pool_elem_g<2, 16, true>(F); pool_elem_g<1, 16, true>(F); pool_elem_g<0, 16, true>(F);
    pool_elem_g<0, 8, false>(F); pool_elem_g<1, 8, false>(F); pool_elem_g<2, 8, false>(F); pool_elem_g<3, 8, false>(F); }

__device__ __forceinline__ void down_phase(Frame& F, const unsigned char* wdn, float* ssq_l, int layer) {
    unsigned char* ws = F.ws;
    if (F.G == 256) {
        { pg8::Gemm g{(const pg8::bf16_t*)(ws + WS_HID), (const pg8::bf16_t*)wdn, MP, DM, DFF, 0}; pg8::MallOrder S; S.init(MP, DM, F.G, (int)blockIdx.x, 256, 2);
          pg8::EpiResid<false> E{(float*)(ws + WS_XRES), nullptr, nullptr, ssq_l, 36};
          pg8::gemm_phase<pg8::EpiResid<false>, pg8::MallOrder, PG8_ALIGN, PG8_SP2>(F.lds + RING_OFF, g, S, E); }
        const int c = (int)blockIdx.x, part = c >> 6, unit = (c & 7) * 8 + ((c >> 3) & 7);
        const int kt0 = part == 0 ? 0 : part == 1 ? 36 : part == 2 ? 82 : 128, ntp = part == 0 ? 36 : part == 3 ? 44 : 46;
        pg8::Gemm g{(const pg8::bf16_t*)(ws + WS_HID) + kt0 * 64, (const pg8::bf16_t*)wdn + kt0 * 64, M, DM, DFF, ntp};
        unsigned* ctr = (unsigned*)(F.ctl + CW_SPLIT) + (layer * 64 + unit) * 16;
        pg8::EpiResidSplit E{(float*)(ws + WS_XRES), ssq_l, (float*)(ws + WS_YSSM) + (size_t)unit * 3 * 65536, ctr, part};
        pg8::SplitOrder S{c, 32};
        pg8::gemm_phase<pg8::EpiResidSplit, pg8::SplitOrder, PG8_ALIGN, PG8_SP2>(F.lds + RING_OFF, g, S, E);
        if (part != 0) { __syncthreads();
            if (F.tid == 0) { __builtin_amdgcn_fence(__ATOMIC_RELEASE, "agent"); asm volatile("s_waitcnt vmcnt(0)" ::: "memory"); (void)__hip_atomic_fetch_add(ctr, 1u, __ATOMIC_RELAXED, __HIP_MEMORY_SCOPE_AGENT); } }
    } else {
        pg8::Gemm g{(const pg8::bf16_t*)(ws + WS_HID), (const pg8::bf16_t*)wdn, M, DM, DFF, 0}; pg8::MallOrder S; S.init(M, DM, F.G, (int)blockIdx.x, 192, 2);
        pg8::EpiResid<false> E{(float*)(ws + WS_XRES), nullptr, nullptr, ssq_l, 36};
        pg8::gemm_phase<pg8::EpiResid<false>, pg8::MallOrder, PG8_ALIGN, PG8_SP2, 3>(F.lds + RING_OFF, g, S, E);
    }
}

struct Args { const float* in[21]; float* out; unsigned char* ws; int ph_lo, ph_hi; };
__global__ void __launch_bounds__(NWAVES * 64, 2) skel_fwd(Args args) {
    extern __shared__ __attribute__((aligned(16))) unsigned char lds[];
    Frame F;
    F.lds = (LAS unsigned char*)lds;
    F.MISC = (volatile LAS unsigned*)(F.lds + MISC_OFF);
    F.tid = threadIdx.x; F.lane = F.tid & 63; F.wave = __builtin_amdgcn_readfirstlane(F.tid >> 6);
    F.G = gridDim.x; { const int bx = blockIdx.x; F.vcu = (F.G % 8 == 0) ? (bx % 8) * (F.G / 8) + bx / 8 : bx; }
    unsigned char* ws = args.ws; F.ws = ws; F.out = args.out;
    F.ctl = (gu32*)(ws + WS_CTL);
#pragma unroll
    for (int i = 0; i < 21; ++i) F.in[i] = args.in[i];
    for (int u = F.tid; u < (LDS_BYTES - LDSCTL_OFF) / 4; u += NWAVES * 64) ((LAS unsigned*)(F.lds + LDSCTL_OFF))[u] = 0u;
    __syncthreads();
    const int lo = args.ph_lo, hi = args.ph_hi;
    const bool use_bar = (hi - lo) > 1;
    XcdBarrier bar; bar.bar = (unsigned*)(F.ctl + CW_BAR); bar.x = 0; bar.st = nullptr;
    if (use_bar) bar = xcd_barrier_post((unsigned*)(F.ctl + CW_BAR), F.MISC + 8);
#define IN(k) (lo <= (k) && (k) < hi)
#define SEAM(k) do { if (IN(k) && IN((k) + 1)) xcd_barrier(bar); } while (0)

    float* ssq = (float*)(F.ctl + CW_SSQ);
    if (IN(0)) { p0_prologue(F); SEAM(0); }
    if (IN(1)) { p1_ssm(F); SEAM(1); }
    if (IN(2)) {
        pg8::Gemm g{(const pg8::bf16_t*)(ws + WS_YSSM), (const pg8::bf16_t*)(ws + WS_WGLU), M, 2 * DM, DM}; pg8::MallOrder S; S.init(M, 2 * DM, F.G, (int)blockIdx.x, 256, 1);
        pg8::EpiGlu E{F.in[I_XP], F.in[I_XS], (float*)(ws + WS_XRES), (pg8::bf16_t*)(ws + WS_HA), ssq};
        pg8::gemm_phase<pg8::EpiGlu, pg8::MallOrder, PG8_ALIGN, PG8_SP2>(F.lds + RING_OFF, g, S, E);
        { constexpr int NIDLE = 256 - (36 * 32) % 256, QUOTA = 60; const int j = (int)blockIdx.x - (256 - NIDLE);
          if (F.G == 256 && j >= 0) { convert_reset(F); convert_weights(F, CI_GLU + CI_GU, CI_L0, j, NIDLE); } }
        SEAM(2);
    }
    if (IN(3)) {
        pg8::Gemm g{(const pg8::bf16_t*)(ws + WS_HA), (const pg8::bf16_t*)(ws + WS_WGU0), M, 2 * DFF, DM}; pg8::MallOrder S; S.init(M, 2 * DFF, F.G, (int)blockIdx.x, 256, 1);
        pg8::EpiSwiglu E{(pg8::bf16_t*)(ws + WS_HID), DFF, ssq};
        pg8::gemm_phase<pg8::EpiSwiglu, pg8::MallOrder, PG8_ALIGN, PG8_SP2>(F.lds + RING_OFF, g, S, E);
        { constexpr int NIDLE = 256 - (36 * 86) % 256, LO = CI_L0 + 128 * 60, HI = CI_ALL - CI_DN; const int j = (int)blockIdx.x - (256 - NIDLE);
          if (F.G == 256) { if (j >= 0) { convert_reset(F); convert_weights(F, CI_L0, HI, j, NIDLE); } }
          else { convert_reset(F); convert_weights(F, CI_L0, HI, F.vcu, F.G); } }
        SEAM(3);
    }
    if (IN(4)) { down_phase(F, ws + WS_WDN0, ssq + M, 0); SEAM(4); }
    if (IN(5)) { pool_elem(F); SEAM(5); }
    if (IN(6)) {
        pg8::Gemm g{(const pg8::bf16_t*)(ws + WS_PPOOL), (const pg8::bf16_t*)(ws + WS_WPOOL), 4 * M, 4096, 1024}; pg8::PoolOrder S{F.G, (int)blockIdx.x, 48};
        pg8::EpiResid<true> E{(float*)(ws + WS_XRES), F.in[I_PSCALE], (pg8::bf16_t*)(ws + WS_HA), ssq + 2 * M, 48};
        pg8::gemm_phase<pg8::EpiResid<true>, pg8::PoolOrder, PG8_ALIGN, PG8_SP2, 3>(F.lds + RING_OFF, g, S, E);
        SEAM(6);
    }
    if (IN(7)) {
        pg8::Gemm g{(const pg8::bf16_t*)(ws + WS_HA), (const pg8::bf16_t*)(ws + WS_WGU1), M, 2 * DFF, DM};
        pg8::EpiSwiglu E{(pg8::bf16_t*)(ws + WS_HID), DFF, ssq + 2 * M};
        constexpr int NU = 36 * 86, NT = NU % 256;
        if (F.G == 256) {
            pg8::MallOrder S; S.init(M, 2 * DFF, F.G, (int)blockIdx.x, 256, 1, NU / 256);
            pg8::gemm_phase<pg8::EpiSwiglu, pg8::MallOrder, PG8_ALIGN, PG8_SP2>(F.lds + RING_OFF, g, S, E);
            pg8::TailOrder T{S, NT, NU / 256};
            pg8::gemm_phase<pg8::EpiSwiglu, pg8::TailOrder, PG8_ALIGN, PG8_SP2, 2>(F.lds + RING_OFF, g, T, E);
            const int j = (int)blockIdx.x - 2 * NT;
            if (j >= 0) { convert_reset(F); convert_weights(F, CI_ALL - CI_DN, CI_ALL, j, 256 - 2 * NT); }
        } else {
            pg8::MallOrder S; S.init(M, 2 * DFF, F.G, (int)blockIdx.x, 256, 1);
            pg8::gemm_phase<pg8::EpiSwiglu, pg8::MallOrder, PG8_ALIGN, PG8_SP2>(F.lds + RING_OFF, g, S, E);
            convert_reset(F); convert_weights(F, CI_ALL - CI_DN, CI_ALL, F.vcu, F.G);
        }
        SEAM(7);
    }
    if (IN(8)) { down_phase(F, ws + WS_WDN1, ssq + 3 * M, 1); SEAM(8); }
    if (IN(9)) { final_norm(F, F.in[I_NFIN], ssq + 3 * M, F.out + O_YP); }
#undef IN
#undef SEAM
}

extern "C" void kernel_launch(void* const* d_in, const int* in_sizes, int n_in, void* d_out, int out_size, void* d_ws, size_t ws_size, hipStream_t stream) {
    static int grid = 0;
    if (grid == 0) {
        if (n_in != 21 || in_sizes[0] != MP * DM || (size_t)out_size != O_END || ws_size < WS_END) { fprintf(stderr, "kernel_launch: unexpected shapes (n_in %d, in0 %d, out %d, ws %zu); nothing launched\n", n_in, n_in > 0 ? in_sizes[0] : -1, out_size, ws_size); grid = -1; return; }
        int dev = 0, cus = 0, per_cu = 0;
        if (hipGetDevice(&dev) != hipSuccess || hipDeviceGetAttribute(&cus, hipDeviceAttributeMultiprocessorCount, dev) != hipSuccess) { grid = -1; return; }
        if (hipFuncSetAttribute((const void*)skel_fwd, hipFuncAttributeMaxDynamicSharedMemorySize, LDS_BYTES) != hipSuccess) { fprintf(stderr, "kernel_launch: hipFuncSetAttribute failed\n"); grid = -1; return; }
        if (hipOccupancyMaxActiveBlocksPerMultiprocessor(&per_cu, (const void*)skel_fwd, NWAVES * 64, LDS_BYTES) != hipSuccess || per_cu < 1) { fprintf(stderr, "kernel_launch: occupancy query says %d blocks per CU\n", per_cu); }
        (void)hipGetLastError();
        grid = cus;
    }
    if (grid < 0) return;
    if (hipMemsetAsync((char*)d_ws + WS_CTL, 0, CTL_ZERO_BYTES, stream) != hipSuccess) return;
    Args a{};
    for (int i = 0; i < 21; ++i) a.in[i] = (const float*)d_in[i];
    a.out = (float*)d_out; a.ws = (unsigned char*)d_ws;
#if MK_ONE_LAUNCH
    a.ph_lo = 0; a.ph_hi = N_PHASES;
    hipLaunchKernelGGL(skel_fwd, dim3(grid), dim3(NWAVES * 64), LDS_BYTES, stream, a);
#else
    for (int ph = 0; ph < N_PHASES; ++ph) { a.ph_lo = ph; a.ph_hi = ph + 1; hipLaunchKernelGGL(skel_fwd, dim3(grid), dim3(NWAVES * 64), LDS_BYTES, stream, a); }
#endif
}
```

```cpp
#include <hip/hip_runtime.h>
#include <cstdio>
#include <cstdint>
namespace pg8 {
#define PG8_LAS __attribute__((address_space(3)))
typedef unsigned short bf16_t;
typedef short bf16x8 __attribute__((ext_vector_type(8)));
typedef float f32x4 __attribute__((ext_vector_type(4)));
typedef unsigned u32x4 __attribute__((ext_vector_type(4)));
constexpr int BM = 256, BK = 64, HALF = 128, HTB = HALF * BK * 2  , STAGE_BYTES = 8 * HTB, NXCD = 8, WGM = 8;

__host__ __device__ __forceinline__ int lds_byte(int r, int c) { const int st = (r >> 4) * 2 + (c >> 5), rr = r & 15, cc = c & 31, ob = rr * 64 + cc * 2; return st * 1024 + (ob ^ (((ob >> 9) & 1) << 5)); }
__host__ __device__ __forceinline__ void stage_rc(int b, int& R, int& C) { const int st = b / 1024, sb = b % 1024, swz = sb ^ (((sb >> 9) & 1) << 5); R = (st >> 1) * 16 + swz / 64; C = (st & 1) * 32 + (swz % 64) / 2; }
__host__ __device__ __forceinline__ int perm32(int rho) { const int n = rho >> 4, i = rho & 15; return 8 * (i >> 2) + 4 * n + (i & 3); }

struct Unit { int pm, pn; };
struct Gemm { const bf16_t* A; const bf16_t* Bt; int M, N, K; int nt; };

struct StaticOrder {
    int nM, nN, nwg, G, c;
    __host__ __device__ void init(int M, int N, int G_, int c_, int bm = BM) { nM = M / bm; nN = N / BM; nwg = nM * nN; G = G_; c = c_; }
    __host__ __device__ bool next(int i, Unit& u) const {
        const long L = (long)i * G + c; if (L >= nwg) return false;
        int wgid = (int)L; { const int q = nwg / NXCD, r = nwg % NXCD, xcd = wgid % NXCD, off = wgid / NXCD; wgid = (xcd < r ? xcd * (q + 1) : r * (q + 1) + (xcd - r) * q) + off; }
        const int nig = WGM * nN, gid = wgid / nig, fm = gid * WGM, gsz = (nM - fm) < WGM ? (nM - fm) : WGM;
        u.pm = fm + ((wgid % nig) % gsz); u.pn = (wgid % nig) / gsz; return true;
    }
    __device__ __forceinline__ void a_ready(const Unit&) const {}
    __device__ __forceinline__ void done(const Unit&) const {}
};

struct MallOrder {
    int nM, nN, G, c, XR, maxr;
    __host__ __device__ void init(int M, int N, int G_, int c_, int bm, int XR_, int maxr_ = 1 << 20) { nM = M / bm; nN = N / BM; G = G_; c = c_; XR = XR_; maxr = maxr_; }
    __host__ __device__ bool next(int i, Unit& u) const {
        constexpr int CW = 32; if (i >= maxr) return false;
        const int XC = NXCD / XR, x = c % NXCD, xr = x / XC, xc = x % XC;
        int q = i * (G / NXCD) + c / NXCD;
        for (int ch = 0; ch * CW < nN; ++ch) {
            const int cw = (nN - ch * CW) < CW ? (nN - ch * CW) : CW;
            for (int g = 0; g * XR * 8 < nM; ++g) {
                const int fm = (g * XR + xr) * 8, left = nM - fm, gsz = left < 0 ? 0 : (left < 8 ? left : 8), perg = gsz * cw / XC;
                if (q < perg) { const int uu = xc * perg + q; u.pm = fm + uu % gsz; u.pn = ch * CW + uu / gsz; return true; }
                q -= perg;
            }
        }
        return false;
    }
    __device__ __forceinline__ void a_ready(const Unit&) const {}
    __device__ __forceinline__ void done(const Unit&) const {}
};

struct TailOrder {
    MallOrder base; int nt, round;
    __host__ __device__ bool next(int i, Unit& u) const {
        if (i != 0 || base.c >= 2 * nt) return false;
        MallOrder b = base; b.c = base.c % nt; b.maxr = 1 << 20; Unit v; if (!b.next(round, v)) return false;
        u.pm = 2 * v.pm + base.c / nt; u.pn = v.pn; return true;
    }
    __device__ __forceinline__ void a_ready(const Unit&) const {}
    __device__ __forceinline__ void done(const Unit&) const {}
};


__device__ __forceinline__ unsigned cvt_pk_bf16(float lo, float hi) { unsigned r; asm volatile("v_cvt_pk_bf16_f32 %0, %1, %2" : "=v"(r) : "v"(lo), "v"(hi)); return r; }
__device__ __forceinline__ float sigmoid_f(float x) { return __builtin_amdgcn_rcpf(1.0f + __expf(-x)); }

__device__ __forceinline__ void ssq_add(float* ssq, int row, float s, int fq) {
    s += __shfl_xor(s, 16); s += __shfl_xor(s, 32);
    if (fq == 0) unsafeAtomicAdd(ssq + row, s);
}
__device__ __forceinline__ float rstd_of(const float* ssq, int row) { return __builtin_amdgcn_rsqf(ssq[row] * (1.0f / 4096.0f) + 1e-6f); }
struct EpiGlu {
    static constexpr bool PERM = false, AFTER_DRAIN = false;
    const float* xin_p; const float* xin_s; float* xout; bf16_t* xb; float* ssq;
    template <int MQ> __device__ __forceinline__ void operator()(const f32x4 (&acc)[2][2][MQ][2], const Unit& u, int wr, int wc, int fr, int fq) const {
        constexpr int MHALF = 32 * MQ; const int row0 = u.pm * (2 * MHALF) + wr * (16 * MQ) + fr, col0 = u.pn * HALF + wc * 32 + 4 * fq;
        const float* xi = (row0 < 8192) ? xin_p + (size_t)row0 * 4096 : xin_s + (size_t)(row0 - 8192) * 4096;
        float* ob = xout + (size_t)row0 * 4096; bf16_t* bb = xb + (size_t)row0 * 4096;
#pragma unroll
        for (int ai = 0; ai < 2; ++ai)
#pragma unroll
            for (int m = 0; m < MQ; ++m) { const size_t off = (size_t)(ai * MHALF + m * 16) * 4096 + col0; float sq = 0.f;
#pragma unroll
                for (int n = 0; n < 2; ++n) { const f32x4 xv = *(const f32x4*)(xi + off + 16 * n); const f32x4 a = acc[ai][0][m][n], b = acc[ai][1][m][n]; f32x4 o;
#pragma unroll
                    for (int j = 0; j < 4; ++j) { o[j] = xv[j] + a[j] * sigmoid_f(b[j]); sq = fmaf(o[j], o[j], sq); }
                    *(f32x4*)(ob + off + 16 * n) = o;
                    *(unsigned long long*)(bb + off + 16 * n) = (unsigned long long)cvt_pk_bf16(o[0], o[1]) | ((unsigned long long)cvt_pk_bf16(o[2], o[3]) << 32); }
                ssq_add(ssq, row0 + ai * MHALF + m * 16, sq, fq); }
    }
};
struct EpiSwiglu {
    static constexpr bool PERM = true, AFTER_DRAIN = false;
    bf16_t* O; int ldc; const float* ssq;
    template <int MQ> __device__ __forceinline__ void operator()(const f32x4 (&acc)[2][2][MQ][2], const Unit& u, int wr, int wc, int fr, int fq) const {
        constexpr int MHALF = 32 * MQ; const int row0 = u.pm * (2 * MHALF) + wr * (16 * MQ) + fr, col0 = u.pn * HALF + wc * 32 + 8 * fq;
#pragma unroll
        for (int ai = 0; ai < 2; ++ai)
#pragma unroll
            for (int m = 0; m < MQ; ++m) { const int r = row0 + ai * MHALF + m * 16; bf16_t* rowp = O + (size_t)r * ldc + col0; const float rs = rstd_of(ssq, r);
                f32x4 h[2];
#pragma unroll
                for (int n = 0; n < 2; ++n) { const f32x4 g = acc[ai][0][m][n] * rs, v = acc[ai][1][m][n] * rs;
#pragma unroll
                    for (int j = 0; j < 4; ++j) h[n][j] = g[j] * sigmoid_f(g[j]) * v[j]; }
                u32x4 w; w.x = cvt_pk_bf16(h[0][0], h[0][1]); w.y = cvt_pk_bf16(h[0][2], h[0][3]); w.z = cvt_pk_bf16(h[1][0], h[1][1]); w.w = cvt_pk_bf16(h[1][2], h[1][3]);
                *(u32x4*)rowp = w; }
    }
};
template <bool POOL> struct EpiResid {
    static constexpr bool PERM = false, AFTER_DRAIN = false;
    float* x; const float* scale; bf16_t* xb; float* ssq; int npm;
    template <int MQ> __device__ __forceinline__ void operator()(const f32x4 (&acc)[2][2][MQ][2], const Unit& u, int wr, int wc, int fr, int fq) const {
        constexpr int MHALF = 32 * MQ; const int pm = POOL ? (u.pm % npm) : u.pm;
        const int row0 = pm * (2 * MHALF) + wr * (16 * MQ) + fr, col0 = u.pn * BM + wc * 32 + 4 * fq;
        f32x4 sv[2][2];
#pragma unroll
        for (int bj = 0; bj < 2; ++bj)
#pragma unroll
            for (int n = 0; n < 2; ++n) sv[bj][n] = POOL ? *(const f32x4*)(scale + col0 + bj * HALF + n * 16) : (f32x4){1.f, 1.f, 1.f, 1.f};
#pragma unroll
        for (int ai = 0; ai < 2; ++ai)
#pragma unroll
            for (int m = 0; m < MQ; ++m) { const int r = row0 + ai * MHALF + m * 16; float* rowp = x + (size_t)r * 4096 + col0; float sq = 0.f;
#pragma unroll
                for (int bj = 0; bj < 2; ++bj)
#pragma unroll
                    for (int n = 0; n < 2; ++n) { const f32x4 xv = *(const f32x4*)(rowp + bj * HALF + n * 16);
                        const f32x4 o = POOL ? xv + acc[ai][bj][m][n] * sv[bj][n] : xv + acc[ai][bj][m][n];
                        sq += (o[0] * o[0] + o[1] * o[1]) + (o[2] * o[2] + o[3] * o[3]);
                        *(f32x4*)(rowp + bj * HALF + n * 16) = o;
                        if (POOL) *(unsigned long long*)(xb + (size_t)r * 4096 + col0 + bj * HALF + n * 16) = (unsigned long long)cvt_pk_bf16(o[0], o[1]) | ((unsigned long long)cvt_pk_bf16(o[2], o[3]) << 32); }
                ssq_add(ssq, r, sq, fq); }
    }
};
struct EpiResidSplit {
    static constexpr bool PERM = false, AFTER_DRAIN = false;
    float* x; float* ssq; float* slab; unsigned* ctr; int part;
    template <int MQ> __device__ __forceinline__ void operator()(const f32x4 (&acc)[2][2][MQ][2], const Unit& u, int wr, int wc, int fr, int fq) const {
        static_assert(MQ == 4, "split tail: 256-row tiles");
        const int tid = threadIdx.x;
        if (part != 0) {
            f32x4* sp = (f32x4*)slab + (size_t)(part - 1) * 16384 + tid;
#pragma unroll
            for (int ai = 0; ai < 2; ++ai)
#pragma unroll
                for (int bj = 0; bj < 2; ++bj)
#pragma unroll
                    for (int m = 0; m < 4; ++m)
#pragma unroll
                        for (int n = 0; n < 2; ++n) sp[(((ai * 2 + bj) * 4 + m) * 2 + n) * 512] = acc[ai][bj][m][n];
            return;
        }
        { unsigned sp = 0; while (__hip_atomic_load(ctr, __ATOMIC_RELAXED, __HIP_MEMORY_SCOPE_AGENT) < 3u && ++sp < (1u << 22)) __builtin_amdgcn_s_sleep(2); }
        __builtin_amdgcn_fence(__ATOMIC_ACQUIRE, "agent");
        const f32x4* sp = (const f32x4*)slab + tid;
        const int row0 = u.pm * 256 + wr * 64 + fr, col0 = u.pn * BM + wc * 32 + 4 * fq;
#pragma unroll
        for (int ai = 0; ai < 2; ++ai)
#pragma unroll
            for (int m = 0; m < 4; ++m) { const int r = row0 + ai * 128 + m * 16; float* rowp = x + (size_t)r * 4096 + col0; float sq = 0.f;
#pragma unroll
                for (int bj = 0; bj < 2; ++bj)
#pragma unroll
                    for (int n = 0; n < 2; ++n) { const int idx = (((ai * 2 + bj) * 4 + m) * 2 + n) * 512;
                        const f32x4 xv = *(const f32x4*)(rowp + bj * HALF + n * 16);
                        const f32x4 o = (xv + acc[ai][bj][m][n]) + ((sp[idx] + sp[16384 + idx]) + sp[32768 + idx]);
                        sq += (o[0] * o[0] + o[1] * o[1]) + (o[2] * o[2] + o[3] * o[3]);
                        *(f32x4*)(rowp + bj * HALF + n * 16) = o; }
                ssq_add(ssq, r, sq, fq); }
    }
};
struct SplitOrder {
    int c, pm0;
    __device__ bool next(int i, Unit& u) const { if (i != 0) return false; const int slot = (c >> 3) & 7; u.pm = pm0 + (slot & 3); u.pn = 2 * (c & 7) + (slot >> 2); return true; }
    __device__ __forceinline__ void a_ready(const Unit&) const {}
    __device__ __forceinline__ void done(const Unit&) const {}
};
struct PoolOrder {
    int G, c, npm;
    __device__ bool next(int i, Unit& u) const {
        const int per = npm * 4, L = i * G + c; if (L >= 4 * per) return false;
        const int grp = L / per, rem = L % per; u.pm = grp * npm + rem % npm; u.pn = grp * 4 + rem / npm; return true;
    }
    __device__ __forceinline__ void a_ready(const Unit&) const {}
    __device__ __forceinline__ void done(const Unit&) const {}
};

template <class Epi, class Sched, bool ALIGN_EPI = false, bool SP2 = false, int MQ = 4>
__device__ __forceinline__ void gemm_phase(PG8_LAS unsigned char* lds, const Gemm g, const Sched& S, const Epi& E) {
    const int tid = threadIdx.x, wid = __builtin_amdgcn_readfirstlane(tid >> 6), lane = tid & 63, wr = wid >> 2, wc = wid & 3, fr = lane & 15, fq = lane >> 4;
    static_assert(MQ == 4 || ((MQ == 3 || MQ == 2) && SP2), "192- and 128-row tiles: only the SP2 loop carries the wave-group-specific waits");
    const int K = g.K, nt = g.nt ? g.nt : K / BK;
    unsigned voffA[2], voffB[2];
#pragma unroll
    for (int i = 0; i < 2; ++i) { int R, C; stage_rc(tid * 16 + i * 8192, R, C); const int Rb = Epi::PERM ? ((R & ~31) + perm32(R & 31)) : R;
        voffA[i] = (unsigned)(R * K + C) * 2u; voffB[i] = (unsigned)(Rb * K + C) * 2u; }
    const size_t kstep = (size_t)(BK * 2);
    const size_t hstep = (size_t)HALF * K * 2, hstepA = (size_t)(32 * MQ) * K * 2;
    const size_t tstep = 2 * hstep, tstepA = 2 * hstepA;
    const unsigned ldsw = (unsigned)wid * 1024u;
    const int aoff = lds_byte(wr * (16 * MQ) + fr, fq * 8), boff = lds_byte(wc * 32 + fr, fq * 8);
#define PG8_SA(b, h) (((b) * 2 + (h)) * HTB)
#define PG8_SB(b, h) ((4 + (b) * 2 + (h)) * HTB)
#define PG8_STAGE(bufoff, gbase, voff) do { _Pragma("unroll") for (int _i = 0; _i < 2; ++_i) \
        __builtin_amdgcn_global_load_lds((const unsigned*)((const char*)(gbase) + (voff)[_i]), (PG8_LAS unsigned*)(lds + (bufoff) + ldsw + _i * 8192), 16, 0, 0); } while (0)
#define PG8_STAGE_A(bufoff, gbase) do { __builtin_amdgcn_global_load_lds((const unsigned*)((const char*)(gbase) + voffA[0]), (PG8_LAS unsigned*)(lds + (bufoff) + ldsw), 16, 0, 0); \
        if (MQ == 4 || (MQ == 3 && wid < 4)) __builtin_amdgcn_global_load_lds((const unsigned*)((const char*)(gbase) + voffA[1]), (PG8_LAS unsigned*)(lds + (bufoff) + ldsw + 8192), 16, 0, 0); } while (0)
#define PG8_LDA(dst, b, h) do { _Pragma("unroll") for (int m = 0; m < MQ; ++m) _Pragma("unroll") for (int k = 0; k < 2; ++k) dst[m][k] = *(const PG8_LAS bf16x8*)(lds + PG8_SA(b, h) + aoff + m * 2048 + k * 1024); } while (0)
#define PG8_LDB(dst, b, h) do { _Pragma("unroll") for (int n = 0; n < 2; ++n) _Pragma("unroll") for (int k = 0; k < 2; ++k) dst[n][k] = *(const PG8_LAS bf16x8*)(lds + PG8_SB(b, h) + boff + n * 2048 + k * 1024); } while (0)
#define PG8_MMA(ai, bj, At, Bt) do { __builtin_amdgcn_s_setprio(1); _Pragma("unroll") for (int m = 0; m < MQ; ++m) _Pragma("unroll") for (int n = 0; n < 2; ++n) _Pragma("unroll") for (int k = 0; k < 2; ++k) \
        acc[ai][bj][m][n] = __builtin_amdgcn_mfma_f32_16x16x32_bf16(Bt[n][k], At[m][k], acc[ai][bj][m][n], 0, 0, 0); __builtin_amdgcn_s_setprio(0); } while (0)
#define PG8_WAIT_V(n) asm volatile("s_waitcnt vmcnt(" #n ")" ::: "memory")
#define PG8_WAIT_V8 do { if (MQ == 2 || (MQ == 3 && wid >= 4)) PG8_WAIT_V(6); else PG8_WAIT_V(8); } while (0)
#define PG8_WAIT_L(n) asm volatile("s_waitcnt lgkmcnt(" #n ")" ::: "memory")
#define PG8_BAR __builtin_amdgcn_s_barrier()
#define PG8_SCHED __builtin_amdgcn_sched_barrier(0)
    Unit cur, nxt; int ui = 0;
    if (!S.next(0, cur)) return;
    f32x4 acc[2][2][MQ][2];
#pragma unroll
    for (int a = 0; a < 2; ++a)
#pragma unroll
        for (int b = 0; b < 2; ++b)
#pragma unroll
            for (int m = 0; m < MQ; ++m)
#pragma unroll
                for (int n = 0; n < 2; ++n) acc[a][b][m][n] = (f32x4){0.f, 0.f, 0.f, 0.f};
    bf16x8 At[MQ][2], B0[2][2], B1[2][2];
    const char* cA = (const char*)g.A + (size_t)cur.pm * tstepA; const char* cB = (const char*)g.Bt + (size_t)cur.pn * tstep;
    S.a_ready(cur);
    if constexpr (SP2) {
        PG8_STAGE(PG8_SB(0, 0), cB, voffB); PG8_STAGE(PG8_SB(0, 1), cB + hstep, voffB); PG8_STAGE_A(PG8_SA(0, 0), cA); PG8_STAGE_A(PG8_SA(0, 1), cA + hstepA);
        if (wr == 1) PG8_BAR;
        if (MQ == 2 || (MQ == 3 && wid >= 4)) PG8_WAIT_V(1); else PG8_WAIT_V(2);
        PG8_BAR;
        PG8_STAGE(PG8_SB(1, 0), cB + kstep, voffB); PG8_STAGE_A(PG8_SA(1, 0), cA + kstep); PG8_STAGE(PG8_SB(1, 1), cB + hstep + kstep, voffB);
        if (MQ == 2 || (MQ == 3 && wid >= 4)) PG8_WAIT_V(5); else PG8_WAIT_V(6);
        PG8_BAR;
    } else {
        PG8_STAGE(PG8_SB(0, 0), cB, voffB); PG8_STAGE_A(PG8_SA(0, 0), cA); PG8_STAGE(PG8_SB(0, 1), cB + hstep, voffB); PG8_STAGE_A(PG8_SA(0, 1), cA + hstepA);
        if (wr == 1) PG8_BAR;
        PG8_WAIT_V(4); PG8_BAR;
        PG8_STAGE(PG8_SB(1, 0), cB + kstep, voffB); PG8_STAGE_A(PG8_SA(1, 0), cA + kstep); PG8_STAGE(PG8_SB(1, 1), cB + hstep + kstep, voffB);
        PG8_WAIT_V(6); PG8_BAR;
    }
    for (;;) {
        const bool has_next = S.next(ui + 1, nxt);
        const char* nA = has_next ? (const char*)g.A + (size_t)nxt.pm * tstepA : cA; const char* nB = has_next ? (const char*)g.Bt + (size_t)nxt.pn * tstep : cB;
        for (int t = 0; t < nt; t += 2) {
            const bool last = (t == nt - 2);
            const char* a1 = cA + (size_t)(t + 1) * kstep;
            const char* a2 = last ? nA : cA + (size_t)(t + 2) * kstep; const char* b2 = last ? nB : cB + (size_t)(t + 2) * kstep;
            const char* a3 = a2 + kstep; const char* b3 = b2 + kstep;
            if (last && has_next) S.a_ready(nxt);
            if constexpr (SP2) {
            PG8_LDB(B0, 0, 0); PG8_LDB(B1, 0, 1); PG8_SCHED; PG8_LDA(At, 0, 0); PG8_STAGE_A(PG8_SA(1, 1), a1 + hstepA);
            PG8_WAIT_V8; PG8_WAIT_L(0); PG8_BAR; PG8_MMA(0, 0, At, B0); PG8_MMA(0, 1, At, B1); PG8_BAR; PG8_SCHED;
            PG8_LDA(At, 0, 1); PG8_STAGE(PG8_SB(0, 0), b2, voffB); PG8_STAGE(PG8_SB(0, 1), b2 + hstep, voffB); PG8_STAGE_A(PG8_SA(0, 0), a2);
            PG8_WAIT_V8; PG8_WAIT_L(0); PG8_BAR; PG8_MMA(1, 0, At, B0); PG8_MMA(1, 1, At, B1); PG8_BAR; PG8_SCHED;
            PG8_LDB(B0, 1, 0); PG8_LDB(B1, 1, 1); PG8_SCHED; PG8_LDA(At, 1, 0); PG8_STAGE_A(PG8_SA(0, 1), a2 + hstepA);
            PG8_WAIT_V8; PG8_WAIT_L(0); PG8_BAR; PG8_MMA(0, 0, At, B0); PG8_MMA(0, 1, At, B1); PG8_BAR; PG8_SCHED;
            PG8_LDA(At, 1, 1); PG8_STAGE(PG8_SB(1, 0), b3, voffB); PG8_STAGE(PG8_SB(1, 1), b3 + hstep, voffB); PG8_STAGE_A(PG8_SA(1, 0), a3);
            PG8_WAIT_V8; PG8_WAIT_L(0); PG8_BAR; PG8_MMA(1, 0, At, B0); PG8_MMA(1, 1, At, B1); PG8_BAR; PG8_SCHED;
            } else {
            PG8_LDB(B0, 0, 0); PG8_SCHED; PG8_LDA(At, 0, 0); PG8_STAGE_A(PG8_SA(1, 1), a1 + hstepA);
            PG8_WAIT_L(8); PG8_BAR; PG8_WAIT_L(0); PG8_MMA(0, 0, At, B0); PG8_BAR; PG8_SCHED;
            PG8_LDB(B1, 0, 1); PG8_STAGE(PG8_SB(0, 0), b2, voffB);
            PG8_BAR; PG8_WAIT_L(0); PG8_MMA(0, 1, At, B1); PG8_BAR;
            PG8_LDA(At, 0, 1); PG8_STAGE_A(PG8_SA(0, 0), a2);
            PG8_BAR; PG8_WAIT_L(0); PG8_MMA(1, 0, At, B0); PG8_BAR; PG8_SCHED;
            PG8_STAGE(PG8_SB(0, 1), b2 + hstep, voffB);
            PG8_WAIT_V(6); PG8_BAR; PG8_MMA(1, 1, At, B1); PG8_BAR;
            PG8_LDB(B0, 1, 0); PG8_SCHED; PG8_LDA(At, 1, 0); PG8_STAGE_A(PG8_SA(0, 1), a2 + hstepA);
            PG8_WAIT_L(8); PG8_BAR; PG8_WAIT_L(0); PG8_MMA(0, 0, At, B0); PG8_BAR; PG8_SCHED;
            PG8_LDB(B1, 1, 1); PG8_STAGE(PG8_SB(1, 0), b3, voffB);
            PG8_BAR; PG8_WAIT_L(0); PG8_MMA(0, 1, At, B1); PG8_BAR;
            PG8_LDA(At, 1, 1); PG8_STAGE_A(PG8_SA(1, 0), a3);
            PG8_BAR; PG8_WAIT_L(0); PG8_MMA(1, 0, At, B0); PG8_BAR; PG8_SCHED;
            PG8_STAGE(PG8_SB(1, 1), b3 + hstep, voffB);
            PG8_WAIT_V(6); PG8_BAR; PG8_MMA(1, 1, At, B1); PG8_BAR;
            }
        }
        if constexpr (ALIGN_EPI) { if (wr == 0) PG8_BAR; }
        if constexpr (!Epi::AFTER_DRAIN) { E(acc, cur, wr, wc, fr, fq); S.done(cur); }
        if (!has_next) break;
#pragma unroll
        for (int a = 0; a < 2; ++a)
#pragma unroll
            for (int b = 0; b < 2; ++b)
#pragma unroll
                for (int m = 0; m < MQ; ++m)
#pragma unroll
                    for (int n = 0; n < 2; ++n) acc[a][b][m][n] = (f32x4){0.f, 0.f, 0.f, 0.f};
        cur = nxt; cA = nA; cB = nB; ++ui;
        if constexpr (ALIGN_EPI) { if (wr == 1) PG8_BAR; }
    }
    PG8_WAIT_V(0);
    if constexpr (!ALIGN_EPI) { if (wr == 0) PG8_BAR; }
    PG8_BAR;
    if constexpr (Epi::AFTER_DRAIN) { E.fused(acc, cur, wr, wc, fr, fq, lds, wid, lane); S.done(cur); }
#undef PG8_SA
#undef PG8_SB
#undef PG8_STAGE
#undef PG8_LDA
#undef PG8_LDB
#undef PG8_MMA
#undef PG8_WAIT_V
#undef PG8_WAIT_V8
#undef PG8_STAGE_A
#undef PG8_WAIT_L
#undef PG8_BAR
#undef PG8_SCHED
}
}

#ifndef PG8_SP2
#define PG8_SP2 true
#endif
#ifndef PG8_ALIGN
#define PG8_ALIGN true
#endif
#ifndef MK_ONE_LAUNCH
#define MK_ONE_LAUNCH 1
#endif

constexpr int NWAVES = 8;
constexpr int DM = 4096, SEQ = 2048, NB = 4, DB = 128, DS = 8, MP = NB * SEQ, MS = DB * DS, M = MP + MS;
constexpr int DFF = 11008, NGRP = 256, NST = 64, NCH = 16, PBUF = 15;
constexpr float RMS_EPS = 1e-6f;
constexpr int N_PHASES = 10;
constexpr size_t O_YP = 0, O_YS = (size_t)MP * DM, O_SRP = O_YS + (size_t)MS * DM, O_SIP = O_SRP + (size_t)NB * NGRP * NST, O_PP = O_SIP + (size_t)NB * NGRP * NST,
                 O_SRS = O_PP + (size_t)NB * PBUF * DM, O_SIS = O_SRS + (size_t)DB * NGRP * NST, O_PS = O_SIS + (size_t)DB * NGRP * NST, O_END = O_PS + (size_t)DB * PBUF * DM;
constexpr size_t MiB = 1u << 20;
constexpr size_t WS_CTL = 0, CTL_ZERO_BYTES = 1 * MiB;
constexpr size_t WS_WGLU = 16 * MiB, WS_WGU0 = 80 * MiB, WS_WGU1 = 252 * MiB, WS_WDN0 = 424 * MiB, WS_WDN1 = 510 * MiB, WS_WPOOL = 596 * MiB;
constexpr size_t WS_XRES = 608 * MiB, WS_HA = 752 * MiB, WS_YSSM = 824 * MiB, WS_PPOOL = 896 * MiB, WS_HID = 968 * MiB, WS_SSMP = 1164 * MiB, WS_RSTD = 1169 * MiB, WS_END = 1170 * MiB;
static_assert(WS_WGLU + (size_t)2 * DM * DM * 2 <= WS_WGU0 && WS_WGU0 + (size_t)2 * DFF * DM * 2 <= WS_WGU1 && WS_WGU1 + (size_t)2 * DFF * DM * 2 <= WS_WDN0 && WS_WDN0 + (size_t)DM * DFF * 2 <= WS_WDN1 &&
              WS_WDN1 + (size_t)DM * DFF * 2 <= WS_WPOOL && WS_WPOOL + (size_t)4 * 1024 * 1024 * 2 <= WS_XRES && WS_XRES + (size_t)M * DM * 4 <= WS_HA && WS_HA + (size_t)M * DM * 2 <= WS_YSSM &&
              WS_YSSM + (size_t)M * DM * 2 <= WS_PPOOL && WS_PPOOL + (size_t)M * DM * 2 <= WS_HID && WS_HID + (size_t)M * DFF * 2 <= WS_SSMP, "d_ws map");
constexpr size_t SPB_AR = 0, SPB_AI = 65536, SPB_BF = 131072, SPB_CF = 131072 + 1048576;
constexpr int CW_BAR = 4096;
constexpr int CW_SPLIT = 65536;
constexpr int CW_SSQ = 16384;
constexpr int RING_OFF = 0, RING_BYTES = 131072;
constexpr int LDSCTL_OFF = RING_BYTES, MISC_OFF = LDSCTL_OFF + 320;
constexpr int LDS_BYTES = 147456;
static_assert(MISC_OFF + 128 <= LDS_BYTES, "LDS map");

#define GAS __attribute__((address_space(1)))
#define LAS __attribute__((address_space(3)))
typedef unsigned short bf16;
typedef unsigned v4u __attribute__((ext_vector_type(4)));
typedef float f32x4 __attribute__((ext_vector_type(4)));
typedef short bf16x8 __attribute__((ext_vector_type(8)));
typedef GAS unsigned gu32;
typedef GAS unsigned long long gu64;
#define RLX_AGENT __ATOMIC_RELAXED, __HIP_MEMORY_SCOPE_AGENT
#define LDS_WAIT() asm volatile("s_waitcnt lgkmcnt(0)" ::: "memory")
#define VM_WAIT() asm volatile("s_waitcnt vmcnt(0)" ::: "memory")
__device__ __forceinline__ unsigned long long rt() { return __builtin_amdgcn_s_memrealtime(); }
__device__ __forceinline__ unsigned f2bf(float f) { unsigned u = __builtin_bit_cast(unsigned, f); return (u + 0x7fffu + ((u >> 16) & 1u)) >> 16; }
__device__ __forceinline__ unsigned pk2(float lo, float hi) { return f2bf(lo) | (f2bf(hi) << 16); }

#define XB_TMO      128
#define XB_XCNT(j)  (256  + 64 * (j))
#define XB_XSUB(j)  (1280 + 64 * (j))
#define XB_XGEN(j)  (2304 + 64 * (j))
#define XB_TOP      3328
#define XB_TOPGEN   3392
#define XCD_BAR_WORDS 3456
#define XB_SPIN_CAP (1u << 18)

__device__ __forceinline__ unsigned xb_ld(unsigned* p)              { return __hip_atomic_load(p, __ATOMIC_RELAXED, __HIP_MEMORY_SCOPE_AGENT); }
__device__ __forceinline__ unsigned xb_add(unsigned* p, unsigned v) { return __hip_atomic_fetch_add(p, v, __ATOMIC_RELAXED, __HIP_MEMORY_SCOPE_AGENT); }
__device__ __forceinline__ unsigned xb_xcc_id() { return (unsigned)__builtin_amdgcn_s_getreg((3 << 11) | 20) & 0xFu; }
#define XB_SPIN(cond, bar) do { unsigned _sp = 0; while (cond) { __builtin_amdgcn_s_sleep(1); \
    if ((++_sp & 255u) == 0u) { if (xb_ld(&(bar)[XB_TMO])) break; if (_sp > XB_SPIN_CAP) { atomicAdd(&(bar)[XB_TMO], 1u); break; } } } } while (0)

struct XcdBarrier {
    unsigned* bar; unsigned x;
    volatile LAS unsigned* st;
};

__device__ __forceinline__ XcdBarrier xcd_barrier_post(unsigned* bar, volatile LAS unsigned* st) {
    XcdBarrier b; b.bar = bar; b.x = xb_xcc_id(); b.st = st;
    if (threadIdx.x == 0) (void)xb_add(&bar[XB_XCNT(b.x)], 1u);
    return b;
}
__device__ __forceinline__ void xcd_barrier_complete(unsigned* bar, unsigned x, unsigned& nloc, unsigned& nx) {
    const unsigned G = gridDim.x * gridDim.y * gridDim.z;
    unsigned sum, cnt, mine, sp = 0u;
    for (;;) {
        sum = 0u; cnt = 0u; mine = 0u;
#pragma unroll
        for (unsigned j = 0; j < 16; ++j) { const unsigned c = xb_ld(&bar[XB_XCNT(j)]); sum += c; cnt += (c > 0u) ? 1u : 0u; mine = (j == x) ? c : mine; }
        if (sum == G) break;
        __builtin_amdgcn_s_sleep(1);
        if ((++sp & 255u) == 0u) { if (xb_ld(&bar[XB_TMO])) break; if (sp > XB_SPIN_CAP) { atomicAdd(&bar[XB_TMO], 1u); break; } }
    }
    nloc = mine > 0u ? mine : 1u; nx = cnt > 0u ? cnt : 1u;
}

__device__ __forceinline__ void xcd_barrier(const XcdBarrier& b) {
    asm volatile("s_waitcnt vmcnt(0)" ::: "memory");
    __syncthreads();
    if (threadIdx.x == 0) {
        unsigned* bar = b.bar;
        __builtin_amdgcn_s_waitcnt(0);
        unsigned nloc = b.st[0], nx = b.st[1];
        if (nloc == 0u) { xcd_barrier_complete(bar, b.x, nloc, nx); b.st[0] = nloc; b.st[1] = nx; }
        const unsigned old = xb_add(&bar[XB_XSUB(b.x)], 1u);
        const unsigned gen = old / nloc;
        if (old + 1u == (gen + 1u) * nloc) {
            __builtin_amdgcn_fence(__ATOMIC_RELEASE, "agent");
            asm volatile("s_waitcnt vmcnt(0)" ::: "memory");
            const unsigned og = xb_add(&bar[XB_TOP], 1u);
            const unsigned tg = og / nx;
            if (og + 1u == (tg + 1u) * nx) xb_add(&bar[XB_TOPGEN], 1u);
            else XB_SPIN(xb_ld(&bar[XB_TOPGEN]) == tg, bar);
            __builtin_amdgcn_fence(__ATOMIC_ACQUIRE, "agent");
            xb_add(&bar[XB_XGEN(b.x)], 1u);
            asm volatile("s_waitcnt vmcnt(0)" ::: "memory");
        } else {
            XB_SPIN(xb_ld(&bar[XB_XGEN(b.x)]) == gen, bar);
            __builtin_amdgcn_fence(__ATOMIC_ACQUIRE, "agent");
            asm volatile("s_waitcnt vmcnt(0)" ::: "memory");
        }
    }
    __syncthreads();
}

struct Frame {
    LAS unsigned char* lds;
    volatile LAS unsigned* MISC;
    gu32* ctl;
    int tid, lane, wave;
    int vcu, G;
    const float* in[21];
    float* out;
    unsigned char* ws;
};
enum { I_XP = 0, I_XS, I_SRE, I_SIM, I_SPOOL, I_NMIX, I_NFFN, I_LRE, I_LIM, I_LSTEP, I_BRE, I_BIM, I_CRE, I_CIM, I_SD, I_WGLU, I_WPOOL, I_PSCALE, I_WGU, I_WDN, I_NFIN };

__device__ __forceinline__ float wave_sum(float v) {
#pragma unroll
    for (int o = 1; o < 64; o <<= 1) v += __shfl_xor(v, o);
    return v;
}
typedef float f32x2_t __attribute__((ext_vector_type(2)));
typedef __bf16 b16x2_t __attribute__((ext_vector_type(2)));
typedef float f32x16 __attribute__((ext_vector_type(16)));
__device__ __forceinline__ unsigned cvtpk(float lo, float hi) { return __builtin_bit_cast(unsigned, __builtin_convertvector((f32x2_t){lo, hi}, b16x2_t)); }
__device__ __forceinline__ const float* xrow_in(const Frame& F, int r) { return r < MP ? F.in[I_XP] + (size_t)r * DM : F.in[I_XS] + (size_t)(r - MP) * DM; }

__device__ __forceinline__ void tr_item(const float* W, int K, int N, bf16* WT, int k0, int n0, int drow0, int lane, const float* kgain = nullptr) {
    const int kq = lane >> 3, nq = lane & 7;
    f32x4 v[2][8];
#pragma unroll
    for (int h = 0; h < 2; ++h)
#pragma unroll
        for (int i = 0; i < 8; ++i) v[h][i] = *(const GAS f32x4*)(W + (size_t)(k0 + 8 * kq + i) * N + n0 + 32 * h + 4 * nq);
    if (kgain) {
        const f32x4 g0 = *(const GAS f32x4*)(kgain + k0 + 8 * kq), g1 = *(const GAS f32x4*)(kgain + k0 + 8 * kq + 4);
#pragma unroll
        for (int h = 0; h < 2; ++h)
#pragma unroll
            for (int i = 0; i < 8; ++i) v[h][i] = v[h][i] * (i < 4 ? g0[i & 3] : g1[i & 3]);
    }
#pragma unroll
    for (int h = 0; h < 2; ++h)
#pragma unroll
        for (int j = 0; j < 4; ++j) { v4u o; o.x = cvtpk(v[h][0][j], v[h][1][j]); o.y = cvtpk(v[h][2][j], v[h][3][j]); o.z = cvtpk(v[h][4][j], v[h][5][j]); o.w = cvtpk(v[h][6][j], v[h][7][j]);
            *(GAS v4u*)(WT + (size_t)(drow0 + 32 * h + 4 * nq + j) * K + k0 + 8 * kq) = o; }
}
__device__ __forceinline__ int drow_pair(int n0, int NH) { const int half = n0 >= NH ? 1 : 0, nn = n0 - half * NH; return 256 * (nn >> 7) + 128 * half + (nn & 127); }

__device__ __forceinline__ double exp_d(double x) {
    const double k = __builtin_rint(x * 1.4426950408889634074); const double r = x - k * 0.69314718055994530942;
    double s = 1.0, t = 1.0;
#pragma unroll
    for (int i = 1; i <= 16; ++i) { t *= r * (1.0 / (double)i); s += t; }
    const long long e = (long long)k + 1023; return s * __builtin_bit_cast(double, (unsigned long long)e << 52);
}
__device__ __forceinline__ void sincos_d(double th, double& sn, double& cs) {
    const double n = __builtin_rint(th * 0.15915494309189533577); const double r = (th - n * 6.283185307179586232) - n * 2.4492935982947064e-16; const double r2 = r * r;
    double s = r, c = 1.0, ts = r, tc = 1.0;
#pragma unroll
    for (int i = 1; i <= 15; ++i) { tc *= r2 * (-1.0 / (double)((2 * i - 1) * (2 * i))); ts *= r2 * (-1.0 / (double)((2 * i) * (2 * i + 1))); c += tc; s += ts; }
    sn = s; cs = c;
}

constexpr int CI_GLU = (DM / 64) * (2 * DM / 64), CI_GU = (DM / 64) * (2 * DFF / 64), CI_DN = (DFF / 64) * (DM / 64), CI_PL = 4 * 16 * 16;
constexpr int CI_L0 = CI_GLU + CI_GU + CI_DN, CI_ALL = CI_L0 + CI_GU + CI_DN + CI_PL;
__device__ __forceinline__ void convert_weights(Frame& F, int lo, int hi, int first, int step) {
    LAS unsigned* ctr = (LAS unsigned*)(F.lds + MISC_OFF + 80);
    for (;;) {
        unsigned k = 0; if (F.lane == 0) k = __hip_atomic_fetch_add(ctr, 1u, __ATOMIC_RELAXED, __HIP_MEMORY_SCOPE_WORKGROUP);
        k = (unsigned)__builtin_amdgcn_readfirstlane((int)k);
        const long itl = (long)lo + first + (long)step * k; if (itl >= hi) break;
        int r = (int)itl;
        if (r < CI_GLU) { const int nb = r % (2 * DM / 64), kb = r / (2 * DM / 64); tr_item(F.in[I_WGLU], DM, 2 * DM, (bf16*)(F.ws + WS_WGLU), kb * 64, nb * 64, drow_pair(nb * 64, DM), F.lane); continue; } r -= CI_GLU;
        if (r >= 2 * CI_GU + CI_DN && r < 2 * CI_GU + CI_DN + CI_PL) { r -= 2 * CI_GU + CI_DN; const int g = r / 256; r -= g * 256; const int nb = r % 16, kb = r / 16;
            tr_item(F.in[I_WPOOL] + (size_t)g * 1024 * 1024, 1024, 1024, (bf16*)(F.ws + WS_WPOOL) + (size_t)g * 1024 * 1024, kb * 64, nb * 64, nb * 64, F.lane); continue; }
        int l, isdn;
        if (r < CI_GU) { l = 0; isdn = 0; } else if (r < CI_GU + CI_DN) { r -= CI_GU; l = 0; isdn = 1; } else if (r < 2 * CI_GU + CI_DN) { r -= CI_GU + CI_DN; l = 1; isdn = 0; } else { r -= 2 * CI_GU + CI_DN + CI_PL; l = 1; isdn = 1; }
        if (!isdn) { const int nb = r % (2 * DFF / 64), kb = r / (2 * DFF / 64);
            tr_item(F.in[I_WGU] + (size_t)l * DM * 2 * DFF, DM, 2 * DFF, (bf16*)(F.ws + (l ? WS_WGU1 : WS_WGU0)), kb * 64, nb * 64, drow_pair(nb * 64, DFF), F.lane, F.in[I_NFFN] + l * DM); continue; }
        { const int nb = r % (DM / 64), kb = r / (DM / 64);
            tr_item(F.in[I_WDN] + (size_t)l * DFF * DM, DFF, DM, (bf16*)(F.ws + (l ? WS_WDN1 : WS_WDN0)), kb * 64, nb * 64, nb * 64, F.lane); }
    }
}
__device__ __forceinline__ void convert_reset(Frame& F) { __syncthreads(); if (F.tid == 0) *(LAS unsigned*)(F.lds + MISC_OFF + 80) = 0u; __syncthreads(); }
__device__ __forceinline__ void p0_prologue(Frame& F) {
    const int gw = F.vcu * NWAVES + F.wave, NGW = F.G * NWAVES;
    float* rstd0 = (float*)(F.ws + WS_RSTD);
    for (int r = gw; r < M; r += NGW) { const GAS f32x4* xr = (const GAS f32x4*)xrow_in(F, r) + F.lane; float s = 0.f;
#pragma unroll
        for (int j = 0; j < 16; ++j) { const f32x4 v = xr[64 * j]; s += (v.x * v.x + v.y * v.y) + (v.z * v.z + v.w * v.w); }
        s = wave_sum(s); if (F.lane == 0) rstd0[r] = 1.0f / sqrtf(s * (1.0f / DM) + RMS_EPS); }
    unsigned char* spb = F.ws + WS_SSMP;
    for (int idx = F.vcu * (NWAVES * 64) + F.tid; idx < NGRP * NST; idx += F.G * NWAVES * 64) {
        const int g = idx >> 6, p = idx & 63, ti = p >> 5, sl = p & 31;
        const double lr = (double)F.in[I_LRE][idx], li = (double)F.in[I_LIM][idx], dt = exp_d((double)F.in[I_LSTEP][g]);
        const double mag = exp_d(lr * dt); double sn, cs; sincos_d(li * dt, sn, cs);
        const double ar = mag * cs, ai = mag * sn, den = lr * lr + li * li;
        const double fr = ((ar - 1.0) * lr + ai * li) / den, fi = (ai * lr - (ar - 1.0) * li) / den;
        ((float*)(spb + SPB_AR))[idx] = (float)ar; ((float*)(spb + SPB_AI))[idx] = (float)ai;
#pragma unroll
        for (int hl = 0; hl < 2; ++hl) { float re[8], im[8];
#pragma unroll
            for (int c4 = 0; c4 < 2; ++c4) { const f32x4 br = *(const GAS f32x4*)(F.in[I_BRE] + (size_t)idx * 16 + 8 * hl + 4 * c4), bi = *(const GAS f32x4*)(F.in[I_BIM] + (size_t)idx * 16 + 8 * hl + 4 * c4);
                const f32x4 gn = *(const GAS f32x4*)(F.in[I_NMIX] + g * 16 + 8 * hl + 4 * c4);
#pragma unroll
                for (int j = 0; j < 4; ++j) { re[4 * c4 + j] = (float)((fr * (double)br[j] - fi * (double)bi[j]) * (double)gn[j]); im[4 * c4 + j] = (float)((fr * (double)bi[j] + fi * (double)br[j]) * (double)gn[j]); } }
            const int ln = 32 * hl + sl; v4u o;
            o.x = cvtpk(re[0], re[1]); o.y = cvtpk(re[2], re[3]); o.z = cvtpk(re[4], re[5]); o.w = cvtpk(re[6], re[7]);
            *(GAS v4u*)(spb + SPB_BF + ((size_t)(((g * 2 + ti) * 2 + 0) * 64 + ln)) * 16) = o;
            o.x = cvtpk(im[0], im[1]); o.y = cvtpk(im[2], im[3]); o.z = cvtpk(im[4], im[5]); o.w = cvtpk(im[6], im[7]);
            *(GAS v4u*)(spb + SPB_BF + ((size_t)(((g * 2 + ti) * 2 + 1) * 64 + ln)) * 16) = o; }
    }
    for (int idx = F.vcu * (NWAVES * 64) + F.tid; idx < NGRP * 4 * 64; idx += F.G * NWAVES * 64) {
        const int g = idx >> 8, ks = (idx >> 6) & 3, ln = idx & 63, q = ln >> 4, c = ln & 15, p0 = 16 * ks + 4 * q;
        const f32x4 cr = *(const GAS f32x4*)(F.in[I_CRE] + ((size_t)g * 16 + c) * NST + p0), ci = *(const GAS f32x4*)(F.in[I_CIM] + ((size_t)g * 16 + c) * NST + p0);
        v4u o; o.x = cvtpk(cr[0], -ci[0]); o.y = cvtpk(cr[1], -ci[1]); o.z = cvtpk(cr[2], -ci[2]); o.w = cvtpk(cr[3], -ci[3]);
        *(GAS v4u*)(spb + SPB_CF + (size_t)idx * 16) = o;
    }
}

__device__ __forceinline__ float gelu_tanh(float x) { const float z = 0.7978845608028654f * (x + 0.044715f * x * x * x); return x * __builtin_amdgcn_rcpf(1.0f + __expf(-2.0f * z)); }
template <bool SAMPLE>
__device__ __forceinline__ void ssm_run(Frame& F, int g, int sel) {
    const int lane = F.lane, hl = lane >> 5, sl = lane & 31, q = lane >> 4, cl = lane & 15;
    const unsigned char* spb = F.ws + WS_SSMP; const float* rstd0 = (const float*)(F.ws + WS_RSTD);
    bf16x8 bfr[2][2], cfr[4];
#pragma unroll
    for (int ti = 0; ti < 2; ++ti)
#pragma unroll
        for (int part = 0; part < 2; ++part) bfr[ti][part] = *(const GAS bf16x8*)(spb + SPB_BF + ((size_t)(((g * 2 + ti) * 2 + part) * 64 + lane)) * 16);
#pragma unroll
    for (int ks = 0; ks < 4; ++ks) cfr[ks] = *(const GAS bf16x8*)(spb + SPB_CF + ((size_t)((g * 4 + ks) * 64 + lane)) * 16);
    float ar[2], ai[2];
#pragma unroll
    for (int ti = 0; ti < 2; ++ti) { ar[ti] = ((const float*)(spb + SPB_AR))[g * NST + 32 * ti + sl]; ai[ti] = ((const float*)(spb + SPB_AI))[g * NST + 32 * ti + sl]; }
    const f32x4 dg = *(const GAS f32x4*)(F.in[I_SD] + g * 16 + 4 * q) * *(const GAS f32x4*)(F.in[I_NMIX] + g * 16 + 4 * q);
    const int hA = (sl >> 2) & 1, rA = (sl & 3) + 4 * (sl >> 3);
    const int hE = (cl >> 2) & 1, rE = (cl & 3) + 4 * (cl >> 3);
    LAS unsigned char* xl = F.lds + RING_OFF + F.wave * 8704;
    LAS unsigned* xw = (LAS unsigned*)(xl + hl * (4 * 272) + sl * 4);
    const LAS unsigned char* xrd = xl + cl * 272 + q * 16;
    int rowA, rowE[2], nch; float xr[2], xi[2], xr2[2], xi2[2]; float *o1r, *o1i, *o2r = nullptr, *o2i = nullptr;
    if constexpr (SAMPLE) { const int b0 = 4 * sel; nch = 1;
        rowA = MP + (b0 + 2 * hA + (rA >> 3)) * DS + (rA & 7); rowE[0] = MP + (b0 + 2 * hE) * DS + rE; rowE[1] = MP + (b0 + 2 * hE + 1) * DS + rE;
        const size_t s1 = ((size_t)(b0 + 2 * hl) * NGRP + g) * NST + sl, s2 = s1 + (size_t)NGRP * NST;
#pragma unroll
        for (int ti = 0; ti < 2; ++ti) { xr[ti] = F.in[I_SRE][s1 + 32 * ti]; xi[ti] = F.in[I_SIM][s1 + 32 * ti]; xr2[ti] = F.in[I_SRE][s2 + 32 * ti]; xi2[ti] = F.in[I_SIM][s2 + 32 * ti]; }
        o1r = F.out + O_SRS + s1; o1i = F.out + O_SIS + s1; o2r = F.out + O_SRS + s2; o2i = F.out + O_SIS + s2;
    } else { const int seq0 = 2 * sel; nch = SEQ / 16;
        rowA = (seq0 + hA) * SEQ + rA; rowE[0] = (seq0 + hE) * SEQ + rE; rowE[1] = rowE[0] + 8;
#pragma unroll
        for (int ti = 0; ti < 2; ++ti) { xr[ti] = 0.f; xi[ti] = 0.f; xr2[ti] = 0.f; xi2[ti] = 0.f; }
        const size_t s1 = ((size_t)(seq0 + hl) * NGRP + g) * NST + sl; o1r = F.out + O_SRP + s1; o1i = F.out + O_SIP + s1;
    }
    f32x16 zero16;
#pragma unroll
    for (int i = 0; i < 16; ++i) zero16[i] = 0.f;
    f32x4 nx0, nx1, nxe[2]; float nrs, nre[2];
    { const float* xp = xrow_in(F, rowA) + g * 16 + 8 * hl; nx0 = *(const GAS f32x4*)xp; nx1 = *(const GAS f32x4*)(xp + 4); nrs = rstd0[rowA];
#pragma unroll
      for (int rt = 0; rt < 2; ++rt) { nxe[rt] = *(const GAS f32x4*)(xrow_in(F, rowE[rt]) + g * 16 + 4 * q); nre[rt] = rstd0[rowE[rt]]; } }
    for (int ch = 0; ch < nch; ++ch) {
        const f32x4 x0 = nx0, x1 = nx1; const float rs = nrs;
        f32x4 xe[2]; float re[2];
#pragma unroll
        for (int rt = 0; rt < 2; ++rt) { xe[rt] = nxe[rt]; re[rt] = nre[rt]; }
        if (ch + 1 < nch) { const int ra = rowA + 16 * (ch + 1); const float* xp = xrow_in(F, ra) + g * 16 + 8 * hl; nx0 = *(const GAS f32x4*)xp; nx1 = *(const GAS f32x4*)(xp + 4); nrs = rstd0[ra];
#pragma unroll
            for (int rt = 0; rt < 2; ++rt) { const int r = rowE[rt] + 16 * (ch + 1); nxe[rt] = *(const GAS f32x4*)(xrow_in(F, r) + g * 16 + 4 * q); nre[rt] = rstd0[r]; } }
        v4u au; au.x = cvtpk(x0[0] * rs, x0[1] * rs); au.y = cvtpk(x0[2] * rs, x0[3] * rs); au.z = cvtpk(x1[0] * rs, x1[1] * rs); au.w = cvtpk(x1[2] * rs, x1[3] * rs);
        const bf16x8 afr = __builtin_bit_cast(bf16x8, au);
#pragma unroll
        for (int ti = 0; ti < 2; ++ti) {
            f32x16 dr = __builtin_amdgcn_mfma_f32_32x32x16_bf16(afr, bfr[ti][0], zero16, 0, 0, 0);
            f32x16 di = __builtin_amdgcn_mfma_f32_32x32x16_bf16(afr, bfr[ti][1], zero16, 0, 0, 0);
            float sr = xr[ti], si = xi[ti];
#pragma unroll
            for (int r = 0; r < 16; ++r) {
                if (SAMPLE && r == 8) { o1r[32 * ti] = sr; o1i[32 * ti] = si; sr = xr2[ti]; si = xi2[ti]; }
                const float nr = fmaf(-ai[ti], si, fmaf(ar[ti], sr, dr[r])), ni = fmaf(ai[ti], sr, fmaf(ar[ti], si, di[r])); sr = nr; si = ni;
                xw[(((r & 3) + 8 * (r >> 2)) * 272 + ti * 128) / 4] = cvtpk(sr, si);
            }
            xr[ti] = sr; xi[ti] = si;
        }
        asm volatile("s_waitcnt lgkmcnt(0)" ::: "memory"); __builtin_amdgcn_sched_barrier(0);
        f32x4 y[2];
#pragma unroll
        for (int rt = 0; rt < 2; ++rt) { y[rt] = (f32x4){0.f, 0.f, 0.f, 0.f};
#pragma unroll
            for (int ks = 0; ks < 4; ++ks) { const bf16x8 xf = *(const LAS bf16x8*)(xrd + rt * (16 * 272) + ks * 64); y[rt] = __builtin_amdgcn_mfma_f32_16x16x32_bf16(cfr[ks], xf, y[rt], 0, 0, 0); } }
        asm volatile("s_waitcnt lgkmcnt(0)" ::: "memory"); __builtin_amdgcn_sched_barrier(0);
#pragma unroll
        for (int rt = 0; rt < 2; ++rt) { const int r = rowE[rt] + 16 * ch; f32x4 v;
#pragma unroll
            for (int j = 0; j < 4; ++j) v[j] = gelu_tanh(y[rt][j] + dg[j] * (xe[rt][j] * re[rt]));
            *(GAS unsigned long long*)((bf16*)(F.ws + WS_YSSM) + (size_t)r * DM + g * 16 + 4 * q) = (unsigned long long)cvtpk(v[0], v[1]) | ((unsigned long long)cvtpk(v[2], v[3]) << 32); }
    }
    if constexpr (SAMPLE) {
#pragma unroll
        for (int ti = 0; ti < 2; ++ti) { o2r[32 * ti] = xr[ti]; o2i[32 * ti] = xi[ti]; }
    } else {
#pragma unroll
        for (int ti = 0; ti < 2; ++ti) { o1r[32 * ti] = xr[ti]; o1i[32 * ti] = xi[ti]; }
    }
}
__device__ __forceinline__ void p1_ssm(Frame& F) {
    if (F.wave < 2) {
        for (int task = F.vcu * 2 + F.wave; task < 2 * NGRP; task += F.G * 2) ssm_run<false>(F, task & 255, task >> 8);
    } else {
        for (int task = F.vcu * 6 + (F.wave - 2); task < 32 * NGRP; task += F.G * 6) ssm_run<true>(F, task & 255, task >> 8);
    }
    convert_weights(F, 0, F.G == 256 ? CI_GLU + CI_GU : CI_L0, F.vcu, F.G);
}

__device__ __forceinline__ void final_norm(Frame& F, const float* gain, const float* ssq, float* dst) {
    const float* X = (const float*)(F.ws + WS_XRES); const size_t NT = (size_t)F.G * NWAVES * 64, TOT = (size_t)M * (DM / 4);
    for (size_t base = (size_t)F.vcu * NWAVES * 64 + F.tid; base < TOT; base += 8 * NT) {
        f32x4 xv[8]; float sv[8];
#pragma unroll
        for (int u = 0; u < 8; ++u) { const size_t idx = base + u * NT; if (idx < TOT) { const int r = (int)(idx >> 10), c = 4 * (int)(idx & 1023); xv[u] = *(const GAS f32x4*)(X + (size_t)r * DM + c); sv[u] = ssq[r]; } }
#pragma unroll
        for (int u = 0; u < 8; ++u) { const size_t idx = base + u * NT; if (idx < TOT) { const int r = (int)(idx >> 10), c = 4 * (int)(idx & 1023);
            *(GAS f32x4*)(dst + (size_t)r * DM + c) = xv[u] * __builtin_amdgcn_rsqf(sv[u] * (1.0f / DM) + RMS_EPS) * *(const GAS f32x4*)(gain + c); } }
    }
}
template <int GI, int R, bool PROMPT> __device__ __forceinline__ void pool_elem_g(Frame& F, int vb, int nb) {
    constexpr int W = 2 << GI, NH = R + W - 1, RBASE = PROMPT ? 0 : MP, NROWS = PROMPT ? MP : MS;
    const float* X = (const float*)(F.ws + WS_XRES); const float* ssq1 = (const float*)(F.ctl + CW_SSQ) + M; const float* gain = F.in[I_NMIX] + DM;
    bf16* PP = (bf16*)(F.ws + WS_PPOOL);
    const size_t NT = (size_t)nb * NWAVES * 64;
    static_assert(PROMPT || R == DS, "a sample sequence is exactly one strip");
    for (size_t idx = (size_t)vb * NWAVES * 64 + F.tid; idx < (size_t)(NROWS / R) * 256; idx += NT) {
        const int r0 = RBASE + (int)(idx >> 8) * R, q = (int)(idx & 255), c = GI * 1024 + 4 * q;
        const f32x4 gv = *(const GAS f32x4*)(gain + c);
        constexpr bool prompt = PROMPT; const int t0 = prompt ? (r0 & (SEQ - 1)) : 0; const int b = (r0 - MP) >> 3;
        f32x4 hv[NH]; float sq[NH];
#pragma unroll
        for (int k = 0; k < NH; ++k) { const int d = k - (W - 1), tt = t0 + d; const bool inseq = tt >= 0;
            const float* src = inseq ? X + (size_t)(r0 + d) * DM + c : (prompt ? X + (size_t)r0 * DM + c : F.in[I_SPOOL] + ((size_t)b * PBUF + (PBUF + tt)) * DM + c);
            hv[k] = *(const GAS f32x4*)src; sq[k] = ssq1[inseq ? r0 + d : r0]; }
#pragma unroll
        for (int k = 0; k < NH; ++k) { const bool inseq = (t0 + k - (W - 1)) >= 0; const float rs = __builtin_amdgcn_rsqf(sq[k] * (1.0f / DM) + RMS_EPS);
            hv[k] = hv[k] * (inseq ? gv * rs : (prompt ? (f32x4){0.f, 0.f, 0.f, 0.f} : (f32x4){1.f, 1.f, 1.f, 1.f})); }
#pragma unroll
        for (int i = 0; i < R; ++i) { const int r = r0 + i, t = t0 + i; const f32x4 h = hv[i + W - 1]; f32x4 s = h;
#pragma unroll
            for (int j = 1; j < W; ++j) s += hv[i + W - 1 - j];
            const float cnt = prompt ? (float)((t + 1) < W ? (t + 1) : W) : (float)W;
            const f32x4 p = s / cnt - h;
            *(GAS unsigned long long*)(PP + ((size_t)GI * M + r) * 1024 + 4 * q) = (unsigned long long)cvtpk(p.x, p.y) | ((unsigned long long)cvtpk(p.z, p.w) << 32);
            if (prompt) { if (t >= SEQ - PBUF) *(GAS f32x4*)(F.out + O_PP + ((size_t)(r >> 11) * PBUF + (t - (SEQ - PBUF))) * DM + c) = h; }
            else { float* ob = F.out + O_PS + (size_t)b * PBUF * DM + c;
                *(GAS f32x4*)(ob + (size_t)(PBUF - DS + t) * DM) = h;
                if (t < PBUF - DS) *(GAS f32x4*)(ob + (size_t)t * DM) = *(const GAS f32x4*)(F.in[I_SPOOL] + ((size_t)b * PBUF + DS + t) * DM + c); } }
    }
}
__device__ __forceinline__ void pool_elem(Frame& F) {
    pool_elem_g<3, 8, true>(F, F.vcu, F.G); pool_elem_g<2, 16, true>(F, F.vcu, F.G); pool_elem_g<1, 16, true>(F, F.vcu, F.G); pool_elem_g<0, 16, true>(F, F.vcu, F.G);
    if (F.G % 4 == 0) { const int nb = F.G / 4, vb = F.vcu % nb;
        switch (F.vcu / nb) { case 0: pool_elem_g<0, 8, false>(F, vb, nb); break; case 1: pool_elem_g<1, 8, false>(F, vb, nb); break; case 2: pool_elem_g<2, 8, false>(F, vb, nb); break; default: pool_elem_g<3, 8, false>(F, vb, nb); break; } }
    else { pool_elem_g<0, 8, false>(F, F.vcu, F.G); pool_elem_g<1, 8, false>(F, F.vcu, F.G); pool_elem_g<2, 8, false>(F, F.vcu, F.G); pool_elem_g<3, 8, false>(F, F.vcu, F.G); }
}

__device__ __forceinline__ void down_phase(Frame& F, const unsigned char* wdn, float* ssq_l, int layer) {
    unsigned char* ws = F.ws;
    if (F.G == 256) {
        { pg8::Gemm g{(const pg8::bf16_t*)(ws + WS_HID), (const pg8::bf16_t*)wdn, MP, DM, DFF, 0}; pg8::MallOrder S; S.init(MP, DM, F.G, (int)blockIdx.x, 256, 2);
          pg8::EpiResid<false> E{(float*)(ws + WS_XRES), nullptr, nullptr, ssq_l, 36};
          pg8::gemm_phase<pg8::EpiResid<false>, pg8::MallOrder, PG8_ALIGN, PG8_SP2>(F.lds + RING_OFF, g, S, E); }
        const int c = (int)blockIdx.x, part = c >> 6, unit = (c & 7) * 8 + ((c >> 3) & 7);
        const int kt0 = part == 0 ? 0 : part == 1 ? 36 : part == 2 ? 82 : 128, ntp = part == 0 ? 36 : part == 3 ? 44 : 46;
        pg8::Gemm g{(const pg8::bf16_t*)(ws + WS_HID) + kt0 * 64, (const pg8::bf16_t*)wdn + kt0 * 64, M, DM, DFF, ntp};
        unsigned* ctr = (unsigned*)(F.ctl + CW_SPLIT) + (layer * 64 + unit) * 16;
        pg8::EpiResidSplit E{(float*)(ws + WS_XRES), ssq_l, (float*)(ws + WS_YSSM) + (size_t)unit * 3 * 65536, ctr, part};
        pg8::SplitOrder S{c, 32};
        pg8::gemm_phase<pg8::EpiResidSplit, pg8::SplitOrder, PG8_ALIGN, PG8_SP2>(F.lds + RING_OFF, g, S, E);
        if (part != 0) { __syncthreads();
            if (F.tid == 0) { __builtin_amdgcn_fence(__ATOMIC_RELEASE, "agent"); asm volatile("s_waitcnt vmcnt(0)" ::: "memory"); (void)__hip_atomic_fetch_add(ctr, 1u, __ATOMIC_RELAXED, __HIP_MEMORY_SCOPE_AGENT); } }
    } else {
        pg8::Gemm g{(const pg8::bf16_t*)(ws + WS_HID), (const pg8::bf16_t*)wdn, M, DM, DFF, 0}; pg8::MallOrder S; S.init(M, DM, F.G, (int)blockIdx.x, 192, 2);
        pg8::EpiResid<false> E{(float*)(ws + WS_XRES), nullptr, nullptr, ssq_l, 36};
        pg8::gemm_phase<pg8::EpiResid<false>, pg8::MallOrder, PG8_ALIGN, PG8_SP2, 3>(F.lds + RING_OFF, g, S, E);
    }
}

struct Args { const float* in[21]; float* out; unsigned char* ws; int ph_lo, ph_hi; };
__global__ void __launch_bounds__(NWAVES * 64, 2) skel_fwd(Args args) {
    extern __shared__ __attribute__((aligned(16))) unsigned char lds[];
    Frame F;
    F.lds = (LAS unsigned char*)lds;
    F.MISC = (volatile LAS unsigned*)(F.lds + MISC_OFF);
    F.tid = threadIdx.x; F.lane = F.tid & 63; F.wave = __builtin_amdgcn_readfirstlane(F.tid >> 6);
    F.G = gridDim.x; { const int bx = blockIdx.x; F.vcu = (F.G % 8 == 0) ? (bx % 8) * (F.G / 8) + bx / 8 : bx; }
    unsigned char* ws = args.ws; F.ws = ws; F.out = args.out;
    F.ctl = (gu32*)(ws + WS_CTL);
#pragma unroll
    for (int i = 0; i < 21; ++i) F.in[i] = args.in[i];
    for (int u = F.tid; u < (LDS_BYTES - LDSCTL_OFF) / 4; u += NWAVES * 64) ((LAS unsigned*)(F.lds + LDSCTL_OFF))[u] = 0u;
    __syncthreads();
    const int lo = args.ph_lo, hi = args.ph_hi;
    const bool use_bar = (hi - lo) > 1;
    XcdBarrier bar; bar.bar = (unsigned*)(F.ctl + CW_BAR); bar.x = 0; bar.st = nullptr;
    if (use_bar) bar = xcd_barrier_post((unsigned*)(F.ctl + CW_BAR), F.MISC + 8);
#define IN(k) (lo <= (k) && (k) < hi)
#define SEAM(k) do { if (IN(k) && IN((k) + 1)) xcd_barrier(bar); } while (0)

    float* ssq = (float*)(F.ctl + CW_SSQ);
    if (IN(0)) { p0_prologue(F); SEAM(0); }
    if (IN(1)) { p1_ssm(F); SEAM(1); }
    if (IN(2)) {
        pg8::Gemm g{(const pg8::bf16_t*)(ws + WS_YSSM), (const pg8::bf16_t*)(ws + WS_WGLU), M, 2 * DM, DM}; pg8::MallOrder S; S.init(M, 2 * DM, F.G, (int)blockIdx.x, 256, 1);
        pg8::EpiGlu E{F.in[I_XP], F.in[I_XS], (float*)(ws + WS_XRES), (pg8::bf16_t*)(ws + WS_HA), ssq};
        pg8::gemm_phase<pg8::EpiGlu, pg8::MallOrder, PG8_ALIGN, PG8_SP2>(F.lds + RING_OFF, g, S, E);
        { constexpr int NIDLE = 256 - (36 * 32) % 256, QUOTA = 60; const int j = (int)blockIdx.x - (256 - NIDLE);
          if (F.G == 256 && j >= 0) { convert_reset(F); convert_weights(F, CI_GLU + CI_GU, CI_L0, j, NIDLE); } }
        SEAM(2);
    }
    if (IN(3)) {
        pg8::Gemm g{(const pg8::bf16_t*)(ws + WS_HA), (const pg8::bf16_t*)(ws + WS_WGU0), M, 2 * DFF, DM}; pg8::MallOrder S; S.init(M, 2 * DFF, F.G, (int)blockIdx.x, 256, 1);
        pg8::EpiSwiglu E{(pg8::bf16_t*)(ws + WS_HID), DFF, ssq};
        pg8::gemm_phase<pg8::EpiSwiglu, pg8::MallOrder, PG8_ALIGN, PG8_SP2>(F.lds + RING_OFF, g, S, E);
        { constexpr int NIDLE = 256 - (36 * 86) % 256, LO = CI_L0 + 128 * 60, HI = CI_ALL - CI_DN; const int j = (int)blockIdx.x - (256 - NIDLE);
          if (F.G == 256) { if (j >= 0) { convert_reset(F); convert_weights(F, CI_L0, HI, j, NIDLE); } }
          else { convert_reset(F); convert_weights(F, CI_L0, HI, F.vcu, F.G); } }
        SEAM(3);
    }
    if (IN(4)) { down_phase(F, ws + WS_WDN0, ssq + M, 0); SEAM(4); }
    if (IN(5)) { pool_elem(F); SEAM(5); }
    if (IN(6)) {
        pg8::Gemm g{(const pg8::bf16_t*)(ws + WS_PPOOL), (const pg8::bf16_t*)(ws + WS_WPOOL), 4 * M, 4096, 1024}; pg8::PoolOrder S{F.G, (int)blockIdx.x, 48};
        pg8::EpiResid<true> E{(float*)(ws + WS_XRES), F.in[I_PSCALE], (pg8::bf16_t*)(ws + WS_HA), ssq + 2 * M, 48};
        pg8::gemm_phase<pg8::EpiResid<true>, pg8::PoolOrder, PG8_ALIGN, PG8_SP2, 3>(F.lds + RING_OFF, g, S, E);
        SEAM(6);
    }
    if (IN(7)) {
        pg8::Gemm g{(const pg8::bf16_t*)(ws + WS_HA), (const pg8::bf16_t*)(ws + WS_WGU1), M, 2 * DFF, DM};
        pg8::EpiSwiglu E{(pg8::bf16_t*)(ws + WS_HID), DFF, ssq + 2 * M};
        constexpr int NU = 36 * 86, NT = NU % 256;
        if (F.G == 256) {
            pg8::MallOrder S; S.init(M, 2 * DFF, F.G, (int)blockIdx.x, 256, 1, NU / 256);
            pg8::gemm_phase<pg8::EpiSwiglu, pg8::MallOrder, PG8_ALIGN, PG8_SP2>(F.lds + RING_OFF, g, S, E);
            pg8::TailOrder T{S, NT, NU / 256};
            pg8::gemm_phase<pg8::EpiSwiglu, pg8::TailOrder, PG8_ALIGN, PG8_SP2, 2>(F.lds + RING_OFF, g, T, E);
            const int j = (int)blockIdx.x - 2 * NT;
            if (j >= 0) { convert_reset(F); convert_weights(F, CI_ALL - CI_DN, CI_ALL, j, 256 - 2 * NT); }
        } else {
            pg8::MallOrder S; S.init(M, 2 * DFF, F.G, (int)blockIdx.x, 256, 1);
            pg8::gemm_phase<pg8::EpiSwiglu, pg8::MallOrder, PG8_ALIGN, PG8_SP2>(F.lds + RING_OFF, g, S, E);
            convert_reset(F); convert_weights(F, CI_ALL - CI_DN, CI_ALL, F.vcu, F.G);
        }
        SEAM(7);
    }
    if (IN(8)) { down_phase(F, ws + WS_WDN1, ssq + 3 * M, 1); SEAM(8); }
    if (IN(9)) { final_norm(F, F.in[I_NFIN], ssq + 3 * M, F.out + O_YP); }
#undef IN
#undef SEAM
}

extern "C" void kernel_launch(void* const* d_in, const int* in_sizes, int n_in, void* d_out, int out_size, void* d_ws, size_t ws_size, hipStream_t stream) {
    static int grid = 0;
    if (grid == 0) {
        if (n_in != 21 || in_sizes[0] != MP * DM || (size_t)out_size != O_END || ws_size < WS_END) { fprintf(stderr, "kernel_launch: unexpected shapes (n_in %d, in0 %d, out %d, ws %zu); nothing launched\n", n_in, n_in > 0 ? in_sizes[0] : -1, out_size, ws_size); grid = -1; return; }
        int dev = 0, cus = 0, per_cu = 0;
        if (hipGetDevice(&dev) != hipSuccess || hipDeviceGetAttribute(&cus, hipDeviceAttributeMultiprocessorCount, dev) != hipSuccess) { grid = -1; return; }
        if (hipFuncSetAttribute((const void*)skel_fwd, hipFuncAttributeMaxDynamicSharedMemorySize, LDS_BYTES) != hipSuccess) { fprintf(stderr, "kernel_launch: hipFuncSetAttribute failed\n"); grid = -1; return; }
        if (hipOccupancyMaxActiveBlocksPerMultiprocessor(&per_cu, (const void*)skel_fwd, NWAVES * 64, LDS_BYTES) != hipSuccess || per_cu < 1) { fprintf(stderr, "kernel_launch: occupancy query says %d blocks per CU\n", per_cu); }
        (void)hipGetLastError();
        grid = cus;
    }
    if (grid < 0) return;
    if (hipMemsetAsync((char*)d_ws + WS_CTL, 0, CTL_ZERO_BYTES, stream) != hipSuccess) return;
    Args a{};
    for (int i = 0; i < 21; ++i) a.in[i] = (const float*)d_in[i];
    a.out = (float*)d_out; a.ws = (unsigned char*)d_ws;
#if MK_ONE_LAUNCH
    a.ph_lo = 0; a.ph_hi = N_PHASES;
    hipLaunchKernelGGL(skel_fwd, dim3(grid), dim3(NWAVES * 64), LDS_BYTES, stream, a);
#else
    for (int ph = 0; ph < N_PHASES; ++ph) { a.ph_lo = ph; a.ph_hi = ph + 1; hipLaunchKernelGGL(skel_fwd, dim3(grid), dim3(NWAVES * 64), LDS_BYTES, stream, a); }
#endif
}
```

```cpp
#include <hip/hip_runtime.h>
#include <cstdio>
#include <cstdint>
namespace pg8 {
#define PG8_LAS __attribute__((address_space(3)))
typedef unsigned short bf16_t;
typedef short bf16x8 __attribute__((ext_vector_type(8)));
typedef float f32x4 __attribute__((ext_vector_type(4)));
typedef unsigned u32x4 __attribute__((ext_vector_type(4)));
constexpr int BM = 256, BK = 64, HALF = 128, HTB = HALF * BK * 2  , STAGE_BYTES = 8 * HTB, NXCD = 8, WGM = 8;

__host__ __device__ __forceinline__ int lds_byte(int r, int c) { const int st = (r >> 4) * 2 + (c >> 5), rr = r & 15, cc = c & 31, ob = rr * 64 + cc * 2; return st * 1024 + (ob ^ (((ob >> 9) & 1) << 5)); }
__host__ __device__ __forceinline__ void stage_rc(int b, int& R, int& C) { const int st = b / 1024, sb = b % 1024, swz = sb ^ (((sb >> 9) & 1) << 5); R = (st >> 1) * 16 + swz / 64; C = (st & 1) * 32 + (swz % 64) / 2; }
__host__ __device__ __forceinline__ int perm32(int rho) { const int n = rho >> 4, i = rho & 15; return 8 * (i >> 2) + 4 * n + (i & 3); }

struct Unit { int pm, pn; };
struct Gemm { const bf16_t* A; const bf16_t* Bt; int M, N, K; int nt; };

struct StaticOrder {
    int nM, nN, nwg, G, c;
    __host__ __device__ void init(int M, int N, int G_, int c_, int bm = BM) { nM = M / bm; nN = N / BM; nwg = nM * nN; G = G_; c = c_; }
    __host__ __device__ bool next(int i, Unit& u) const {
        const long L = (long)i * G + c; if (L >= nwg) return false;
        int wgid = (int)L; { const int q = nwg / NXCD, r = nwg % NXCD, xcd = wgid % NXCD, off = wgid / NXCD; wgid = (xcd < r ? xcd * (q + 1) : r * (q + 1) + (xcd - r) * q) + off; }
        const int nig = WGM * nN, gid = wgid / nig, fm = gid * WGM, gsz = (nM - fm) < WGM ? (nM - fm) : WGM;
        u.pm = fm + ((wgid % nig) % gsz); u.pn = (wgid % nig) / gsz; return true;
    }
    __device__ __forceinline__ void a_ready(const Unit&) const {}
    __device__ __forceinline__ void done(const Unit&) const {}
};

struct MallOrder {
    int nM, nN, G, c, XR, maxr;
    __host__ __device__ void init(int M, int N, int G_, int c_, int bm, int XR_, int maxr_ = 1 << 20) { nM = M / bm; nN = N / BM; G = G_; c = c_; XR = XR_; maxr = maxr_; }
    __host__ __device__ bool next(int i, Unit& u) const {
        constexpr int CW = 32; if (i >= maxr) return false;
        const int XC = NXCD / XR, x = c % NXCD, xr = x / XC, xc = x % XC;
        int q = i * (G / NXCD) + c / NXCD;
        for (int ch = 0; ch * CW < nN; ++ch) {
            const int cw = (nN - ch * CW) < CW ? (nN - ch * CW) : CW;
            for (int g = 0; g * XR * 8 < nM; ++g) {
                const int fm = (g * XR + xr) * 8, left = nM - fm, gsz = left < 0 ? 0 : (left < 8 ? left : 8), perg = gsz * cw / XC;
                if (q < perg) { const int uu = xc * perg + q; u.pm = fm + uu % gsz; u.pn = ch * CW + uu / gsz; return true; }
                q -= perg;
            }
        }
        return false;
    }
    __device__ __forceinline__ void a_ready(const Unit&) const {}
    __device__ __forceinline__ void done(const Unit&) const {}
};

struct TailOrder {
    MallOrder base; int nt, round;
    __host__ __device__ bool next(int i, Unit& u) const {
        if (i != 0 || base.c >= 2 * nt) return false;
        MallOrder b = base; b.c = base.c % nt; b.maxr = 1 << 20; Unit v; if (!b.next(round, v)) return false;
        u.pm = 2 * v.pm + base.c / nt; u.pn = v.pn; return true;
    }
    __device__ __forceinline__ void a_ready(const Unit&) const {}
    __device__ __forceinline__ void done(const Unit&) const {}
};


__device__ __forceinline__ unsigned cvt_pk_bf16(float lo, float hi) { unsigned r; asm volatile("v_cvt_pk_bf16_f32 %0, %1, %2" : "=v"(r) : "v"(lo), "v"(hi)); return r; }
__device__ __forceinline__ float sigmoid_f(float x) { return __builtin_amdgcn_rcpf(1.0f + __expf(-x)); }

__device__ __forceinline__ void ssq_add(float* ssq, int row, float s, int fq) {
    s += __shfl_xor(s, 16); s += __shfl_xor(s, 32);
    if (fq == 0) unsafeAtomicAdd(ssq + row, s);
}
__device__ __forceinline__ float rstd_of(const float* ssq, int row) { return __builtin_amdgcn_rsqf(ssq[row] * (1.0f / 4096.0f) + 1e-6f); }
struct EpiGlu {
    static constexpr bool PERM = false, AFTER_DRAIN = false;
    const float* xin_p; const float* xin_s; float* xout; bf16_t* xb; float* ssq;
    template <int MQ> __device__ __forceinline__ void operator()(const f32x4 (&acc)[2][2][MQ][2], const Unit& u, int wr, int wc, int fr, int fq) const {
        constexpr int MHALF = 32 * MQ; const int row0 = u.pm * (2 * MHALF) + wr * (16 * MQ) + fr, col0 = u.pn * HALF + wc * 32 + 4 * fq;
        const float* xi = (row0 < 8192) ? xin_p + (size_t)row0 * 4096 : xin_s + (size_t)(row0 - 8192) * 4096;
        float* ob = xout + (size_t)row0 * 4096; bf16_t* bb = xb + (size_t)row0 * 4096;
#pragma unroll
        for (int ai = 0; ai < 2; ++ai)
#pragma unroll
            for (int m = 0; m < MQ; ++m) { const size_t off = (size_t)(ai * MHALF + m * 16) * 4096 + col0; float sq = 0.f;
#pragma unroll
                for (int n = 0; n < 2; ++n) { const f32x4 xv = *(const f32x4*)(xi + off + 16 * n); const f32x4 a = acc[ai][0][m][n], b = acc[ai][1][m][n]; f32x4 o;
#pragma unroll
                    for (int j = 0; j < 4; ++j) { o[j] = xv[j] + a[j] * sigmoid_f(b[j]); sq = fmaf(o[j], o[j], sq); }
                    *(f32x4*)(ob + off + 16 * n) = o;
                    *(unsigned long long*)(bb + off + 16 * n) = (unsigned long long)cvt_pk_bf16(o[0], o[1]) | ((unsigned long long)cvt_pk_bf16(o[2], o[3]) << 32); }
                ssq_add(ssq, row0 + ai * MHALF + m * 16, sq, fq); }
    }
};
struct EpiSwiglu {
    static constexpr bool PERM = true, AFTER_DRAIN = false;
    bf16_t* O; int ldc; const float* ssq;
    template <int MQ> __device__ __forceinline__ void operator()(const f32x4 (&acc)[2][2][MQ][2], const Unit& u, int wr, int wc, int fr, int fq) const {
        constexpr int MHALF = 32 * MQ; const int row0 = u.pm * (2 * MHALF) + wr * (16 * MQ) + fr, col0 = u.pn * HALF + wc * 32 + 8 * fq;
#pragma unroll
        for (int ai = 0; ai < 2; ++ai)
#pragma unroll
            for (int m = 0; m < MQ; ++m) { const int r = row0 + ai * MHALF + m * 16; bf16_t* rowp = O + (size_t)r * ldc + col0; const float rs = rstd_of(ssq, r);
                f32x4 h[2];
#pragma unroll
                for (int n = 0; n < 2; ++n) { const f32x4 g = acc[ai][0][m][n] * rs, v = acc[ai][1][m][n] * rs;
#pragma unroll
                    for (int j = 0; j < 4; ++j) h[n][j] = g[j] * sigmoid_f(g[j]) * v[j]; }
                u32x4 w; w.x = cvt_pk_bf16(h[0][0], h[0][1]); w.y = cvt_pk_bf16(h[0][2], h[0][3]); w.z = cvt_pk_bf16(h[1][0], h[1][1]); w.w = cvt_pk_bf16(h[1][2], h[1][3]);
                *(u32x4*)rowp = w; }
    }
};
template <bool POOL> struct EpiResid {
    static constexpr bool PERM = false, AFTER_DRAIN = false;
    float* x; const float* scale; bf16_t* xb; float* ssq; int npm;
    template <int MQ> __device__ __forceinline__ void operator()(const f32x4 (&acc)[2][2][MQ][2], const Unit& u, int wr, int wc, int fr, int fq) const {
        constexpr int MHALF = 32 * MQ; const int pm = POOL ? (u.pm % npm) : u.pm;
        const int row0 = pm * (2 * MHALF) + wr * (16 * MQ) + fr, col0 = u.pn * BM + wc * 32 + 4 * fq;
        f32x4 sv[2][2];
#pragma unroll
        for (int bj = 0; bj < 2; ++bj)
#pragma unroll
            for (int n = 0; n < 2; ++n) sv[bj][n] = POOL ? *(const f32x4*)(scale + col0 + bj * HALF + n * 16) : (f32x4){1.f, 1.f, 1.f, 1.f};
#pragma unroll
        for (int ai = 0; ai < 2; ++ai)
#pragma unroll
            for (int m = 0; m < MQ; ++m) { const int r = row0 + ai * MHALF + m * 16; float* rowp = x + (size_t)r * 4096 + col0; float sq = 0.f;
#pragma unroll
                for (int bj = 0; bj < 2; ++bj)
#pragma unroll
                    for (int n = 0; n < 2; ++n) { const f32x4 xv = *(const f32x4*)(rowp + bj * HALF + n * 16);
                        const f32x4 o = POOL ? xv + acc[ai][bj][m][n] * sv[bj][n] : xv + acc[ai][bj][m][n];
                        sq += (o[0] * o[0] + o[1] * o[1]) + (o[2] * o[2] + o[3] * o[3]);
                        *(f32x4*)(rowp + bj * HALF + n * 16) = o;
                        if (POOL) *(unsigned long long*)(xb + (size_t)r * 4096 + col0 + bj * HALF + n * 16) = (unsigned long long)cvt_pk_bf16(o[0], o[1]) | ((unsigned long long)cvt_pk_bf16(o[2], o[3]) << 32); }
                ssq_add(ssq, r, sq, fq); }
    }
};
struct EpiResidSplit {
    static constexpr bool PERM = false, AFTER_DRAIN = false;
    float* x; float* ssq; float* slab; unsigned* ctr; int part;
    template <int MQ> __device__ __forceinline__ void operator()(const f32x4 (&acc)[2][2][MQ][2], const Unit& u, int wr, int wc, int fr, int fq) const {
        static_assert(MQ == 4, "split tail: 256-row tiles");
        const int tid = threadIdx.x;
        if (part != 0) {
            f32x4* sp = (f32x4*)slab + (size_t)(part - 1) * 16384 + tid;
#pragma unroll
            for (int ai = 0; ai < 2; ++ai)
#pragma unroll
                for (int bj = 0; bj < 2; ++bj)
#pragma unroll
                    for (int m = 0; m < 4; ++m)
#pragma unroll
                        for (int n = 0; n < 2; ++n) sp[(((ai * 2 + bj) * 4 + m) * 2 + n) * 512] = acc[ai][bj][m][n];
            return;
        }
        { unsigned sp = 0; while (__hip_atomic_load(ctr, __ATOMIC_RELAXED, __HIP_MEMORY_SCOPE_AGENT) < 3u && ++sp < (1u << 22)) __builtin_amdgcn_s_sleep(2); }
        __builtin_amdgcn_fence(__ATOMIC_ACQUIRE, "agent");
        const f32x4* sp = (const f32x4*)slab + tid;
        const int row0 = u.pm * 256 + wr * 64 + fr, col0 = u.pn * BM + wc * 32 + 4 * fq;
#pragma unroll
        for (int ai = 0; ai < 2; ++ai)
#pragma unroll
            for (int m = 0; m < 4; ++m) { const int r = row0 + ai * 128 + m * 16; float* rowp = x + (size_t)r * 4096 + col0; float sq = 0.f;
#pragma unroll
                for (int bj = 0; bj < 2; ++bj)
#pragma unroll
                    for (int n = 0; n < 2; ++n) { const int idx = (((ai * 2 + bj) * 4 + m) * 2 + n) * 512;
                        const f32x4 xv = *(const f32x4*)(rowp + bj * HALF + n * 16);
                        const f32x4 o = (xv + acc[ai][bj][m][n]) + ((sp[idx] + sp[16384 + idx]) + sp[32768 + idx]);
                        sq += (o[0] * o[0] + o[1] * o[1]) + (o[2] * o[2] + o[3] * o[3]);
                        *(f32x4*)(rowp + bj * HALF + n * 16) = o; }
                ssq_add(ssq, r, sq, fq); }
    }
};
struct SplitOrder {
    int c, pm0;
    __device__ bool next(int i, Unit& u) const { if (i != 0) return false; const int slot = (c >> 3) & 7; u.pm = pm0 + (slot & 3); u.pn = 2 * (c & 7) + (slot >> 2); return true; }
    __device__ __forceinline__ void a_ready(const Unit&) const {}
    __device__ __forceinline__ void done(const Unit&) const {}
};
struct PoolOrder {
    int G, c, npm;
    __device__ bool next(int i, Unit& u) const {
        const int per = npm * 4, L = i * G + c; if (L >= 4 * per) return false;
        const int grp = L / per, rem = L % per; u.pm = grp * npm + rem % npm; u.pn = grp * 4 + rem / npm; return true;
    }
    __device__ __forceinline__ void a_ready(const Unit&) const {}
    __device__ __forceinline__ void done(const Unit&) const {}
};

template <class Epi, class Sched, bool ALIGN_EPI = false, bool SP2 = false, int MQ = 4>
__device__ __forceinline__ void gemm_phase(PG8_LAS unsigned char* lds, const Gemm g, const Sched& S, const Epi& E) {
    const int tid = threadIdx.x, wid = __builtin_amdgcn_readfirstlane(tid >> 6), lane = tid & 63, wr = wid >> 2, wc = wid & 3, fr = lane & 15, fq = lane >> 4;
    static_assert(MQ == 4 || ((MQ == 3 || MQ == 2) && SP2), "192- and 128-row tiles: only the SP2 loop carries the wave-group-specific waits");
    const int K = g.K, nt = g.nt ? g.nt : K / BK;
    unsigned voffA[2], voffB[2];
#pragma unroll
    for (int i = 0; i < 2; ++i) { int R, C; stage_rc(tid * 16 + i * 8192, R, C); const int Rb = Epi::PERM ? ((R & ~31) + perm32(R & 31)) : R;
        voffA[i] = (unsigned)(R * K + C) * 2u; voffB[i] = (unsigned)(Rb * K + C) * 2u; }
    const size_t kstep = (size_t)(BK * 2);
    const size_t hstep = (size_t)HALF * K * 2, hstepA = (size_t)(32 * MQ) * K * 2;
    const size_t tstep = 2 * hstep, tstepA = 2 * hstepA;
    const unsigned ldsw = (unsigned)wid * 1024u;
    const int aoff = lds_byte(wr * (16 * MQ) + fr, fq * 8), boff = lds_byte(wc * 32 + fr, fq * 8);
#define PG8_SA(b, h) (((b) * 2 + (h)) * HTB)
#define PG8_SB(b, h) ((4 + (b) * 2 + (h)) * HTB)
#define PG8_STAGE(bufoff, gbase, voff) do { _Pragma("unroll") for (int _i = 0; _i < 2; ++_i) \
        __builtin_amdgcn_global_load_lds((const unsigned*)((const char*)(gbase) + (voff)[_i]), (PG8_LAS unsigned*)(lds + (bufoff) + ldsw + _i * 8192), 16, 0, 0); } while (0)
#define PG8_STAGE_A(bufoff, gbase) do { __builtin_amdgcn_global_load_lds((const unsigned*)((const char*)(gbase) + voffA[0]), (PG8_LAS unsigned*)(lds + (bufoff) + ldsw), 16, 0, 0); \
        if (MQ == 4 || (MQ == 3 && wid < 4)) __builtin_amdgcn_global_load_lds((const unsigned*)((const char*)(gbase) + voffA[1]), (PG8_LAS unsigned*)(lds + (bufoff) + ldsw + 8192), 16, 0, 0); } while (0)
#define PG8_LDA(dst, b, h) do { _Pragma("unroll") for (int m = 0; m < MQ; ++m) _Pragma("unroll") for (int k = 0; k < 2; ++k) dst[m][k] = *(const PG8_LAS bf16x8*)(lds + PG8_SA(b, h) + aoff + m * 2048 + k * 1024); } while (0)
#define PG8_LDB(dst, b, h) do { _Pragma("unroll") for (int n = 0; n < 2; ++n) _Pragma("unroll") for (int k = 0; k < 2; ++k) dst[n][k] = *(const PG8_LAS bf16x8*)(lds + PG8_SB(b, h) + boff + n * 2048 + k * 1024); } while (0)
#define PG8_MMA(ai, bj, At, Bt) do { __builtin_amdgcn_s_setprio(1); _Pragma("unroll") for (int m = 0; m < MQ; ++m) _Pragma("unroll") for (int n = 0; n < 2; ++n) _Pragma("unroll") for (int k = 0; k < 2; ++k) \
        acc[ai][bj][m][n] = __builtin_amdgcn_mfma_f32_16x16x32_bf16(Bt[n][k], At[m][k], acc[ai][bj][m][n], 0, 0, 0); __builtin_amdgcn_s_setprio(0); } while (0)
#define PG8_WAIT_V(n) asm volatile("s_waitcnt vmcnt(" #n ")" ::: "memory")
#define PG8_WAIT_V8 do { if (MQ == 2 || (MQ == 3 && wid >= 4)) PG8_WAIT_V(6); else PG8_WAIT_V(8); } while (0)
#define PG8_WAIT_L(n) asm volatile("s_waitcnt lgkmcnt(" #n ")" ::: "memory")
#define PG8_BAR __builtin_amdgcn_s_barrier()
#define PG8_SCHED __builtin_amdgcn_sched_barrier(0)
    Unit cur, nxt; int ui = 0;
    if (!S.next(0, cur)) return;
    f32x4 acc[2][2][MQ][2];
#pragma unroll
    for (int a = 0; a < 2; ++a)
#pragma unroll
        for (int b = 0; b < 2; ++b)
#pragma unroll
            for (int m = 0; m < MQ; ++m)
#pragma unroll
                for (int n = 0; n < 2; ++n) acc[a][b][m][n] = (f32x4){0.f, 0.f, 0.f, 0.f};
    bf16x8 At[MQ][2], B0[2][2], B1[2][2];
    const char* cA = (const char*)g.A + (size_t)cur.pm * tstepA; const char* cB = (const char*)g.Bt + (size_t)cur.pn * tstep;
    S.a_ready(cur);
    if constexpr (SP2) {
        PG8_STAGE(PG8_SB(0, 0), cB, voffB); PG8_STAGE(PG8_SB(0, 1), cB + hstep, voffB); PG8_STAGE_A(PG8_SA(0, 0), cA); PG8_STAGE_A(PG8_SA(0, 1), cA + hstepA);
        if (wr == 1) PG8_BAR;
        if (MQ == 2 || (MQ == 3 && wid >= 4)) PG8_WAIT_V(1); else PG8_WAIT_V(2);
        PG8_BAR;
        PG8_STAGE(PG8_SB(1, 0), cB + kstep, voffB); PG8_STAGE_A(PG8_SA(1, 0), cA + kstep); PG8_STAGE(PG8_SB(1, 1), cB + hstep + kstep, voffB);
        if (MQ == 2 || (MQ == 3 && wid >= 4)) PG8_WAIT_V(5); else PG8_WAIT_V(6);
        PG8_BAR;
    } else {
        PG8_STAGE(PG8_SB(0, 0), cB, voffB); PG8_STAGE_A(PG8_SA(0, 0), cA); PG8_STAGE(PG8_SB(0, 1), cB + hstep, voffB); PG8_STAGE_A(PG8_SA(0, 1), cA + hstepA);
        if (wr == 1) PG8_BAR;
        PG8_WAIT_V(4); PG8_BAR;
        PG8_STAGE(PG8_SB(1, 0), cB + kstep, voffB); PG8_STAGE_A(PG8_SA(1, 0), cA + kstep); PG8_STAGE(PG8_SB(1, 1), cB + hstep + kstep, voffB);
        PG8_WAIT_V(6); PG8_BAR;
    }
    for (;;) {
        const bool has_next = S.next(ui + 1, nxt);
        const char* nA = has_next ? (const char*)g.A + (size_t)nxt.pm * tstepA : cA; const char* nB = has_next ? (const char*)g.Bt + (size_t)nxt.pn * tstep : cB;
        for (int t = 0; t < nt; t += 2) {
            const bool last = (t == nt - 2);
            const char* a1 = cA + (size_t)(t + 1) * kstep;
            const char* a2 = last ? nA : cA + (size_t)(t + 2) * kstep; const char* b2 = last ? nB : cB + (size_t)(t + 2) * kstep;
            const char* a3 = a2 + kstep; const char* b3 = b2 + kstep;
            if (last && has_next) S.a_ready(nxt);
            if constexpr (SP2) {
            PG8_LDB(B0, 0, 0); PG8_LDB(B1, 0, 1); PG8_SCHED; PG8_LDA(At, 0, 0); PG8_STAGE_A(PG8_SA(1, 1), a1 + hstepA);
            PG8_WAIT_V8; PG8_WAIT_L(0); PG8_BAR; PG8_MMA(0, 0, At, B0); PG8_MMA(0, 1, At, B1); PG8_BAR; PG8_SCHED;
            PG8_LDA(At, 0, 1); PG8_STAGE(PG8_SB(0, 0), b2, voffB); PG8_STAGE(PG8_SB(0, 1), b2 + hstep, voffB); PG8_STAGE_A(PG8_SA(0, 0), a2);
            PG8_WAIT_V8; PG8_WAIT_L(0); PG8_BAR; PG8_MMA(1, 0, At, B0); PG8_MMA(1, 1, At, B1); PG8_BAR; PG8_SCHED;
            PG8_LDB(B0, 1, 0); PG8_LDB(B1, 1, 1); PG8_SCHED; PG8_LDA(At, 1, 0); PG8_STAGE_A(PG8_SA(0, 1), a2 + hstepA);
            PG8_WAIT_V8; PG8_WAIT_L(0); PG8_BAR; PG8_MMA(0, 0, At, B0); PG8_MMA(0, 1, At, B1); PG8_BAR; PG8_SCHED;
            PG8_LDA(At, 1, 1); PG8_STAGE(PG8_SB(1, 0), b3, voffB); PG8_STAGE(PG8_SB(1, 1), b3 + hstep, voffB); PG8_STAGE_A(PG8_SA(1, 0), a3);
            PG8_WAIT_V8; PG8_WAIT_L(0); PG8_BAR; PG8_MMA(1, 0, At, B0); PG8_MMA(1, 1, At, B1); PG8_BAR; PG8_SCHED;
            } else {
            PG8_LDB(B0, 0, 0); PG8_SCHED; PG8_LDA(At, 0, 0); PG8_STAGE_A(PG8_SA(1, 1), a1 + hstepA);
            PG8_WAIT_L(8); PG8_BAR; PG8_WAIT_L(0); PG8_MMA(0, 0, At, B0); PG8_BAR; PG8_SCHED;
            PG8_LDB(B1, 0, 1); PG8_STAGE(PG8_SB(0, 0), b2, voffB);
            PG8_BAR; PG8_WAIT_L(0); PG8_MMA(0, 1, At, B1); PG8_BAR;
            PG8_LDA(At, 0, 1); PG8_STAGE_A(PG8_SA(0, 0), a2);
            PG8_BAR; PG8_WAIT_L(0); PG8_MMA(1, 0, At, B0); PG8_BAR; PG8_SCHED;
            PG8_STAGE(PG8_SB(0, 1), b2 + hstep, voffB);
            PG8_WAIT_V(6); PG8_BAR; PG8_MMA(1, 1, At, B1); PG8_BAR;
            PG8_LDB(B0, 1, 0); PG8_SCHED; PG8_LDA(At, 1, 0); PG8_STAGE_A(PG8_SA(0, 1), a2 + hstepA);
            PG8_WAIT_L(8); PG8_BAR; PG8_WAIT_L(0); PG8_MMA(0, 0, At, B0); PG8_BAR; PG8_SCHED;
            PG8_LDB(B1, 1, 1); PG8_STAGE(PG8_SB(1, 0), b3, voffB);
            PG8_BAR; PG8_WAIT_L(0); PG8_MMA(0, 1, At, B1); PG8_BAR;
            PG8_LDA(At, 1, 1); PG8_STAGE_A(PG8_SA(1, 0), a3);
            PG8_BAR; PG8_WAIT_L(0); PG8_MMA(1, 0, At, B0); PG8_BAR; PG8_SCHED;
            PG8_STAGE(PG8_SB(1, 1), b3 + hstep, voffB);
            PG8_WAIT_V(6); PG8_BAR; PG8_MMA(1, 1, At, B1); PG8_BAR;
            }
        }
        if constexpr (ALIGN_EPI) { if (wr == 0) PG8_BAR; }
        if constexpr (!Epi::AFTER_DRAIN) { E(acc, cur, wr, wc, fr, fq); S.done(cur); }
        if (!has_next) break;
#pragma unroll
        for (int a = 0; a < 2; ++a)
#pragma unroll
            for (int b = 0; b < 2; ++b)
#pragma unroll
                for (int m = 0; m < MQ; ++m)
#pragma unroll
                    for (int n = 0; n < 2; ++n) acc[a][b][m][n] = (f32x4){0.f, 0.f, 0.f, 0.f};
        cur = nxt; cA = nA; cB = nB; ++ui;
        if constexpr (ALIGN_EPI) { if (wr == 1) PG8_BAR; }
    }
    PG8_WAIT_V(0);
    if constexpr (!ALIGN_EPI) { if (wr == 0) PG8_BAR; }
    PG8_BAR;
    if constexpr (Epi::AFTER_DRAIN) { E.fused(acc, cur, wr, wc, fr, fq, lds, wid, lane); S.done(cur); }
#undef PG8_SA
#undef PG8_SB
#undef PG8_STAGE
#undef PG8_LDA
#undef PG8_LDB
#undef PG8_MMA
#undef PG8_WAIT_V
#undef PG8_WAIT_V8
#undef PG8_STAGE_A
#undef PG8_WAIT_L
#undef PG8_BAR
#undef PG8_SCHED
}
}

#ifndef PG8_SP2
#define PG8_SP2 true
#endif
#ifndef PG8_ALIGN
#define PG8_ALIGN true
#endif
#ifndef MK_ONE_LAUNCH
#define MK_ONE_LAUNCH 1
#endif

constexpr int NWAVES = 8;
constexpr int DM = 4096, SEQ = 2048, NB = 4, DB = 128, DS = 8, MP = NB * SEQ, MS = DB * DS, M = MP + MS;
constexpr int DFF = 11008, NGRP = 256, NST = 64, NCH = 16, PBUF = 15;
constexpr float RMS_EPS = 1e-6f;
constexpr int N_PHASES = 10;
constexpr size_t O_YP = 0, O_YS = (size_t)MP * DM, O_SRP = O_YS + (size_t)MS * DM, O_SIP = O_SRP + (size_t)NB * NGRP * NST, O_PP = O_SIP + (size_t)NB * NGRP * NST,
                 O_SRS = O_PP + (size_t)NB * PBUF * DM, O_SIS = O_SRS + (size_t)DB * NGRP * NST, O_PS = O_SIS + (size_t)DB * NGRP * NST, O_END = O_PS + (size_t)DB * PBUF * DM;
constexpr size_t MiB = 1u << 20;
constexpr size_t WS_CTL = 0, CTL_ZERO_BYTES = 1 * MiB;
constexpr size_t WS_WGLU = 16 * MiB, WS_WGU0 = 80 * MiB, WS_WGU1 = 252 * MiB, WS_WDN0 = 424 * MiB, WS_WDN1 = 510 * MiB, WS_WPOOL = 596 * MiB;
constexpr size_t WS_XRES = 608 * MiB, WS_HA = 752 * MiB, WS_YSSM = 824 * MiB, WS_PPOOL = 896 * MiB, WS_HID = 968 * MiB, WS_SSMP = 1164 * MiB, WS_RSTD = 1169 * MiB, WS_END = 1170 * MiB;
static_assert(WS_WGLU + (size_t)2 * DM * DM * 2 <= WS_WGU0 && WS_WGU0 + (size_t)2 * DFF * DM * 2 <= WS_WGU1 && WS_WGU1 + (size_t)2 * DFF * DM * 2 <= WS_WDN0 && WS_WDN0 + (size_t)DM * DFF * 2 <= WS_WDN1 &&
              WS_WDN1 + (size_t)DM * DFF * 2 <= WS_WPOOL && WS_WPOOL + (size_t)4 * 1024 * 1024 * 2 <= WS_XRES && WS_XRES + (size_t)M * DM * 4 <= WS_HA && WS_HA + (size_t)M * DM * 2 <= WS_YSSM &&
              WS_YSSM + (size_t)M * DM * 2 <= WS_PPOOL && WS_PPOOL + (size_t)M * DM * 2 <= WS_HID && WS_HID + (size_t)M * DFF * 2 <= WS_SSMP, "d_ws map");
constexpr size_t SPB_AR = 0, SPB_AI = 65536, SPB_BF = 131072, SPB_CF = 131072 + 1048576;
constexpr int CW_BAR = 4096;
constexpr int CW_SPLIT = 65536;
constexpr int CW_SSQ = 16384;
constexpr int RING_OFF = 0, RING_BYTES = 131072;
constexpr int LDSCTL_OFF = RING_BYTES, MISC_OFF = LDSCTL_OFF + 320;
constexpr int LDS_BYTES = 147456;
static_assert(MISC_OFF + 128 <= LDS_BYTES, "LDS map");

#define GAS __attribute__((address_space(1)))
#define LAS __attribute__((address_space(3)))
typedef unsigned short bf16;
typedef unsigned v4u __attribute__((ext_vector_type(4)));
typedef float f32x4 __attribute__((ext_vector_type(4)));
typedef short bf16x8 __attribute__((ext_vector_type(8)));
typedef GAS unsigned gu32;
typedef GAS unsigned long long gu64;
#define RLX_AGENT __ATOMIC_RELAXED, __HIP_MEMORY_SCOPE_AGENT
#define LDS_WAIT() asm volatile("s_waitcnt lgkmcnt(0)" ::: "memory")
#define VM_WAIT() asm volatile("s_waitcnt vmcnt(0)" ::: "memory")
__device__ __forceinline__ unsigned long long rt() { return __builtin_amdgcn_s_memrealtime(); }
__device__ __forceinline__ unsigned f2bf(float f) { unsigned u = __builtin_bit_cast(unsigned, f); return (u + 0x7fffu + ((u >> 16) & 1u)) >> 16; }
__device__ __forceinline__ unsigned pk2(float lo, float hi) { return f2bf(lo) | (f2bf(hi) << 16); }

#define XB_TMO      128
#define XB_XCNT(j)  (256  + 64 * (j))
#define XB_XSUB(j)  (1280 + 64 * (j))
#define XB_XGEN(j)  (2304 + 64 * (j))
#define XB_TOP      3328
#define XB_TOPGEN   3392
#define XCD_BAR_WORDS 3456
#define XB_SPIN_CAP (1u << 18)

__device__ __forceinline__ unsigned xb_ld(unsigned* p)              { return __hip_atomic_load(p, __ATOMIC_RELAXED, __HIP_MEMORY_SCOPE_AGENT); }
__device__ __forceinline__ unsigned xb_add(unsigned* p, unsigned v) { return __hip_atomic_fetch_add(p, v, __ATOMIC_RELAXED, __HIP_MEMORY_SCOPE_AGENT); }
__device__ __forceinline__ unsigned xb_xcc_id() { return (unsigned)__builtin_amdgcn_s_getreg((3 << 11) | 20) & 0xFu; }
#define XB_SPIN(cond, bar) do { unsigned _sp = 0; while (cond) { __builtin_amdgcn_s_sleep(1); \
    if ((++_sp & 255u) == 0u) { if (xb_ld(&(bar)[XB_TMO])) break; if (_sp > XB_SPIN_CAP) { atomicAdd(&(bar)[XB_TMO], 1u); break; } } } } while (0)

struct XcdBarrier {
    unsigned* bar; unsigned x;
    volatile LAS unsigned* st;
};

__device__ __forceinline__ XcdBarrier xcd_barrier_post(unsigned* bar, volatile LAS unsigned* st) {
    XcdBarrier b; b.bar = bar; b.x = xb_xcc_id(); b.st = st;
    if (threadIdx.x == 0) (void)xb_add(&bar[XB_XCNT(b.x)], 1u);
    return b;
}
__device__ __forceinline__ void xcd_barrier_complete(unsigned* bar, unsigned x, unsigned& nloc, unsigned& nx) {
    const unsigned G = gridDim.x * gridDim.y * gridDim.z;
    unsigned sum, cnt, mine, sp = 0u;
    for (;;) {
        sum = 0u; cnt = 0u; mine = 0u;
#pragma unroll
        for (unsigned j = 0; j < 16; ++j) { const unsigned c = xb_ld(&bar[XB_XCNT(j)]); sum += c; cnt += (c > 0u) ? 1u : 0u; mine = (j == x) ? c : mine; }
        if (sum == G) break;
        __builtin_amdgcn_s_sleep(1);
        if ((++sp & 255u) == 0u) { if (xb_ld(&bar[XB_TMO])) break; if (sp > XB_SPIN_CAP) { atomicAdd(&bar[XB_TMO], 1u); break; } }
    }
    nloc = mine > 0u ? mine : 1u; nx = cnt > 0u ? cnt : 1u;
}

__device__ __forceinline__ void xcd_barrier(const XcdBarrier& b) {
    asm volatile("s_waitcnt vmcnt(0)" ::: "memory");
    __syncthreads();
    if (threadIdx.x == 0) {
        unsigned* bar = b.bar;
        __builtin_amdgcn_s_waitcnt(0);
        unsigned nloc = b.st[0], nx = b.st[1];
        if (nloc == 0u) { xcd_barrier_complete(bar, b.x, nloc, nx); b.st[0] = nloc; b.st[1] = nx; }
        const unsigned old = xb_add(&bar[XB_XSUB(b.x)], 1u);
        const unsigned gen = old / nloc;
        if (old + 1u == (gen + 1u) * nloc) {
            __builtin_amdgcn_fence(__ATOMIC_RELEASE, "agent");
            asm volatile("s_waitcnt vmcnt(0)" ::: "memory");
            const unsigned og = xb_add(&bar[XB_TOP], 1u);
            const unsigned tg = og / nx;
            if (og + 1u == (tg + 1u) * nx) xb_add(&bar[XB_TOPGEN], 1u);
            else XB_SPIN(xb_ld(&bar[XB_TOPGEN]) == tg, bar);
            __builtin_amdgcn_fence(__ATOMIC_ACQUIRE, "agent");
            xb_add(&bar[XB_XGEN(b.x)], 1u);
            asm volatile("s_waitcnt vmcnt(0)" ::: "memory");
        } else {
            XB_SPIN(xb_ld(&bar[XB_XGEN(b.x)]) == gen, bar);
            __builtin_amdgcn_fence(__ATOMIC_ACQUIRE, "agent");
            asm volatile("s_waitcnt vmcnt(0)" ::: "memory");
        }
    }
    __syncthreads();
}

struct Frame {
    LAS unsigned char* lds;
    volatile LAS unsigned* MISC;
    gu32* ctl;
    int tid, lane, wave;
    int vcu, G;
    const float* in[21];
    float* out;
    unsigned char* ws;
};
enum { I_XP = 0, I_XS, I_SRE, I_SIM, I_SPOOL, I_NMIX, I_NFFN, I_LRE, I_LIM, I_LSTEP, I_BRE, I_BIM, I_CRE, I_CIM, I_SD, I_WGLU, I_WPOOL, I_PSCALE, I_WGU, I_WDN, I_NFIN };

__device__ __forceinline__ float wave_sum(float v) {
#pragma unroll
    for (int o = 1; o < 64; o <<= 1) v += __shfl_xor(v, o);
    return v;
}
typedef float f32x2_t __attribute__((ext_vector_type(2)));
typedef __bf16 b16x2_t __attribute__((ext_vector_type(2)));
typedef float f32x16 __attribute__((ext_vector_type(16)));
__device__ __forceinline__ unsigned cvtpk(float lo, float hi) { return __builtin_bit_cast(unsigned, __builtin_convertvector((f32x2_t){lo, hi}, b16x2_t)); }
__device__ __forceinline__ const float* xrow_in(const Frame& F, int r) { return r < MP ? F.in[I_XP] + (size_t)r * DM : F.in[I_XS] + (size_t)(r - MP) * DM; }

__device__ __forceinline__ void tr_item(const float* W, int K, int N, bf16* WT, int k0, int n0, int drow0, int lane, const float* kgain = nullptr) {
    const int kq = lane >> 3, nq = lane & 7;
    f32x4 v[2][8];
#pragma unroll
    for (int h = 0; h < 2; ++h)
#pragma unroll
        for (int i = 0; i < 8; ++i) v[h][i] = *(const GAS f32x4*)(W + (size_t)(k0 + 8 * kq + i) * N + n0 + 32 * h + 4 * nq);
    if (kgain) {
        const f32x4 g0 = *(const GAS f32x4*)(kgain + k0 + 8 * kq), g1 = *(const GAS f32x4*)(kgain + k0 + 8 * kq + 4);
#pragma unroll
        for (int h = 0; h < 2; ++h)
#pragma unroll
            for (int i = 0; i < 8; ++i) v[h][i] = v[h][i] * (i < 4 ? g0[i & 3] : g1[i & 3]);
    }
#pragma unroll
    for (int h = 0; h < 2; ++h)
#pragma unroll
        for (int j = 0; j < 4; ++j) { v4u o; o.x = cvtpk(v[h][0][j], v[h][1][j]); o.y = cvtpk(v[h][2][j], v[h][3][j]); o.z = cvtpk(v[h][4][j], v[h][5][j]); o.w = cvtpk(v[h][6][j], v[h][7][j]);
            *(GAS v4u*)(WT + (size_t)(drow0 + 32 * h + 4 * nq + j) * K + k0 + 8 * kq) = o; }
}
__device__ __forceinline__ int drow_pair(int n0, int NH) { const int half = n0 >= NH ? 1 : 0, nn = n0 - half * NH; return 256 * (nn >> 7) + 128 * half + (nn & 127); }

__device__ __forceinline__ double exp_d(double x) {
    const double k = __builtin_rint(x * 1.4426950408889634074); const double r = x - k * 0.69314718055994530942;
    double s = 1.0, t = 1.0;
#pragma unroll
    for (int i = 1; i <= 16; ++i) { t *= r * (1.0 / (double)i); s += t; }
    const long long e = (long long)k + 1023; return s * __builtin_bit_cast(double, (unsigned long long)e << 52);
}
__device__ __forceinline__ void sincos_d(double th, double& sn, double& cs) {
    const double n = __builtin_rint(th * 0.15915494309189533577); const double r = (th - n * 6.283185307179586232) - n * 2.4492935982947064e-16; const double r2 = r * r;
    double s = r, c = 1.0, ts = r, tc = 1.0;
#pragma unroll
    for (int i = 1; i <= 15; ++i) { tc *= r2 * (-1.0 / (double)((2 * i - 1) * (2 * i))); ts *= r2 * (-1.0 / (double)((2 * i) * (2 * i + 1))); c += tc; s += ts; }
    sn = s; cs = c;
}

constexpr int CI_GLU = (DM / 64) * (2 * DM / 64), CI_GU = (DM / 64) * (2 * DFF / 64), CI_DN = (DFF / 64) * (DM / 64), CI_PL = 4 * 16 * 16;
constexpr int CI_L0 = CI_GLU + CI_GU + CI_DN, CI_ALL = CI_L0 + CI_GU + CI_DN + CI_PL;
__device__ __forceinline__ void convert_weights(Frame& F, int lo, int hi, int first, int step) {
    LAS unsigned* ctr = (LAS unsigned*)(F.lds + MISC_OFF + 80);
    for (;;) {
        unsigned k = 0; if (F.lane == 0) k = __hip_atomic_fetch_add(ctr, 1u, __ATOMIC_RELAXED, __HIP_MEMORY_SCOPE_WORKGROUP);
        k = (unsigned)__builtin_amdgcn_readfirstlane((int)k);
        const long itl = (long)lo + first + (long)step * k; if (itl >= hi) break;
        int r = (int)itl;
        if (r < CI_GLU) { const int nb = r % (2 * DM / 64), kb = r / (2 * DM / 64); tr_item(F.in[I_WGLU], DM, 2 * DM, (bf16*)(F.ws + WS_WGLU), kb * 64, nb * 64, drow_pair(nb * 64, DM), F.lane); continue; } r -= CI_GLU;
        if (r >= 2 * CI_GU + CI_DN && r < 2 * CI_GU + CI_DN + CI_PL) { r -= 2 * CI_GU + CI_DN; const int g = r / 256; r -= g * 256; const int nb = r % 16, kb = r / 16;
            tr_item(F.in[I_WPOOL] + (size_t)g * 1024 * 1024, 1024, 1024, (bf16*)(F.ws + WS_WPOOL) + (size_t)g * 1024 * 1024, kb * 64, nb * 64, nb * 64, F.lane); continue; }
        int l, isdn;
        if (r < CI_GU) { l = 0; isdn = 0; } else if (r < CI_GU + CI_DN) { r -= CI_GU; l = 0; isdn = 1; } else if (r < 2 * CI_GU + CI_DN) { r -= CI_GU + CI_DN; l = 1; isdn = 0; } else { r -= 2 * CI_GU + CI_DN + CI_PL; l = 1; isdn = 1; }
        if (!isdn) { const int nb = r % (2 * DFF / 64), kb = r / (2 * DFF / 64);
            tr_item(F.in[I_WGU] + (size_t)l * DM * 2 * DFF, DM, 2 * DFF, (bf16*)(F.ws + (l ? WS_WGU1 : WS_WGU0)), kb * 64, nb * 64, drow_pair(nb * 64, DFF), F.lane, F.in[I_NFFN] + l * DM); continue; }
        { const int nb = r % (DM / 64), kb = r / (DM / 64);
            tr_item(F.in[I_WDN] + (size_t)l * DFF * DM, DFF, DM, (bf16*)(F.ws + (l ? WS_WDN1 : WS_WDN0)), kb * 64, nb * 64, nb * 64, F.lane); }
    }
}
__device__ __forceinline__ void convert_reset(Frame& F) { __syncthreads(); if (F.tid == 0) *(LAS unsigned*)(F.lds + MISC_OFF + 80) = 0u; __syncthreads(); }
__device__ __forceinline__ void p0_prologue(Frame& F) {
    const int gw = F.vcu * NWAVES + F.wave, NGW = F.G * NWAVES;
    float* rstd0 = (float*)(F.ws + WS_RSTD);
    for (int r = gw; r < M; r += NGW) { const GAS f32x4* xr = (const GAS f32x4*)xrow_in(F, r) + F.lane; float s = 0.f;
#pragma unroll
        for (int j = 0; j < 16; ++j) { const f32x4 v = xr[64 * j]; s += (v.x * v.x + v.y * v.y) + (v.z * v.z + v.w * v.w); }
        s = wave_sum(s); if (F.lane == 0) rstd0[r] = 1.0f / sqrtf(s * (1.0f / DM) + RMS_EPS); }
    unsigned char* spb = F.ws + WS_SSMP;
    for (int idx = F.vcu * (NWAVES * 64) + F.tid; idx < NGRP * NST; idx += F.G * NWAVES * 64) {
        const int g = idx >> 6, p = idx & 63, ti = p >> 5, sl = p & 31;
        const double lr = (double)F.in[I_LRE][idx], li = (double)F.in[I_LIM][idx], dt = exp_d((double)F.in[I_LSTEP][g]);
        const double mag = exp_d(lr * dt); double sn, cs; sincos_d(li * dt, sn, cs);
        const double ar = mag * cs, ai = mag * sn, den = lr * lr + li * li;
        const double fr = ((ar - 1.0) * lr + ai * li) / den, fi = (ai * lr - (ar - 1.0) * li) / den;
        ((float*)(spb + SPB_AR))[idx] = (float)ar; ((float*)(spb + SPB_AI))[idx] = (float)ai;
#pragma unroll
        for (int hl = 0; hl < 2; ++hl) { float re[8], im[8];
#pragma unroll
            for (int c4 = 0; c4 < 2; ++c4) { const f32x4 br = *(const GAS f32x4*)(F.in[I_BRE] + (size_t)idx * 16 + 8 * hl + 4 * c4), bi = *(const GAS f32x4*)(F.in[I_BIM] + (size_t)idx * 16 + 8 * hl + 4 * c4);
                const f32x4 gn = *(const GAS f32x4*)(F.in[I_NMIX] + g * 16 + 8 * hl + 4 * c4);
#pragma unroll
                for (int j = 0; j < 4; ++j) { re[4 * c4 + j] = (float)((fr * (double)br[j] - fi * (double)bi[j]) * (double)gn[j]); im[4 * c4 + j] = (float)((fr * (double)bi[j] + fi * (double)br[j]) * (double)gn[j]); } }
            const int ln = 32 * hl + sl; v4u o;
            o.x = cvtpk(re[0], re[1]); o.y = cvtpk(re[2], re[3]); o.z = cvtpk(re[4], re[5]); o.w = cvtpk(re[6], re[7]);
            *(GAS v4u*)(spb + SPB_BF + ((size_t)(((g * 2 + ti) * 2 + 0) * 64 + ln)) * 16) = o;
            o.x = cvtpk(im[0], im[1]); o.y = cvtpk(im[2], im[3]); o.z = cvtpk(im[4], im[5]); o.w = cvtpk(im[6], im[7]);
            *(GAS v4u*)(spb + SPB_BF + ((size_t)(((g * 2 + ti) * 2 + 1) * 64 + ln)) * 16) = o; }
    }
    for (int idx = F.vcu * (NWAVES * 64) + F.tid; idx < NGRP * 4 * 64; idx += F.G * NWAVES * 64) {
        const int g = idx >> 8, ks = (idx >> 6) & 3, ln = idx & 63, q = ln >> 4, c = ln & 15, p0 = 16 * ks + 4 * q;
        const f32x4 cr = *(const GAS f32x4*)(F.in[I_CRE] + ((size_t)g * 16 + c) * NST + p0), ci = *(const GAS f32x4*)(F.in[I_CIM] + ((size_t)g * 16 + c) * NST + p0);
        v4u o; o.x = cvtpk(cr[0], -ci[0]); o.y = cvtpk(cr[1], -ci[1]); o.z = cvtpk(cr[2], -ci[2]); o.w = cvtpk(cr[3], -ci[3]);
        *(GAS v4u*)(spb + SPB_CF + (size_t)idx * 16) = o;
    }
}

__device__ __forceinline__ float gelu_tanh(float x) { const float z = 0.7978845608028654f * (x + 0.044715f * x * x * x); return x * __builtin_amdgcn_rcpf(1.0f + __expf(-2.0f * z)); }
template <bool SAMPLE>
__device__ __forceinline__ void ssm_run(Frame& F, int g, int sel) {
    const int lane = F.lane, hl = lane >> 5, sl = lane & 31, q = lane >> 4, cl = lane & 15;
    const unsigned char* spb = F.ws + WS_SSMP; const float* rstd0 = (const float*)(F.ws + WS_RSTD);
    bf16x8 bfr[2][2], cfr[4];
#pragma unroll
    for (int ti = 0; ti < 2; ++ti)
#pragma unroll
        for (int part = 0; part < 2; ++part) bfr[ti][part] = *(const GAS bf16x8*)(spb + SPB_BF + ((size_t)(((g * 2 + ti) * 2 + part) * 64 + lane)) * 16);
#pragma unroll
    for (int ks = 0; ks < 4; ++ks) cfr[ks] = *(const GAS bf16x8*)(spb + SPB_CF + ((size_t)((g * 4 + ks) * 64 + lane)) * 16);
    float ar[2], ai[2];
#pragma unroll
    for (int ti = 0; ti < 2; ++ti) { ar[ti] = ((const float*)(spb + SPB_AR))[g * NST + 32 * ti + sl]; ai[ti] = ((const float*)(spb + SPB_AI))[g * NST + 32 * ti + sl]; }
    const f32x4 dg = *(const GAS f32x4*)(F.in[I_SD] + g * 16 + 4 * q) * *(const GAS f32x4*)(F.in[I_NMIX] + g * 16 + 4 * q);
    const int hA = (sl >> 2) & 1, rA = (sl & 3) + 4 * (sl >> 3);
    const int hE = (cl >> 2) & 1, rE = (cl & 3) + 4 * (cl >> 3);
    LAS unsigned char* xl = F.lds + RING_OFF + F.wave * 8704;
    LAS unsigned* xw = (LAS unsigned*)(xl + hl * (4 * 272) + sl * 4);
    const LAS unsigned char* xrd = xl + cl * 272 + q * 16;
    int rowA, rowE[2], nch; float xr[2], xi[2], xr2[2], xi2[2]; float *o1r, *o1i, *o2r = nullptr, *o2i = nullptr;
    if constexpr (SAMPLE) { const int b0 = 4 * sel; nch = 1;
        rowA = MP + (b0 + 2 * hA + (rA >> 3)) * DS + (rA & 7); rowE[0] = MP + (b0 + 2 * hE) * DS + rE; rowE[1] = MP + (b0 + 2 * hE + 1) * DS + rE;
        const size_t s1 = ((size_t)(b0 + 2 * hl) * NGRP + g) * NST + sl, s2 = s1 + (size_t)NGRP * NST;
#pragma unroll
        for (int ti = 0; ti < 2; ++ti) { xr[ti] = F.in[I_SRE][s1 + 32 * ti]; xi[ti] = F.in[I_SIM][s1 + 32 * ti]; xr2[ti] = F.in[I_SRE][s2 + 32 * ti]; xi2[ti] = F.in[I_SIM][s2 + 32 * ti]; }
        o1r = F.out + O_SRS + s1; o1i = F.out + O_SIS + s1; o2r = F.out + O_SRS + s2; o2i = F.out + O_SIS + s2;
    } else { const int seq0 = 2 * sel; nch = SEQ / 16;
        rowA = (seq0 + hA) * SEQ + rA; rowE[0] = (seq0 + hE) * SEQ + rE; rowE[1] = rowE[0] + 8;
#pragma unroll
        for (int ti = 0; ti < 2; ++ti) { xr[ti] = 0.f; xi[ti] = 0.f; xr2[ti] = 0.f; xi2[ti] = 0.f; }
        const size_t s1 = ((size_t)(seq0 + hl) * NGRP + g) * NST + sl; o1r = F.out + O_SRP + s1; o1i = F.out + O_SIP + s1;
    }
    f32x16 zero16;
#pragma unroll
    for (int i = 0; i < 16; ++i) zero16[i] = 0.f;
    f32x4 nx0, nx1, nxe[2]; float nrs, nre[2];
    { const float* xp = xrow_in(F, rowA) + g * 16 + 8 * hl; nx0 = *(const GAS f32x4*)xp; nx1 = *(const GAS f32x4*)(xp + 4); nrs = rstd0[rowA];
#pragma unroll
      for (int rt = 0; rt < 2; ++rt) { nxe[rt] = *(const GAS f32x4*)(xrow_in(F, rowE[rt]) + g * 16 + 4 * q); nre[rt] = rstd0[rowE[rt]]; } }
    for (int ch = 0; ch < nch; ++ch) {
        const f32x4 x0 = nx0, x1 = nx1; const float rs = nrs;
        f32x4 xe[2]; float re[2];
#pragma unroll
        for (int rt = 0; rt < 2; ++rt) { xe[rt] = nxe[rt]; re[rt] = nre[rt]; }
        if (ch + 1 < nch) { const int ra = rowA + 16 * (ch + 1); const float* xp = xrow_in(F, ra) + g * 16 + 8 * hl; nx0 = *(const GAS f32x4*)xp; nx1 = *(const GAS f32x4*)(xp + 4); nrs = rstd0[ra];
#pragma unroll
            for (int rt = 0; rt < 2; ++rt) { const int r = rowE[rt] + 16 * (ch + 1); nxe[rt] = *(const GAS f32x4*)(xrow_in(F, r) + g * 16 + 4 * q); nre[rt] = rstd0[r]; } }
        v4u au; au.x = cvtpk(x0[0] * rs, x0[1] * rs); au.y = cvtpk(x0[2] * rs, x0[3] * rs); au.z = cvtpk(x1[0] * rs, x1[1] * rs); au.w = cvtpk(x1[2] * rs, x1[3] * rs);
        const bf16x8 afr = __builtin_bit_cast(bf16x8, au);
#pragma unroll
        for (int ti = 0; ti < 2; ++ti) {
            f32x16 dr = __builtin_amdgcn_mfma_f32_32x32x16_bf16(afr, bfr[ti][0], zero16, 0, 0, 0);
            f32x16 di = __builtin_amdgcn_mfma_f32_32x32x16_bf16(afr, bfr[ti][1], zero16, 0, 0, 0);
            float sr = xr[ti], si = xi[ti];
#pragma unroll
            for (int r = 0; r < 16; ++r) {
                if (SAMPLE && r == 8) { o1r[32 * ti] = sr; o1i[32 * ti] = si; sr = xr2[ti]; si = xi2[ti]; }
                const float nr = fmaf(-ai[ti], si, fmaf(ar[ti], sr, dr[r])), ni = fmaf(ai[ti], sr, fmaf(ar[ti], si, di[r])); sr = nr; si = ni;
                xw[(((r & 3) + 8 * (r >> 2)) * 272 + ti * 128) / 4] = cvtpk(sr, si);
            }
            xr[ti] = sr; xi[ti] = si;
        }
        asm volatile("s_waitcnt lgkmcnt(0)" ::: "memory"); __builtin_amdgcn_sched_barrier(0);
        f32x4 y[2];
#pragma unroll
        for (int rt = 0; rt < 2; ++rt) { y[rt] = (f32x4){0.f, 0.f, 0.f, 0.f};
#pragma unroll
            for (int ks = 0; ks < 4; ++ks) { const bf16x8 xf = *(const LAS bf16x8*)(xrd + rt * (16 * 272) + ks * 64); y[rt] = __builtin_amdgcn_mfma_f32_16x16x32_bf16(cfr[ks], xf, y[rt], 0, 0, 0); } }
        asm volatile("s_waitcnt lgkmcnt(0)" ::: "memory"); __builtin_amdgcn_sched_barrier(0);
#pragma unroll
        for (int rt = 0; rt < 2; ++rt) { const int r = rowE[rt] + 16 * ch; f32x4 v;
#pragma unroll
            for (int j = 0; j < 4; ++j) v[j] = gelu_tanh(y[rt][j] + dg[j] * (xe[rt][j] * re[rt]));
            *(GAS unsigned long long*)((bf16*)(F.ws + WS_YSSM) + (size_t)r * DM + g * 16 + 4 * q) = (unsigned long long)cvtpk(v[0], v[1]) | ((unsigned long long)cvtpk(v[2], v[3]) << 32); }
    }
    if constexpr (SAMPLE) {
#pragma unroll
        for (int ti = 0; ti < 2; ++ti) { o2r[32 * ti] = xr[ti]; o2i[32 * ti] = xi[ti]; }
    } else {
#pragma unroll
        for (int ti = 0; ti < 2; ++ti) { o1r[32 * ti] = xr[ti]; o1i[32 * ti] = xi[ti]; }
    }
}
__device__ __forceinline__ void p1_ssm(Frame& F) {
    if (F.wave < 2) {
        for (int task = F.vcu * 2 + F.wave; task < 2 * NGRP; task += F.G * 2) ssm_run<false>(F, task & 255, task >> 8);
    } else {
        for (int task = F.vcu * 6 + (F.wave - 2); task < 32 * NGRP; task += F.G * 6) ssm_run<true>(F, task & 255, task >> 8);
    }
    convert_weights(F, 0, F.G == 256 ? CI_GLU + CI_GU : CI_L0, F.vcu, F.G);
}

__device__ __forceinline__ void final_norm(Frame& F, const float* gain, const float* ssq, float* dst) {
    (void)ssq;
    const float* X = (const float*)(F.ws + WS_XRES); const int gw = F.vcu * NWAVES + F.wave, NGW = F.G * NWAVES;
    f32x4 v[16], w[16];
    if (gw < M) { const GAS f32x4* xr = (const GAS f32x4*)(X + (size_t)gw * DM) + F.lane;
#pragma unroll
        for (int u = 0; u < 16; ++u) v[u] = xr[64 * u]; }
    for (int r = gw; r < M; r += NGW) {
        const int rn = r + NGW;
        if (rn < M) { const GAS f32x4* xr = (const GAS f32x4*)(X + (size_t)rn * DM) + F.lane;
#pragma unroll
            for (int u = 0; u < 16; ++u) w[u] = xr[64 * u]; }
        float s = 0.f;
#pragma unroll
        for (int u = 0; u < 16; ++u) s += (v[u].x * v[u].x + v[u].y * v[u].y) + (v[u].z * v[u].z + v[u].w * v[u].w);
        s = wave_sum(s);
        const float rs = __builtin_amdgcn_rsqf(s * (1.0f / DM) + RMS_EPS);
        GAS f32x4* dr = (GAS f32x4*)(dst + (size_t)r * DM) + F.lane; const GAS f32x4* gr = (const GAS f32x4*)gain + F.lane;
#pragma unroll
        for (int u = 0; u < 16; ++u) dr[64 * u] = v[u] * rs * gr[64 * u];
#pragma unroll
        for (int u = 0; u < 16; ++u) v[u] = w[u];
    }
}
template <int GI, int R, bool PROMPT> __device__ __forceinline__ void pool_elem_g(Frame& F, int vb, int nb) {
    constexpr int W = 2 << GI, NH = R + W - 1, RBASE = PROMPT ? 0 : MP, NROWS = PROMPT ? MP : MS;
    const float* X = (const float*)(F.ws + WS_XRES); const float* ssq1 = (const float*)(F.ctl + CW_SSQ) + M; const float* gain = F.in[I_NMIX] + DM;
    bf16* PP = (bf16*)(F.ws + WS_PPOOL);
    const size_t NT = (size_t)nb * NWAVES * 64;
    static_assert(PROMPT || R == DS, "a sample sequence is exactly one strip");
    for (size_t idx = (size_t)vb * NWAVES * 64 + F.tid; idx < (size_t)(NROWS / R) * 256; idx += NT) {
        const int r0 = RBASE + (int)(idx >> 8) * R, q = (int)(idx & 255), c = GI * 1024 + 4 * q;
        const f32x4 gv = *(const GAS f32x4*)(gain + c);
        constexpr bool prompt = PROMPT; const int t0 = prompt ? (r0 & (SEQ - 1)) : 0; const int b = (r0 - MP) >> 3;
        f32x4 hv[NH]; float sq[NH];
#pragma unroll
        for (int k = 0; k < NH; ++k) { const int d = k - (W - 1), tt = t0 + d; const bool inseq = tt >= 0;
            const float* src = inseq ? X + (size_t)(r0 + d) * DM + c : (prompt ? X + (size_t)r0 * DM + c : F.in[I_SPOOL] + ((size_t)b * PBUF + (PBUF + tt)) * DM + c);
            hv[k] = *(const GAS f32x4*)src; sq[k] = ssq1[inseq ? r0 + d : r0]; }
#pragma unroll
        for (int k = 0; k < NH; ++k) { const bool inseq = (t0 + k - (W - 1)) >= 0; const float rs = __builtin_amdgcn_rsqf(sq[k] * (1.0f / DM) + RMS_EPS);
            hv[k] = hv[k] * (inseq ? gv * rs : (prompt ? (f32x4){0.f, 0.f, 0.f, 0.f} : (f32x4){1.f, 1.f, 1.f, 1.f})); }
#pragma unroll
        for (int i = 0; i < R; ++i) { const int r = r0 + i, t = t0 + i; const f32x4 h = hv[i + W - 1]; f32x4 s = h;
#pragma unroll
            for (int j = 1; j < W; ++j) s += hv[i + W - 1 - j];
            const float cnt = prompt ? (float)((t + 1) < W ? (t + 1) : W) : (float)W;
            const f32x4 p = s / cnt - h;
            *(GAS unsigned long long*)(PP + ((size_t)GI * M + r) * 1024 + 4 * q) = (unsigned long long)cvtpk(p.x, p.y) | ((unsigned long long)cvtpk(p.z, p.w) << 32);
            if (prompt) { if (t >= SEQ - PBUF) *(GAS f32x4*)(F.out + O_PP + ((size_t)(r >> 11) * PBUF + (t - (SEQ - PBUF))) * DM + c) = h; }
            else { float* ob = F.out + O_PS + (size_t)b * PBUF * DM + c;
                *(GAS f32x4*)(ob + (size_t)(PBUF - DS + t) * DM) = h;
                if (t < PBUF - DS) *(GAS f32x4*)(ob + (size_t)t * DM) = *(const GAS f32x4*)(F.in[I_SPOOL] + ((size_t)b * PBUF + DS + t) * DM + c); } }
    }
}
__device__ __forceinline__ void pool_elem(Frame& F) {
    pool_elem_g<3, 8, true>(F, F.vcu, F.G); pool_elem_g<2, 16, true>(F, F.vcu, F.G); pool_elem_g<1, 16, true>(F, F.vcu, F.G); pool_elem_g<0, 16, true>(F, F.vcu, F.G);
    if (F.G % 4 == 0) { const int nb = F.G / 4, vb = F.vcu % nb;
        switch (F.vcu / nb) { case 0: pool_elem_g<0, 8, false>(F, vb, nb); break; case 1: pool_elem_g<1, 8, false>(F, vb, nb); break; case 2: pool_elem_g<2, 8, false>(F, vb, nb); break; default: pool_elem_g<3, 8, false>(F, vb, nb); break; } }
    else { pool_elem_g<0, 8, false>(F, F.vcu, F.G); pool_elem_g<1, 8, false>(F, F.vcu, F.G); pool_elem_g<2, 8, false>(F, F.vcu, F.G); pool_elem_g<3, 8, false>(F, F.vcu, F.G); }
}

__device__ __forceinline__ void down_phase(Frame& F, const unsigned char* wdn, float* ssq_l, int layer) {
    unsigned char* ws = F.ws;
    if (F.G == 256) {
        { pg8::Gemm g{(const pg8::bf16_t*)(ws + WS_HID), (const pg8::bf16_t*)wdn, MP, DM, DFF, 0}; pg8::MallOrder S; S.init(MP, DM, F.G, (int)blockIdx.x, 256, 2);
          pg8::EpiResid<false> E{(float*)(ws + WS_XRES), nullptr, nullptr, ssq_l, 36};
          pg8::gemm_phase<pg8::EpiResid<false>, pg8::MallOrder, PG8_ALIGN, PG8_SP2>(F.lds + RING_OFF, g, S, E); }
        const int c = (int)blockIdx.x, part = c >> 6, unit = (c & 7) * 8 + ((c >> 3) & 7);
        const int kt0 = part == 0 ? 0 : part == 1 ? 36 : part == 2 ? 82 : 128, ntp = part == 0 ? 36 : part == 3 ? 44 : 46;
        pg8::Gemm g{(const pg8::bf16_t*)(ws + WS_HID) + kt0 * 64, (const pg8::bf16_t*)wdn + kt0 * 64, M, DM, DFF, ntp};
        unsigned* ctr = (unsigned*)(F.ctl + CW_SPLIT) + (layer * 64 + unit) * 16;
        pg8::EpiResidSplit E{(float*)(ws + WS_XRES), ssq_l, (float*)(ws + WS_YSSM) + (size_t)unit * 3 * 65536, ctr, part};
        pg8::SplitOrder S{c, 32};
        pg8::gemm_phase<pg8::EpiResidSplit, pg8::SplitOrder, PG8_ALIGN, PG8_SP2>(F.lds + RING_OFF, g, S, E);
        if (part != 0) { __syncthreads();
            if (F.tid == 0) { __builtin_amdgcn_fence(__ATOMIC_RELEASE, "agent"); asm volatile("s_waitcnt vmcnt(0)" ::: "memory"); (void)__hip_atomic_fetch_add(ctr, 1u, __ATOMIC_RELAXED, __HIP_MEMORY_SCOPE_AGENT); } }
    } else {
        pg8::Gemm g{(const pg8::bf16_t*)(ws + WS_HID), (const pg8::bf16_t*)wdn, M, DM, DFF, 0}; pg8::MallOrder S; S.init(M, DM, F.G, (int)blockIdx.x, 192, 2);
        pg8::EpiResid<false> E{(float*)(ws + WS_XRES), nullptr, nullptr, ssq_l, 36};
        pg8::gemm_phase<pg8::EpiResid<false>, pg8::MallOrder, PG8_ALIGN, PG8_SP2, 3>(F.lds + RING_OFF, g, S, E);
    }
}

struct Args { const float* in[21]; float* out; unsigned char* ws; int ph_lo, ph_hi; };
__global__ void __launch_bounds__(NWAVES * 64, 2) skel_fwd(Args args) {
    extern __shared__ __attribute__((aligned(16))) unsigned char lds[];
    Frame F;
    F.lds = (LAS unsigned char*)lds;
    F.MISC = (volatile LAS unsigned*)(F.lds + MISC_OFF);
    F.tid = threadIdx.x; F.lane = F.tid & 63; F.wave = __builtin_amdgcn_readfirstlane(F.tid >> 6);
    F.G = gridDim.x; { const int bx = blockIdx.x; F.vcu = (F.G % 8 == 0) ? (bx % 8) * (F.G / 8) + bx / 8 : bx; }
    unsigned char* ws = args.ws; F.ws = ws; F.out = args.out;
    F.ctl = (gu32*)(ws + WS_CTL);
#pragma unroll
    for (int i = 0; i < 21; ++i) F.in[i] = args.in[i];
    for (int u = F.tid; u < (LDS_BYTES - LDSCTL_OFF) / 4; u += NWAVES * 64) ((LAS unsigned*)(F.lds + LDSCTL_OFF))[u] = 0u;
    __syncthreads();
    const int lo = args.ph_lo, hi = args.ph_hi;
    const bool use_bar = (hi - lo) > 1;
    XcdBarrier bar; bar.bar = (unsigned*)(F.ctl + CW_BAR); bar.x = 0; bar.st = nullptr;
    if (use_bar) bar = xcd_barrier_post((unsigned*)(F.ctl + CW_BAR), F.MISC + 8);
#define IN(k) (lo <= (k) && (k) < hi)
#define SEAM(k) do { if (IN(k) && IN((k) + 1)) xcd_barrier(bar); } while (0)

    float* ssq = (float*)(F.ctl + CW_SSQ);
    if (IN(0)) { p0_prologue(F); SEAM(0); }
    if (IN(1)) { p1_ssm(F); SEAM(1); }
    if (IN(2)) {
        pg8::Gemm g{(const pg8::bf16_t*)(ws + WS_YSSM), (const pg8::bf16_t*)(ws + WS_WGLU), M, 2 * DM, DM}; pg8::MallOrder S; S.init(M, 2 * DM, F.G, (int)blockIdx.x, 256, 1);
        pg8::EpiGlu E{F.in[I_XP], F.in[I_XS], (float*)(ws + WS_XRES), (pg8::bf16_t*)(ws + WS_HA), ssq};
        pg8::gemm_phase<pg8::EpiGlu, pg8::MallOrder, PG8_ALIGN, PG8_SP2>(F.lds + RING_OFF, g, S, E);
        { constexpr int NIDLE = 256 - (36 * 32) % 256, QUOTA = 60; const int j = (int)blockIdx.x - (256 - NIDLE);
          if (F.G == 256 && j >= 0) { convert_reset(F); convert_weights(F, CI_GLU + CI_GU, CI_L0, j, NIDLE); } }
        SEAM(2);
    }
    if (IN(3)) {
        pg8::Gemm g{(const pg8::bf16_t*)(ws + WS_HA), (const pg8::bf16_t*)(ws + WS_WGU0), M, 2 * DFF, DM}; pg8::MallOrder S; S.init(M, 2 * DFF, F.G, (int)blockIdx.x, 256, 1);
        pg8::EpiSwiglu E{(pg8::bf16_t*)(ws + WS_HID), DFF, ssq};
        pg8::gemm_phase<pg8::EpiSwiglu, pg8::MallOrder, PG8_ALIGN, PG8_SP2>(F.lds + RING_OFF, g, S, E);
        { constexpr int NIDLE = 256 - (36 * 86) % 256, LO = CI_L0 + 128 * 60, HI = CI_ALL - CI_DN; const int j = (int)blockIdx.x - (256 - NIDLE);
          if (F.G == 256) { if (j >= 0) { convert_reset(F); convert_weights(F, CI_L0, HI, j, NIDLE); } }
          else { convert_reset(F); convert_weights(F, CI_L0, HI, F.vcu, F.G); } }
        SEAM(3);
    }
    if (IN(4)) { down_phase(F, ws + WS_WDN0, ssq + M, 0); SEAM(4); }
    if (IN(5)) { pool_elem(F); SEAM(5); }
    if (IN(6)) {
        pg8::Gemm g{(const pg8::bf16_t*)(ws + WS_PPOOL), (const pg8::bf16_t*)(ws + WS_WPOOL), 4 * M, 4096, 1024}; pg8::PoolOrder S{F.G, (int)blockIdx.x, 48};
        pg8::EpiResid<true> E{(float*)(ws + WS_XRES), F.in[I_PSCALE], (pg8::bf16_t*)(ws + WS_HA), ssq + 2 * M, 48};
        pg8::gemm_phase<pg8::EpiResid<true>, pg8::PoolOrder, PG8_ALIGN, PG8_SP2, 3>(F.lds + RING_OFF, g, S, E);
        SEAM(6);
    }
    if (IN(7)) {
        pg8::Gemm g{(const pg8::bf16_t*)(ws + WS_HA), (const pg8::bf16_t*)(ws + WS_WGU1), M, 2 * DFF, DM};
        pg8::EpiSwiglu E{(pg8::bf16_t*)(ws + WS_HID), DFF, ssq + 2 * M};
        constexpr int NU = 36 * 86, NT = NU % 256;
        if (F.G == 256) {
            pg8::MallOrder S; S.init(M, 2 * DFF, F.G, (int)blockIdx.x, 256, 1, NU / 256);
            pg8::gemm_phase<pg8::EpiSwiglu, pg8::MallOrder, PG8_ALIGN, PG8_SP2>(F.lds + RING_OFF, g, S, E);
            pg8::TailOrder T{S, NT, NU / 256};
            pg8::gemm_phase<pg8::EpiSwiglu, pg8::TailOrder, PG8_ALIGN, PG8_SP2, 2>(F.lds + RING_OFF, g, T, E);
            const int j = (int)blockIdx.x - 2 * NT;
            if (j >= 0) { convert_reset(F); convert_weights(F, CI_ALL - CI_DN, CI_ALL, j, 256 - 2 * NT); }
        } else {
            pg8::MallOrder S; S.init(M, 2 * DFF, F.G, (int)blockIdx.x, 256, 1);
            pg8::gemm_phase<pg8::EpiSwiglu, pg8::MallOrder, PG8_ALIGN, PG8_SP2>(F.lds + RING_OFF, g, S, E);
            convert_reset(F); convert_weights(F, CI_ALL - CI_DN, CI_ALL, F.vcu, F.G);
        }
        SEAM(7);
    }
    if (IN(8)) { down_phase(F, ws + WS_WDN1, ssq + 3 * M, 1); SEAM(8); }
    if (IN(9)) { final_norm(F, F.in[I_NFIN], ssq + 3 * M, F.out + O_YP); }
#undef IN
#undef SEAM
}

extern "C" void kernel_launch(void* const* d_in, const int* in_sizes, int n_in, void* d_out, int out_size, void* d_ws, size_t ws_size, hipStream_t stream) {
    static int grid = 0;
    if (grid == 0) {
        if (n_in != 21 || in_sizes[0] != MP * DM || (size_t)out_size != O_END || ws_size < WS_END) { fprintf(stderr, "kernel_launch: unexpected shapes (n_in %d, in0 %d, out %d, ws %zu); nothing launched\n", n_in, n_in > 0 ? in_sizes[0] : -1, out_size, ws_size); grid = -1; return; }
        int dev = 0, cus = 0, per_cu = 0;
        if (hipGetDevice(&dev) != hipSuccess || hipDeviceGetAttribute(&cus, hipDeviceAttributeMultiprocessorCount, dev) != hipSuccess) { grid = -1; return; }
        if (hipFuncSetAttribute((const void*)skel_fwd, hipFuncAttributeMaxDynamicSharedMemorySize, LDS_BYTES) != hipSuccess) { fprintf(stderr, "kernel_launch: hipFuncSetAttribute failed\n"); grid = -1; return; }
        if (hipOccupancyMaxActiveBlocksPerMultiprocessor(&per_cu, (const void*)skel_fwd, NWAVES * 64, LDS_BYTES) != hipSuccess || per_cu < 1) { fprintf(stderr, "kernel_launch: occupancy query says %d blocks per CU\n", per_cu); }
        (void)hipGetLastError();
        grid = cus;
    }
    if (grid < 0) return;
    if (hipMemsetAsync((char*)d_ws + WS_CTL, 0, CTL_ZERO_BYTES, stream) != hipSuccess) return;
    Args a{};
    for (int i = 0; i < 21; ++i) a.in[i] = (const float*)d_in[i];
    a.out = (float*)d_out; a.ws = (unsigned char*)d_ws;
#if MK_ONE_LAUNCH
    a.ph_lo = 0; a.ph_hi = N_PHASES;
    hipLaunchKernelGGL(skel_fwd, dim3(grid), dim3(NWAVES * 64), LDS_BYTES, stream, a);
#else
    for (int ph = 0; ph < N_PHASES; ++ph) { a.ph_lo = ph; a.ph_hi = ph + 1; hipLaunchKernelGGL(skel_fwd, dim3(grid), dim3(NWAVES * 64), LDS_BYTES, stream, a); }
#endif
}
```

```cpp
#include <hip/hip_runtime.h>
#include <cstdio>
#include <cstdint>
namespace pg8 {
#define PG8_LAS __attribute__((address_space(3)))
typedef unsigned short bf16_t;
typedef short bf16x8 __attribute__((ext_vector_type(8)));
typedef float f32x4 __attribute__((ext_vector_type(4)));
typedef unsigned u32x4 __attribute__((ext_vector_type(4)));
constexpr int BM = 256, BK = 64, HALF = 128, HTB = HALF * BK * 2  , STAGE_BYTES = 8 * HTB, NXCD = 8, WGM = 8;

__host__ __device__ __forceinline__ int lds_byte(int r, int c) { const int st = (r >> 4) * 2 + (c >> 5), rr = r & 15, cc = c & 31, ob = rr * 64 + cc * 2; return st * 1024 + (ob ^ (((ob >> 9) & 1) << 5)); }
__host__ __device__ __forceinline__ void stage_rc(int b, int& R, int& C) { const int st = b / 1024, sb = b % 1024, swz = sb ^ (((sb >> 9) & 1) << 5); R = (st >> 1) * 16 + swz / 64; C = (st & 1) * 32 + (swz % 64) / 2; }
__host__ __device__ __forceinline__ int perm32(int rho) { const int n = rho >> 4, i = rho & 15; return 8 * (i >> 2) + 4 * n + (i & 3); }

struct Unit { int pm, pn; };
struct Gemm { const bf16_t* A; const bf16_t* Bt; int M, N, K; int nt; };

struct StaticOrder {
    int nM, nN, nwg, G, c;
    __host__ __device__ void init(int M, int N, int G_, int c_, int bm = BM) { nM = M / bm; nN = N / BM; nwg = nM * nN; G = G_; c = c_; }
    __host__ __device__ bool next(int i, Unit& u) const {
        const long L = (long)i * G + c; if (L >= nwg) return false;
        int wgid = (int)L; { const int q = nwg / NXCD, r = nwg % NXCD, xcd = wgid % NXCD, off = wgid / NXCD; wgid = (xcd < r ? xcd * (q + 1) : r * (q + 1) + (xcd - r) * q) + off; }
        const int nig = WGM * nN, gid = wgid / nig, fm = gid * WGM, gsz = (nM - fm) < WGM ? (nM - fm) : WGM;
        u.pm = fm + ((wgid % nig) % gsz); u.pn = (wgid % nig) / gsz; return true;
    }
    __device__ __forceinline__ void a_ready(const Unit&) const {}
    __device__ __forceinline__ void done(const Unit&) const {}
};

struct MallOrder {
    int nM, nN, G, c, XR, maxr;
    __host__ __device__ void init(int M, int N, int G_, int c_, int bm, int XR_, int maxr_ = 1 << 20) { nM = M / bm; nN = N / BM; G = G_; c = c_; XR = XR_; maxr = maxr_; }
    __host__ __device__ bool next(int i, Unit& u) const {
        constexpr int CW = 32; if (i >= maxr) return false;
        const int XC = NXCD / XR, x = c % NXCD, xr = x / XC, xc = x % XC;
        int q = i * (G / NXCD) + c / NXCD;
        for (int ch = 0; ch * CW < nN; ++ch) {
            const int cw = (nN - ch * CW) < CW ? (nN - ch * CW) : CW;
            for (int g = 0; g * XR * 8 < nM; ++g) {
                const int fm = (g * XR + xr) * 8, left = nM - fm, gsz = left < 0 ? 0 : (left < 8 ? left : 8), perg = gsz * cw / XC;
                if (q < perg) { const int uu = xc * perg + q; u.pm = fm + uu % gsz; u.pn = ch * CW + uu / gsz; return true; }
                q -= perg;
            }
        }
        return false;
    }
    __device__ __forceinline__ void a_ready(const Unit&) const {}
    __device__ __forceinline__ void done(const Unit&) const {}
};

struct TailOrder {
    MallOrder base; int nt, round;
    __host__ __device__ bool next(int i, Unit& u) const {
        if (i != 0 || base.c >= 2 * nt) return false;
        MallOrder b = base; b.c = base.c % nt; b.maxr = 1 << 20; Unit v; if (!b.next(round, v)) return false;
        u.pm = 2 * v.pm + base.c / nt; u.pn = v.pn; return true;
    }
    __device__ __forceinline__ void a_ready(const Unit&) const {}
    __device__ __forceinline__ void done(const Unit&) const {}
};


__device__ __forceinline__ unsigned cvt_pk_bf16(float lo, float hi) { unsigned r; asm volatile("v_cvt_pk_bf16_f32 %0, %1, %2" : "=v"(r) : "v"(lo), "v"(hi)); return r; }
__device__ __forceinline__ float sigmoid_f(float x) { return __builtin_amdgcn_rcpf(1.0f + __expf(-x)); }

__device__ __forceinline__ void ssq_add(float* ssq, int row, float s, int fq) {
    s += __shfl_xor(s, 16); s += __shfl_xor(s, 32);
    if (fq == 0) unsafeAtomicAdd(ssq + row, s);
}
__device__ __forceinline__ float rstd_of(const float* ssq, int row) { return __builtin_amdgcn_rsqf(ssq[row] * (1.0f / 4096.0f) + 1e-6f); }
struct EpiGlu {
    static constexpr bool PERM = false, AFTER_DRAIN = false;
    const float* xin_p; const float* xin_s; float* xout; bf16_t* xb; float* ssq;
    template <int MQ> __device__ __forceinline__ void operator()(const f32x4 (&acc)[2][2][MQ][2], const Unit& u, int wr, int wc, int fr, int fq) const {
        constexpr int MHALF = 32 * MQ; const int row0 = u.pm * (2 * MHALF) + wr * (16 * MQ) + fr, col0 = u.pn * HALF + wc * 32 + 4 * fq;
        const float* xi = (row0 < 8192) ? xin_p + (size_t)row0 * 4096 : xin_s + (size_t)(row0 - 8192) * 4096;
        float* ob = xout + (size_t)row0 * 4096; bf16_t* bb = xb + (size_t)row0 * 4096;
#pragma unroll
        for (int ai = 0; ai < 2; ++ai)
#pragma unroll
            for (int m = 0; m < MQ; ++m) { const size_t off = (size_t)(ai * MHALF + m * 16) * 4096 + col0; float sq = 0.f;
#pragma unroll
                for (int n = 0; n < 2; ++n) { const f32x4 xv = *(const f32x4*)(xi + off + 16 * n); const f32x4 a = acc[ai][0][m][n], b = acc[ai][1][m][n]; f32x4 o;
#pragma unroll
                    for (int j = 0; j < 4; ++j) { o[j] = xv[j] + a[j] * sigmoid_f(b[j]); sq = fmaf(o[j], o[j], sq); }
                    *(f32x4*)(ob + off + 16 * n) = o;
                    *(unsigned long long*)(bb + off + 16 * n) = (unsigned long long)cvt_pk_bf16(o[0], o[1]) | ((unsigned long long)cvt_pk_bf16(o[2], o[3]) << 32); }
                ssq_add(ssq, row0 + ai * MHALF + m * 16, sq, fq); }
    }
};
struct EpiSwiglu {
    static constexpr bool PERM = true, AFTER_DRAIN = false;
    bf16_t* O; int ldc; const float* ssq;
    template <int MQ> __device__ __forceinline__ void operator()(const f32x4 (&acc)[2][2][MQ][2], const Unit& u, int wr, int wc, int fr, int fq) const {
        constexpr int MHALF = 32 * MQ; const int row0 = u.pm * (2 * MHALF) + wr * (16 * MQ) + fr, col0 = u.pn * HALF + wc * 32 + 8 * fq;
#pragma unroll
        for (int ai = 0; ai < 2; ++ai)
#pragma unroll
            for (int m = 0; m < MQ; ++m) { const int r = row0 + ai * MHALF + m * 16; bf16_t* rowp = O + (size_t)r * ldc + col0; const float rs = rstd_of(ssq, r);
                f32x4 h[2];
#pragma unroll
                for (int n = 0; n < 2; ++n) { const f32x4 g = acc[ai][0][m][n] * rs, v = acc[ai][1][m][n] * rs;
#pragma unroll
                    for (int j = 0; j < 4; ++j) h[n][j] = g[j] * sigmoid_f(g[j]) * v[j]; }
                u32x4 w; w.x = cvt_pk_bf16(h[0][0], h[0][1]); w.y = cvt_pk_bf16(h[0][2], h[0][3]); w.z = cvt_pk_bf16(h[1][0], h[1][1]); w.w = cvt_pk_bf16(h[1][2], h[1][3]);
                *(u32x4*)rowp = w; }
    }
};
template <bool POOL> struct EpiResid {
    static constexpr bool PERM = false, AFTER_DRAIN = false;
    float* x; const float* scale; bf16_t* xb; float* ssq; int npm;
    template <int MQ> __device__ __forceinline__ void operator()(const f32x4 (&acc)[2][2][MQ][2], const Unit& u, int wr, int wc, int fr, int fq) const {
        constexpr int MHALF = 32 * MQ; const int pm = POOL ? (u.pm % npm) : u.pm;
        const int row0 = pm * (2 * MHALF) + wr * (16 * MQ) + fr, col0 = u.pn * BM + wc * 32 + 4 * fq;
        f32x4 sv[2][2];
#pragma unroll
        for (int bj = 0; bj < 2; ++bj)
#pragma unroll
            for (int n = 0; n < 2; ++n) sv[bj][n] = POOL ? *(const f32x4*)(scale + col0 + bj * HALF + n * 16) : (f32x4){1.f, 1.f, 1.f, 1.f};
#pragma unroll
        for (int ai = 0; ai < 2; ++ai)
#pragma unroll
            for (int m = 0; m < MQ; ++m) { const int r = row0 + ai * MHALF + m * 16; float* rowp = x + (size_t)r * 4096 + col0; float sq = 0.f;
#pragma unroll
                for (int bj = 0; bj < 2; ++bj)
#pragma unroll
                    for (int n = 0; n < 2; ++n) { const f32x4 xv = *(const f32x4*)(rowp + bj * HALF + n * 16);
                        const f32x4 o = POOL ? xv + acc[ai][bj][m][n] * sv[bj][n] : xv + acc[ai][bj][m][n];
                        sq += (o[0] * o[0] + o[1] * o[1]) + (o[2] * o[2] + o[3] * o[3]);
                        *(f32x4*)(rowp + bj * HALF + n * 16) = o;
                        if (POOL) *(unsigned long long*)(xb + (size_t)r * 4096 + col0 + bj * HALF + n * 16) = (unsigned long long)cvt_pk_bf16(o[0], o[1]) | ((unsigned long long)cvt_pk_bf16(o[2], o[3]) << 32); }
                ssq_add(ssq, r, sq, fq); }
    }
};
struct EpiResidSplit {
    static constexpr bool PERM = false, AFTER_DRAIN = false;
    float* x; float* ssq; float* slab; unsigned* ctr; int part;
    template <int MQ> __device__ __forceinline__ void operator()(const f32x4 (&acc)[2][2][MQ][2], const Unit& u, int wr, int wc, int fr, int fq) const {
        static_assert(MQ == 4, "split tail: 256-row tiles");
        const int tid = threadIdx.x;
        if (part != 0) {
            f32x4* sp = (f32x4*)slab + (size_t)(part - 1) * 16384 + tid;
#pragma unroll
            for (int ai = 0; ai < 2; ++ai)
#pragma unroll
                for (int bj = 0; bj < 2; ++bj)
#pragma unroll
                    for (int m = 0; m < 4; ++m)
#pragma unroll
                        for (int n = 0; n < 2; ++n) sp[(((ai * 2 + bj) * 4 + m) * 2 + n) * 512] = acc[ai][bj][m][n];
            return;
        }
        { unsigned sp = 0; while (__hip_atomic_load(ctr, __ATOMIC_RELAXED, __HIP_MEMORY_SCOPE_AGENT) < 3u && ++sp < (1u << 22)) __builtin_amdgcn_s_sleep(2); }
        __builtin_amdgcn_fence(__ATOMIC_ACQUIRE, "agent");
        const f32x4* sp = (const f32x4*)slab + tid;
        const int row0 = u.pm * 256 + wr * 64 + fr, col0 = u.pn * BM + wc * 32 + 4 * fq;
#pragma unroll
        for (int ai = 0; ai < 2; ++ai)
#pragma unroll
            for (int m = 0; m < 4; ++m) { const int r = row0 + ai * 128 + m * 16; float* rowp = x + (size_t)r * 4096 + col0; float sq = 0.f;
#pragma unroll
                for (int bj = 0; bj < 2; ++bj)
#pragma unroll
                    for (int n = 0; n < 2; ++n) { const int idx = (((ai * 2 + bj) * 4 + m) * 2 + n) * 512;
                        const f32x4 xv = *(const f32x4*)(rowp + bj * HALF + n * 16);
                        const f32x4 o = (xv + acc[ai][bj][m][n]) + ((sp[idx] + sp[16384 + idx]) + sp[32768 + idx]);
                        sq += (o[0] * o[0] + o[1] * o[1]) + (o[2] * o[2] + o[3] * o[3]);
                        *(f32x4*)(rowp + bj * HALF + n * 16) = o; }
                ssq_add(ssq, r, sq, fq); }
    }
};
struct SplitOrder {
    int c, pm0;
    __device__ bool next(int i, Unit& u) const { if (i != 0) return false; const int slot = (c >> 3) & 7; u.pm = pm0 + (slot & 3); u.pn = 2 * (c & 7) + (slot >> 2); return true; }
    __device__ __forceinline__ void a_ready(const Unit&) const {}
    __device__ __forceinline__ void done(const Unit&) const {}
};
struct PoolOrder {
    int G, c, npm;
    __device__ bool next(int i, Unit& u) const {
        const int per = npm * 4, L = i * G + c; if (L >= 4 * per) return false;
        const int grp = L / per, rem = L % per; u.pm = grp * npm + rem % npm; u.pn = grp * 4 + rem / npm; return true;
    }
    __device__ __forceinline__ void a_ready(const Unit&) const {}
    __device__ __forceinline__ void done(const Unit&) const {}
};

template <class Epi, class Sched, bool ALIGN_EPI = false, bool SP2 = false, int MQ = 4>
__device__ __forceinline__ void gemm_phase(PG8_LAS unsigned char* lds, const Gemm g, const Sched& S, const Epi& E) {
    const int tid = threadIdx.x, wid = __builtin_amdgcn_readfirstlane(tid >> 6), lane = tid & 63, wr = wid >> 2, wc = wid & 3, fr = lane & 15, fq = lane >> 4;
    static_assert(MQ == 4 || ((MQ == 3 || MQ == 2) && SP2), "192- and 128-row tiles: only the SP2 loop carries the wave-group-specific waits");
    const int K = g.K, nt = g.nt ? g.nt : K / BK;
    unsigned voffA[2], voffB[2];
#pragma unroll
    for (int i = 0; i < 2; ++i) { int R, C; stage_rc(tid * 16 + i * 8192, R, C); const int Rb = Epi::PERM ? ((R & ~31) + perm32(R & 31)) : R;
        voffA[i] = (unsigned)(R * K + C) * 2u; voffB[i] = (unsigned)(Rb * K + C) * 2u; }
    const size_t kstep = (size_t)(BK * 2);
    const size_t hstep = (size_t)HALF * K * 2, hstepA = (size_t)(32 * MQ) * K * 2;
    const size_t tstep = 2 * hstep, tstepA = 2 * hstepA;
    const unsigned ldsw = (unsigned)wid * 1024u;
    const int aoff = lds_byte(wr * (16 * MQ) + fr, fq * 8), boff = lds_byte(wc * 32 + fr, fq * 8);
#define PG8_SA(b, h) (((b) * 2 + (h)) * HTB)
#define PG8_SB(b, h) ((4 + (b) * 2 + (h)) * HTB)
#define PG8_STAGE(bufoff, gbase, voff) do { _Pragma("unroll") for (int _i = 0; _i < 2; ++_i) \
        __builtin_amdgcn_global_load_lds((const unsigned*)((const char*)(gbase) + (voff)[_i]), (PG8_LAS unsigned*)(lds + (bufoff) + ldsw + _i * 8192), 16, 0, 0); } while (0)
#define PG8_STAGE_A(bufoff, gbase) do { __builtin_amdgcn_global_load_lds((const unsigned*)((const char*)(gbase) + voffA[0]), (PG8_LAS unsigned*)(lds + (bufoff) + ldsw), 16, 0, 0); \
        if (MQ == 4 || (MQ == 3 && wid < 4)) __builtin_amdgcn_global_load_lds((const unsigned*)((const char*)(gbase) + voffA[1]), (PG8_LAS unsigned*)(lds + (bufoff) + ldsw + 8192), 16, 0, 0); } while (0)
#define PG8_LDA(dst, b, h) do { _Pragma("unroll") for (int m = 0; m < MQ; ++m) _Pragma("unroll") for (int k = 0; k < 2; ++k) dst[m][k] = *(const PG8_LAS bf16x8*)(lds + PG8_SA(b, h) + aoff + m * 2048 + k * 1024); } while (0)
#define PG8_LDB(dst, b, h) do { _Pragma("unroll") for (int n = 0; n < 2; ++n) _Pragma("unroll") for (int k = 0; k < 2; ++k) dst[n][k] = *(const PG8_LAS bf16x8*)(lds + PG8_SB(b, h) + boff + n * 2048 + k * 1024); } while (0)
#define PG8_MMA(ai, bj, At, Bt) do { __builtin_amdgcn_s_setprio(1); _Pragma("unroll") for (int m = 0; m < MQ; ++m) _Pragma("unroll") for (int n = 0; n < 2; ++n) _Pragma("unroll") for (int k = 0; k < 2; ++k) \
        acc[ai][bj][m][n] = __builtin_amdgcn_mfma_f32_16x16x32_bf16(Bt[n][k], At[m][k], acc[ai][bj][m][n], 0, 0, 0); __builtin_amdgcn_s_setprio(0); } while (0)
#define PG8_WAIT_V(n) asm volatile("s_waitcnt vmcnt(" #n ")" ::: "memory")
#define PG8_WAIT_V8 do { if (MQ == 2 || (MQ == 3 && wid >= 4)) PG8_WAIT_V(6); else PG8_WAIT_V(8); } while (0)
#define PG8_WAIT_L(n) asm volatile("s_waitcnt lgkmcnt(" #n ")" ::: "memory")
#define PG8_BAR __builtin_amdgcn_s_barrier()
#define PG8_SCHED __builtin_amdgcn_sched_barrier(0)
    Unit cur, nxt; int ui = 0;
    if (!S.next(0, cur)) return;
    f32x4 acc[2][2][MQ][2];
#pragma unroll
    for (int a = 0; a < 2; ++a)
#pragma unroll
        for (int b = 0; b < 2; ++b)
#pragma unroll
            for (int m = 0; m < MQ; ++m)
#pragma unroll
                for (int n = 0; n < 2; ++n) acc[a][b][m][n] = (f32x4){0.f, 0.f, 0.f, 0.f};
    bf16x8 At[MQ][2], B0[2][2], B1[2][2];
    const char* cA = (const char*)g.A + (size_t)cur.pm * tstepA; const char* cB = (const char*)g.Bt + (size_t)cur.pn * tstep;
    S.a_ready(cur);
    if constexpr (SP2) {
        PG8_STAGE(PG8_SB(0, 0), cB, voffB); PG8_STAGE(PG8_SB(0, 1), cB + hstep, voffB); PG8_STAGE_A(PG8_SA(0, 0), cA); PG8_STAGE_A(PG8_SA(0, 1), cA + hstepA);
        if (wr == 1) PG8_BAR;
        if (MQ == 2 || (MQ == 3 && wid >= 4)) PG8_WAIT_V(1); else PG8_WAIT_V(2);
        PG8_BAR;
        PG8_STAGE(PG8_SB(1, 0), cB + kstep, voffB); PG8_STAGE_A(PG8_SA(1, 0), cA + kstep); PG8_STAGE(PG8_SB(1, 1), cB + hstep + kstep, voffB);
        if (MQ == 2 || (MQ == 3 && wid >= 4)) PG8_WAIT_V(5); else PG8_WAIT_V(6);
        PG8_BAR;
    } else {
        PG8_STAGE(PG8_SB(0, 0), cB, voffB); PG8_STAGE_A(PG8_SA(0, 0), cA); PG8_STAGE(PG8_SB(0, 1), cB + hstep, voffB); PG8_STAGE_A(PG8_SA(0, 1), cA + hstepA);
        if (wr == 1) PG8_BAR;
        PG8_WAIT_V(4); PG8_BAR;
        PG8_STAGE(PG8_SB(1, 0), cB + kstep, voffB); PG8_STAGE_A(PG8_SA(1, 0), cA + kstep); PG8_STAGE(PG8_SB(1, 1), cB + hstep + kstep, voffB);
        PG8_WAIT_V(6); PG8_BAR;
    }
    for (;;) {
        const bool has_next = S.next(ui + 1, nxt);
        const char* nA = has_next ? (const char*)g.A + (size_t)nxt.pm * tstepA : cA; const char* nB = has_next ? (const char*)g.Bt + (size_t)nxt.pn * tstep : cB;
        for (int t = 0; t < nt; t += 2) {
            const bool last = (t == nt - 2);
            const char* a1 = cA + (size_t)(t + 1) * kstep;
            const char* a2 = last ? nA : cA + (size_t)(t + 2) * kstep; const char* b2 = last ? nB : cB + (size_t)(t + 2) * kstep;
            const char* a3 = a2 + kstep; const char* b3 = b2 + kstep;
            if (last && has_next) S.a_ready(nxt);
            if constexpr (SP2) {
            PG8_LDB(B0, 0, 0); PG8_LDB(B1, 0, 1); PG8_SCHED; PG8_LDA(At, 0, 0); PG8_STAGE_A(PG8_SA(1, 1), a1 + hstepA);
            PG8_WAIT_V8; PG8_WAIT_L(0); PG8_BAR; PG8_MMA(0, 0, At, B0); PG8_MMA(0, 1, At, B1); PG8_BAR; PG8_SCHED;
            PG8_LDA(At, 0, 1); PG8_STAGE(PG8_SB(0, 0), b2, voffB); PG8_STAGE(PG8_SB(0, 1), b2 + hstep, voffB); PG8_STAGE_A(PG8_SA(0, 0), a2);
            PG8_WAIT_V8; PG8_WAIT_L(0); PG8_BAR; PG8_MMA(1, 0, At, B0); PG8_MMA(1, 1, At, B1); PG8_BAR; PG8_SCHED;
            PG8_LDB(B0, 1, 0); PG8_LDB(B1, 1, 1); PG8_SCHED; PG8_LDA(At, 1, 0); PG8_STAGE_A(PG8_SA(0, 1), a2 + hstepA);
            PG8_WAIT_V8; PG8_WAIT_L(0); PG8_BAR; PG8_MMA(0, 0, At, B0); PG8_MMA(0, 1, At, B1); PG8_BAR; PG8_SCHED;
            PG8_LDA(At, 1, 1); PG8_STAGE(PG8_SB(1, 0), b3, voffB); PG8_STAGE(PG8_SB(1, 1), b3 + hstep, voffB); PG8_STAGE_A(PG8_SA(1, 0), a3);
            PG8_WAIT_V8; PG8_WAIT_L(0); PG8_BAR; PG8_MMA(1, 0, At, B0); PG8_MMA(1, 1, At, B1); PG8_BAR; PG8_SCHED;
            } else {
            PG8_LDB(B0, 0, 0); PG8_SCHED; PG8_LDA(At, 0, 0); PG8_STAGE_A(PG8_SA(1, 1), a1 + hstepA);
            PG8_WAIT_L(8); PG8_BAR; PG8_WAIT_L(0); PG8_MMA(0, 0, At, B0); PG8_BAR; PG8_SCHED;
            PG8_LDB(B1, 0, 1); PG8_STAGE(PG8_SB(0, 0), b2, voffB);
            PG8_BAR; PG8_WAIT_L(0); PG8_MMA(0, 1, At, B1); PG8_BAR;
            PG8_LDA(At, 0, 1); PG8_STAGE_A(PG8_SA(0, 0), a2);
            PG8_BAR; PG8_WAIT_L(0); PG8_MMA(1, 0, At, B0); PG8_BAR; PG8_SCHED;
            PG8_STAGE(PG8_SB(0, 1), b2 + hstep, voffB);
            PG8_WAIT_V(6); PG8_BAR; PG8_MMA(1, 1, At, B1); PG8_BAR;
            PG8_LDB(B0, 1, 0); PG8_SCHED; PG8_LDA(At, 1, 0); PG8_STAGE_A(PG8_SA(0, 1), a2 + hstepA);
            PG8_WAIT_L(8); PG8_BAR; PG8_WAIT_L(0); PG8_MMA(0, 0, At, B0); PG8_BAR; PG8_SCHED;
            PG8_LDB(B1, 1, 1); PG8_STAGE(PG8_SB(1, 0), b3, voffB);
            PG8_BAR; PG8_WAIT_L(0); PG8_MMA(0, 1, At, B1); PG8_BAR;
            PG8_LDA(At, 1, 1); PG8_STAGE_A(PG8_SA(1, 0), a3);
            PG8_BAR; PG8_WAIT_L(0); PG8_MMA(1, 0, At, B0); PG8_BAR; PG8_SCHED;
            PG8_STAGE(PG8_SB(1, 1), b3 + hstep, voffB);
            PG8_WAIT_V(6); PG8_BAR; PG8_MMA(1, 1, At, B1); PG8_BAR;
            }
        }
        if constexpr (ALIGN_EPI) { if (wr == 0) PG8_BAR; }
        if constexpr (!Epi::AFTER_DRAIN) { E(acc, cur, wr, wc, fr, fq); S.done(cur); }
        if (!has_next) break;
#pragma unroll
        for (int a = 0; a < 2; ++a)
#pragma unroll
            for (int b = 0; b < 2; ++b)
#pragma unroll
                for (int m = 0; m < MQ; ++m)
#pragma unroll
                    for (int n = 0; n < 2; ++n) acc[a][b][m][n] = (f32x4){0.f, 0.f, 0.f, 0.f};
        cur = nxt; cA = nA; cB = nB; ++ui;
        if constexpr (ALIGN_EPI) { if (wr == 1) PG8_BAR; }
    }
    PG8_WAIT_V(0);
    if constexpr (!ALIGN_EPI) { if (wr == 0) PG8_BAR; }
    PG8_BAR;
    if constexpr (Epi::AFTER_DRAIN) { E.fused(acc, cur, wr, wc, fr, fq, lds, wid, lane); S.done(cur); }
#undef PG8_SA
#undef PG8_SB
#undef PG8_STAGE
#undef PG8_LDA
#undef PG8_LDB
#undef PG8_MMA
#undef PG8_WAIT_V
#undef PG8_WAIT_V8
#undef PG8_STAGE_A
#undef PG8_WAIT_L
#undef PG8_BAR
#undef PG8_SCHED
}
}

#ifndef PG8_SP2
#define PG8_SP2 true
#endif
#ifndef PG8_ALIGN
#define PG8_ALIGN true
#endif
#ifndef MK_ONE_LAUNCH
#define MK_ONE_LAUNCH 1
#endif

constexpr int NWAVES = 8;
constexpr int DM = 4096, SEQ = 2048, NB = 4, DB = 128, DS = 8, MP = NB * SEQ, MS = DB * DS, M = MP + MS;
constexpr int DFF = 11008, NGRP = 256, NST = 64, NCH = 16, PBUF = 15;
constexpr float RMS_EPS = 1e-6f;
constexpr int N_PHASES = 10;
constexpr size_t O_YP = 0, O_YS = (size_t)MP * DM, O_SRP = O_YS + (size_t)MS * DM, O_SIP = O_SRP + (size_t)NB * NGRP * NST, O_PP = O_SIP + (size_t)NB * NGRP * NST,
                 O_SRS = O_PP + (size_t)NB * PBUF * DM, O_SIS = O_SRS + (size_t)DB * NGRP * NST, O_PS = O_SIS + (size_t)DB * NGRP * NST, O_END = O_PS + (size_t)DB * PBUF * DM;
constexpr size_t MiB = 1u << 20;
constexpr size_t WS_CTL = 0, CTL_ZERO_BYTES = 1 * MiB;
constexpr size_t WS_WGLU = 16 * MiB, WS_WGU0 = 80 * MiB, WS_WGU1 = 252 * MiB, WS_WDN0 = 424 * MiB, WS_WDN1 = 510 * MiB, WS_WPOOL = 596 * MiB;
constexpr size_t WS_XRES = 608 * MiB, WS_HA = 752 * MiB, WS_YSSM = 824 * MiB, WS_PPOOL = 896 * MiB, WS_HID = 968 * MiB, WS_SSMP = 1164 * MiB, WS_RSTD = 1169 * MiB, WS_END = 1170 * MiB;
static_assert(WS_WGLU + (size_t)2 * DM * DM * 2 <= WS_WGU0 && WS_WGU0 + (size_t)2 * DFF * DM * 2 <= WS_WGU1 && WS_WGU1 + (size_t)2 * DFF * DM * 2 <= WS_WDN0 && WS_WDN0 + (size_t)DM * DFF * 2 <= WS_WDN1 &&
              WS_WDN1 + (size_t)DM * DFF * 2 <= WS_WPOOL && WS_WPOOL + (size_t)4 * 1024 * 1024 * 2 <= WS_XRES && WS_XRES + (size_t)M * DM * 4 <= WS_HA && WS_HA + (size_t)M * DM * 2 <= WS_YSSM &&
              WS_YSSM + (size_t)M * DM * 2 <= WS_PPOOL && WS_PPOOL + (size_t)M * DM * 2 <= WS_HID && WS_HID + (size_t)M * DFF * 2 <= WS_SSMP, "d_ws map");
constexpr size_t SPB_AR = 0, SPB_AI = 65536, SPB_BF = 131072, SPB_CF = 131072 + 1048576;
constexpr int CW_BAR = 4096;
constexpr int CW_SPLIT = 65536;
constexpr int CW_SSQ = 16384;
constexpr int RING_OFF = 0, RING_BYTES = 131072;
constexpr int LDSCTL_OFF = RING_BYTES, MISC_OFF = LDSCTL_OFF + 320;
constexpr int LDS_BYTES = 147456;
static_assert(MISC_OFF + 128 <= LDS_BYTES, "LDS map");

#define GAS __attribute__((address_space(1)))
#define LAS __attribute__((address_space(3)))
typedef unsigned short bf16;
typedef unsigned v4u __attribute__((ext_vector_type(4)));
typedef float f32x4 __attribute__((ext_vector_type(4)));
typedef short bf16x8 __attribute__((ext_vector_type(8)));
typedef GAS unsigned gu32;
typedef GAS unsigned long long gu64;
#define RLX_AGENT __ATOMIC_RELAXED, __HIP_MEMORY_SCOPE_AGENT
#define LDS_WAIT() asm volatile("s_waitcnt lgkmcnt(0)" ::: "memory")
#define VM_WAIT() asm volatile("s_waitcnt vmcnt(0)" ::: "memory")
__device__ __forceinline__ unsigned long long rt() { return __builtin_amdgcn_s_memrealtime(); }
__device__ __forceinline__ unsigned f2bf(float f) { unsigned u = __builtin_bit_cast(unsigned, f); return (u + 0x7fffu + ((u >> 16) & 1u)) >> 16; }
__device__ __forceinline__ unsigned pk2(float lo, float hi) { return f2bf(lo) | (f2bf(hi) << 16); }

#define XB_TMO      128
#define XB_XCNT(j)  (256  + 64 * (j))
#define XB_XSUB(j)  (1280 + 64 * (j))
#define XB_XGEN(j)  (2304 + 64 * (j))
#define XB_TOP      3328
#define XB_TOPGEN   3392
#define XCD_BAR_WORDS 3456
#define XB_SPIN_CAP (1u << 18)

__device__ __forceinline__ unsigned xb_ld(unsigned* p)              { return __hip_atomic_load(p, __ATOMIC_RELAXED, __HIP_MEMORY_SCOPE_AGENT); }
__device__ __forceinline__ unsigned xb_add(unsigned* p, unsigned v) { return __hip_atomic_fetch_add(p, v, __ATOMIC_RELAXED, __HIP_MEMORY_SCOPE_AGENT); }
__device__ __forceinline__ unsigned xb_xcc_id() { return (unsigned)__builtin_amdgcn_s_getreg((3 << 11) | 20) & 0xFu; }
#define XB_SPIN(cond, bar) do { unsigned _sp = 0; while (cond) { __builtin_amdgcn_s_sleep(1); \
    if ((++_sp & 255u) == 0u) { if (xb_ld(&(bar)[XB_TMO])) break; if (_sp > XB_SPIN_CAP) { atomicAdd(&(bar)[XB_TMO], 1u); break; } } } } while (0)

struct XcdBarrier {
    unsigned* bar; unsigned x;
    volatile LAS unsigned* st;
};

__device__ __forceinline__ XcdBarrier xcd_barrier_post(unsigned* bar, volatile LAS unsigned* st) {
    XcdBarrier b; b.bar = bar; b.x = xb_xcc_id(); b.st = st;
    if (threadIdx.x == 0) (void)xb_add(&bar[XB_XCNT(b.x)], 1u);
    return b;
}
__device__ __forceinline__ void xcd_barrier_complete(unsigned* bar, unsigned x, unsigned& nloc, unsigned& nx) {
    const unsigned G = gridDim.x * gridDim.y * gridDim.z;
    unsigned sum, cnt, mine, sp = 0u;
    for (;;) {
        sum = 0u; cnt = 0u; mine = 0u;
#pragma unroll
        for (unsigned j = 0; j < 16; ++j) { const unsigned c = xb_ld(&bar[XB_XCNT(j)]); sum += c; cnt += (c > 0u) ? 1u : 0u; mine = (j == x) ? c : mine; }
        if (sum == G) break;
        __builtin_amdgcn_s_sleep(1);
        if ((++sp & 255u) == 0u) { if (xb_ld(&bar[XB_TMO])) break; if (sp > XB_SPIN_CAP) { atomicAdd(&bar[XB_TMO], 1u); break; } }
    }
    nloc = mine > 0u ? mine : 1u; nx = cnt > 0u ? cnt : 1u;
}

__device__ __forceinline__ void xcd_barrier(const XcdBarrier& b) {
    asm volatile("s_waitcnt vmcnt(0)" ::: "memory");
    __syncthreads();
    if (threadIdx.x == 0) {
        unsigned* bar = b.bar;
        __builtin_amdgcn_s_waitcnt(0);
        unsigned nloc = b.st[0], nx = b.st[1];
        if (nloc == 0u) { xcd_barrier_complete(bar, b.x, nloc, nx); b.st[0] = nloc; b.st[1] = nx; }
        const unsigned old = xb_add(&bar[XB_XSUB(b.x)], 1u);
        const unsigned gen = old / nloc;
        if (old + 1u == (gen + 1u) * nloc) {
            __builtin_amdgcn_fence(__ATOMIC_RELEASE, "agent");
            asm volatile("s_waitcnt vmcnt(0)" ::: "memory");
            const unsigned og = xb_add(&bar[XB_TOP], 1u);
            const unsigned tg = og / nx;
            if (og + 1u == (tg + 1u) * nx) xb_add(&bar[XB_TOPGEN], 1u);
            else XB_SPIN(xb_ld(&bar[XB_TOPGEN]) == tg, bar);
            __builtin_amdgcn_fence(__ATOMIC_ACQUIRE, "agent");
            xb_add(&bar[XB_XGEN(b.x)], 1u);
            asm volatile("s_waitcnt vmcnt(0)" ::: "memory");
        } else {
            XB_SPIN(xb_ld(&bar[XB_XGEN(b.x)]) == gen, bar);
            __builtin_amdgcn_fence(__ATOMIC_ACQUIRE, "agent");
            asm volatile("s_waitcnt vmcnt(0)" ::: "memory");
        }
    }
    __syncthreads();
}

struct Frame {
    LAS unsigned char* lds;
    volatile LAS unsigned* MISC;
    gu32* ctl;
    int tid, lane, wave;
    int vcu, G;
    const float* in[21];
    float* out;
    unsigned char* ws;
};
enum { I_XP = 0, I_XS, I_SRE, I_SIM, I_SPOOL, I_NMIX, I_NFFN, I_LRE, I_LIM, I_LSTEP, I_BRE, I_BIM, I_CRE, I_CIM, I_SD, I_WGLU, I_WPOOL, I_PSCALE, I_WGU, I_WDN, I_NFIN };

__device__ __forceinline__ float wave_sum(float v) {
#pragma unroll
    for (int o = 1; o < 64; o <<= 1) v += __shfl_xor(v, o);
    return v;
}
typedef float f32x2_t __attribute__((ext_vector_type(2)));
typedef __bf16 b16x2_t __attribute__((ext_vector_type(2)));
typedef float f32x16 __attribute__((ext_vector_type(16)));
__device__ __forceinline__ unsigned cvtpk(float lo, float hi) { return __builtin_bit_cast(unsigned, __builtin_convertvector((f32x2_t){lo, hi}, b16x2_t)); }
__device__ __forceinline__ const float* xrow_in(const Frame& F, int r) { return r < MP ? F.in[I_XP] + (size_t)r * DM : F.in[I_XS] + (size_t)(r - MP) * DM; }

__device__ __forceinline__ void tr_item(const float* W, int K, int N, bf16* WT, int k0, int n0, int drow0, int lane, const float* kgain = nullptr) {
    const int kq = lane >> 3, nq = lane & 7;
    f32x4 v[2][8];
#pragma unroll
    for (int h = 0; h < 2; ++h)
#pragma unroll
        for (int i = 0; i < 8; ++i) v[h][i] = __builtin_nontemporal_load((const GAS f32x4*)(W + (size_t)(k0 + 8 * kq + i) * N + n0 + 32 * h + 4 * nq));
    if (kgain) {
        const f32x4 g0 = *(const GAS f32x4*)(kgain + k0 + 8 * kq), g1 = *(const GAS f32x4*)(kgain + k0 + 8 * kq + 4);
#pragma unroll
        for (int h = 0; h < 2; ++h)
#pragma unroll
            for (int i = 0; i < 8; ++i) v[h][i] = v[h][i] * (i < 4 ? g0[i & 3] : g1[i & 3]);
    }
#pragma unroll
    for (int h = 0; h < 2; ++h)
#pragma unroll
        for (int j = 0; j < 4; ++j) { v4u o; o.x = cvtpk(v[h][0][j], v[h][1][j]); o.y = cvtpk(v[h][2][j], v[h][3][j]); o.z = cvtpk(v[h][4][j], v[h][5][j]); o.w = cvtpk(v[h][6][j], v[h][7][j]);
            *(GAS v4u*)(WT + (size_t)(drow0 + 32 * h + 4 * nq + j) * K + k0 + 8 * kq) = o; }
}
__device__ __forceinline__ int drow_pair(int n0, int NH) { const int half = n0 >= NH ? 1 : 0, nn = n0 - half * NH; return 256 * (nn >> 7) + 128 * half + (nn & 127); }

__device__ __forceinline__ double exp_d(double x) {
    const double k = __builtin_rint(x * 1.4426950408889634074); const double r = x - k * 0.69314718055994530942;
    double s = 1.0, t = 1.0;
#pragma unroll
    for (int i = 1; i <= 16; ++i) { t *= r * (1.0 / (double)i); s += t; }
    const long long e = (long long)k + 1023; return s * __builtin_bit_cast(double, (unsigned long long)e << 52);
}
__device__ __forceinline__ void sincos_d(double th, double& sn, double& cs) {
    const double n = __builtin_rint(th * 0.15915494309189533577); const double r = (th - n * 6.283185307179586232) - n * 2.4492935982947064e-16; const double r2 = r * r;
    double s = r, c = 1.0, ts = r, tc = 1.0;
#pragma unroll
    for (int i = 1; i <= 15; ++i) { tc *= r2 * (-1.0 / (double)((2 * i - 1) * (2 * i))); ts *= r2 * (-1.0 / (double)((2 * i) * (2 * i + 1))); c += tc; s += ts; }
    sn = s; cs = c;
}

constexpr int CI_GLU = (DM / 64) * (2 * DM / 64), CI_GU = (DM / 64) * (2 * DFF / 64), CI_DN = (DFF / 64) * (DM / 64), CI_PL = 4 * 16 * 16;
constexpr int CI_L0 = CI_GLU + CI_GU + CI_DN, CI_ALL = CI_L0 + CI_GU + CI_DN + CI_PL;
__device__ __forceinline__ void convert_weights(Frame& F, int lo, int hi, int first, int step) {
    LAS unsigned* ctr = (LAS unsigned*)(F.lds + MISC_OFF + 80);
    for (;;) {
        unsigned k = 0; if (F.lane == 0) k = __hip_atomic_fetch_add(ctr, 1u, __ATOMIC_RELAXED, __HIP_MEMORY_SCOPE_WORKGROUP);
        k = (unsigned)__builtin_amdgcn_readfirstlane((int)k);
        const long itl = (long)lo + first + (long)step * k; if (itl >= hi) break;
        int r = (int)itl;
        if (r < CI_GLU) { const int nb = r % (2 * DM / 64), kb = r / (2 * DM / 64); tr_item(F.in[I_WGLU], DM, 2 * DM, (bf16*)(F.ws + WS_WGLU), kb * 64, nb * 64, drow_pair(nb * 64, DM), F.lane); continue; } r -= CI_GLU;
        if (r >= 2 * CI_GU + CI_DN && r < 2 * CI_GU + CI_DN + CI_PL) { r -= 2 * CI_GU + CI_DN; const int g = r / 256; r -= g * 256; const int nb = r % 16, kb = r / 16;
            tr_item(F.in[I_WPOOL] + (size_t)g * 1024 * 1024, 1024, 1024, (bf16*)(F.ws + WS_WPOOL) + (size_t)g * 1024 * 1024, kb * 64, nb * 64, nb * 64, F.lane); continue; }
        int l, isdn;
        if (r < CI_GU) { l = 0; isdn = 0; } else if (r < CI_GU + CI_DN) { r -= CI_GU; l = 0; isdn = 1; } else if (r < 2 * CI_GU + CI_DN) { r -= CI_GU + CI_DN; l = 1; isdn = 0; } else { r -= 2 * CI_GU + CI_DN + CI_PL; l = 1; isdn = 1; }
        if (!isdn) { const int nb = r % (2 * DFF / 64), kb = r / (2 * DFF / 64);
            tr_item(F.in[I_WGU] + (size_t)l * DM * 2 * DFF, DM, 2 * DFF, (bf16*)(F.ws + (l ? WS_WGU1 : WS_WGU0)), kb * 64, nb * 64, drow_pair(nb * 64, DFF), F.lane, F.in[I_NFFN] + l * DM); continue; }
        { const int nb = r % (DM / 64), kb = r / (DM / 64);
            tr_item(F.in[I_WDN] + (size_t)l * DFF * DM, DFF, DM, (bf16*)(F.ws + (l ? WS_WDN1 : WS_WDN0)), kb * 64, nb * 64, nb * 64, F.lane); }
    }
}
__device__ __forceinline__ void convert_reset(Frame& F) { __syncthreads(); if (F.tid == 0) *(LAS unsigned*)(F.lds + MISC_OFF + 80) = 0u; __syncthreads(); }
__device__ __forceinline__ void p0_prologue(Frame& F) {
    const int gw = F.vcu * NWAVES + F.wave, NGW = F.G * NWAVES;
    float* rstd0 = (float*)(F.ws + WS_RSTD);
    for (int r = gw; r < M; r += NGW) { const GAS f32x4* xr = (const GAS f32x4*)xrow_in(F, r) + F.lane; float s = 0.f;
#pragma unroll
        for (int j = 0; j < 16; ++j) { const f32x4 v = xr[64 * j]; s += (v.x * v.x + v.y * v.y) + (v.z * v.z + v.w * v.w); }
        s = wave_sum(s); if (F.lane == 0) rstd0[r] = 1.0f / sqrtf(s * (1.0f / DM) + RMS_EPS); }
    unsigned char* spb = F.ws + WS_SSMP;
    for (int idx = F.vcu * (NWAVES * 64) + F.tid; idx < NGRP * NST; idx += F.G * NWAVES * 64) {
        const int g = idx >> 6, p = idx & 63, ti = p >> 5, sl = p & 31;
        const double lr = (double)F.in[I_LRE][idx], li = (double)F.in[I_LIM][idx], dt = exp_d((double)F.in[I_LSTEP][g]);
        const double mag = exp_d(lr * dt); double sn, cs; sincos_d(li * dt, sn, cs);
        const double ar = mag * cs, ai = mag * sn, den = lr * lr + li * li;
        const double fr = ((ar - 1.0) * lr + ai * li) / den, fi = (ai * lr - (ar - 1.0) * li) / den;
        ((float*)(spb + SPB_AR))[idx] = (float)ar; ((float*)(spb + SPB_AI))[idx] = (float)ai;
#pragma unroll
        for (int hl = 0; hl < 2; ++hl) { float re[8], im[8];
#pragma unroll
            for (int c4 = 0; c4 < 2; ++c4) { const f32x4 br = *(const GAS f32x4*)(F.in[I_BRE] + (size_t)idx * 16 + 8 * hl + 4 * c4), bi = *(const GAS f32x4*)(F.in[I_BIM] + (size_t)idx * 16 + 8 * hl + 4 * c4);
                const f32x4 gn = *(const GAS f32x4*)(F.in[I_NMIX] + g * 16 + 8 * hl + 4 * c4);
#pragma unroll
                for (int j = 0; j < 4; ++j) { re[4 * c4 + j] = (float)((fr * (double)br[j] - fi * (double)bi[j]) * (double)gn[j]); im[4 * c4 + j] = (float)((fr * (double)bi[j] + fi * (double)br[j]) * (double)gn[j]); } }
            const int ln = 32 * hl + sl; v4u o;
            o.x = cvtpk(re[0], re[1]); o.y = cvtpk(re[2], re[3]); o.z = cvtpk(re[4], re[5]); o.w = cvtpk(re[6], re[7]);
            *(GAS v4u*)(spb + SPB_BF + ((size_t)(((g * 2 + ti) * 2 + 0) * 64 + ln)) * 16) = o;
            o.x = cvtpk(im[0], im[1]); o.y = cvtpk(im[2], im[3]); o.z = cvtpk(im[4], im[5]); o.w = cvtpk(im[6], im[7]);
            *(GAS v4u*)(spb + SPB_BF + ((size_t)(((g * 2 + ti) * 2 + 1) * 64 + ln)) * 16) = o; }
    }
    for (int idx = F.vcu * (NWAVES * 64) + F.tid; idx < NGRP * 4 * 64; idx += F.G * NWAVES * 64) {
        const int g = idx >> 8, ks = (idx >> 6) & 3, ln = idx & 63, q = ln >> 4, c = ln & 15, p0 = 16 * ks + 4 * q;
        const f32x4 cr = *(const GAS f32x4*)(F.in[I_CRE] + ((size_t)g * 16 + c) * NST + p0), ci = *(const GAS f32x4*)(F.in[I_CIM] + ((size_t)g * 16 + c) * NST + p0);
        v4u o; o.x = cvtpk(cr[0], -ci[0]); o.y = cvtpk(cr[1], -ci[1]); o.z = cvtpk(cr[2], -ci[2]); o.w = cvtpk(cr[3], -ci[3]);
        *(GAS v4u*)(spb + SPB_CF + (size_t)idx * 16) = o;
    }
}

__device__ __forceinline__ float gelu_tanh(float x) { const float z = 0.7978845608028654f * (x + 0.044715f * x * x * x); return x * __builtin_amdgcn_rcpf(1.0f + __expf(-2.0f * z)); }
template <bool SAMPLE>
__device__ __forceinline__ void ssm_run(Frame& F, int g, int sel) {
    const int lane = F.lane, hl = lane >> 5, sl = lane & 31, q = lane >> 4, cl = lane & 15;
    const unsigned char* spb = F.ws + WS_SSMP; const float* rstd0 = (const float*)(F.ws + WS_RSTD);
    bf16x8 bfr[2][2], cfr[4];
#pragma unroll
    for (int ti = 0; ti < 2; ++ti)
#pragma unroll
        for (int part = 0; part < 2; ++part) bfr[ti][part] = *(const GAS bf16x8*)(spb + SPB_BF + ((size_t)(((g * 2 + ti) * 2 + part) * 64 + lane)) * 16);
#pragma unroll
    for (int ks = 0; ks < 4; ++ks) cfr[ks] = *(const GAS bf16x8*)(spb + SPB_CF + ((size_t)((g * 4 + ks) * 64 + lane)) * 16);
    float ar[2], ai[2];
#pragma unroll
    for (int ti = 0; ti < 2; ++ti) { ar[ti] = ((const float*)(spb + SPB_AR))[g * NST + 32 * ti + sl]; ai[ti] = ((const float*)(spb + SPB_AI))[g * NST + 32 * ti + sl]; }
    const f32x4 dg = *(const GAS f32x4*)(F.in[I_SD] + g * 16 + 4 * q) * *(const GAS f32x4*)(F.in[I_NMIX] + g * 16 + 4 * q);
    const int hA = (sl >> 2) & 1, rA = (sl & 3) + 4 * (sl >> 3);
    const int hE = (cl >> 2) & 1, rE = (cl & 3) + 4 * (cl >> 3);
    LAS unsigned char* xl = F.lds + RING_OFF + F.wave * 8704;
    LAS unsigned* xw = (LAS unsigned*)(xl + hl * (4 * 272) + sl * 4);
    const LAS unsigned char* xrd = xl + cl * 272 + q * 16;
    int rowA, rowE[2], nch; float xr[2], xi[2], xr2[2], xi2[2]; float *o1r, *o1i, *o2r = nullptr, *o2i = nullptr;
    if constexpr (SAMPLE) { const int b0 = 4 * sel; nch = 1;
        rowA = MP + (b0 + 2 * hA + (rA >> 3)) * DS + (rA & 7); rowE[0] = MP + (b0 + 2 * hE) * DS + rE; rowE[1] = MP + (b0 + 2 * hE + 1) * DS + rE;
        const size_t s1 = ((size_t)(b0 + 2 * hl) * NGRP + g) * NST + sl, s2 = s1 + (size_t)NGRP * NST;
#pragma unroll
        for (int ti = 0; ti < 2; ++ti) { xr[ti] = F.in[I_SRE][s1 + 32 * ti]; xi[ti] = F.in[I_SIM][s1 + 32 * ti]; xr2[ti] = F.in[I_SRE][s2 + 32 * ti]; xi2[ti] = F.in[I_SIM][s2 + 32 * ti]; }
        o1r = F.out + O_SRS + s1; o1i = F.out + O_SIS + s1; o2r = F.out + O_SRS + s2; o2i = F.out + O_SIS + s2;
    } else { const int seq0 = 2 * sel; nch = SEQ / 16;
        rowA = (seq0 + hA) * SEQ + rA; rowE[0] = (seq0 + hE) * SEQ + rE; rowE[1] = rowE[0] + 8;
#pragma unroll
        for (int ti = 0; ti < 2; ++ti) { xr[ti] = 0.f; xi[ti] = 0.f; xr2[ti] = 0.f; xi2[ti] = 0.f; }
        const size_t s1 = ((size_t)(seq0 + hl) * NGRP + g) * NST + sl; o1r = F.out + O_SRP + s1; o1i = F.out + O_SIP + s1;
    }
    f32x16 zero16;
#pragma unroll
    for (int i = 0; i < 16; ++i) zero16[i] = 0.f;
    f32x4 nx0, nx1, nxe[2]; float nrs, nre[2];
    { const float* xp = xrow_in(F, rowA) + g * 16 + 8 * hl; nx0 = *(const GAS f32x4*)xp; nx1 = *(const GAS f32x4*)(xp + 4); nrs = rstd0[rowA];
#pragma unroll
      for (int rt = 0; rt < 2; ++rt) { nxe[rt] = *(const GAS f32x4*)(xrow_in(F, rowE[rt]) + g * 16 + 4 * q); nre[rt] = rstd0[rowE[rt]]; } }
    for (int ch = 0; ch < nch; ++ch) {
        const f32x4 x0 = nx0, x1 = nx1; const float rs = nrs;
        f32x4 xe[2]; float re[2];
#pragma unroll
        for (int rt = 0; rt < 2; ++rt) { xe[rt] = nxe[rt]; re[rt] = nre[rt]; }
        if (ch + 1 < nch) { const int ra = rowA + 16 * (ch + 1); const float* xp = xrow_in(F, ra) + g * 16 + 8 * hl; nx0 = *(const GAS f32x4*)xp; nx1 = *(const GAS f32x4*)(xp + 4); nrs = rstd0[ra];
#pragma unroll
            for (int rt = 0; rt < 2; ++rt) { const int r = rowE[rt] + 16 * (ch + 1); nxe[rt] = *(const GAS f32x4*)(xrow_in(F, r) + g * 16 + 4 * q); nre[rt] = rstd0[r]; } }
        v4u au; au.x = cvtpk(x0[0] * rs, x0[1] * rs); au.y = cvtpk(x0[2] * rs, x0[3] * rs); au.z = cvtpk(x1[0] * rs, x1[1] * rs); au.w = cvtpk(x1[2] * rs, x1[3] * rs);
        const bf16x8 afr = __builtin_bit_cast(bf16x8, au);
#pragma unroll
        for (int ti = 0; ti < 2; ++ti) {
            f32x16 dr = __builtin_amdgcn_mfma_f32_32x32x16_bf16(afr, bfr[ti][0], zero16, 0, 0, 0);
            f32x16 di = __builtin_amdgcn_mfma_f32_32x32x16_bf16(afr, bfr[ti][1], zero16, 0, 0, 0);
            float sr = xr[ti], si = xi[ti];
#pragma unroll
            for (int r = 0; r < 16; ++r) {
                if (SAMPLE && r == 8) { o1r[32 * ti] = sr; o1i[32 * ti] = si; sr = xr2[ti]; si = xi2[ti]; }
                const float nr = fmaf(-ai[ti], si, fmaf(ar[ti], sr, dr[r])), ni = fmaf(ai[ti], sr, fmaf(ar[ti], si, di[r])); sr = nr; si = ni;
                xw[(((r & 3) + 8 * (r >> 2)) * 272 + ti * 128) / 4] = cvtpk(sr, si);
            }
            xr[ti] = sr; xi[ti] = si;
        }
        asm volatile("s_waitcnt lgkmcnt(0)" ::: "memory"); __builtin_amdgcn_sched_barrier(0);
        f32x4 y[2];
#pragma unroll
        for (int rt = 0; rt < 2; ++rt) { y[rt] = (f32x4){0.f, 0.f, 0.f, 0.f};
#pragma unroll
            for (int ks = 0; ks < 4; ++ks) { const bf16x8 xf = *(const LAS bf16x8*)(xrd + rt * (16 * 272) + ks * 64); y[rt] = __builtin_amdgcn_mfma_f32_16x16x32_bf16(cfr[ks], xf, y[rt], 0, 0, 0); } }
        asm volatile("s_waitcnt lgkmcnt(0)" ::: "memory"); __builtin_amdgcn_sched_barrier(0);
#pragma unroll
        for (int rt = 0; rt < 2; ++rt) { const int r = rowE[rt] + 16 * ch; f32x4 v;
#pragma unroll
            for (int j = 0; j < 4; ++j) v[j] = gelu_tanh(y[rt][j] + dg[j] * (xe[rt][j] * re[rt]));
            *(GAS unsigned long long*)((bf16*)(F.ws + WS_YSSM) + (size_t)r * DM + g * 16 + 4 * q) = (unsigned long long)cvtpk(v[0], v[1]) | ((unsigned long long)cvtpk(v[2], v[3]) << 32); }
    }
    if constexpr (SAMPLE) {
#pragma unroll
        for (int ti = 0; ti < 2; ++ti) { o2r[32 * ti] = xr[ti]; o2i[32 * ti] = xi[ti]; }
    } else {
#pragma unroll
        for (int ti = 0; ti < 2; ++ti) { o1r[32 * ti] = xr[ti]; o1i[32 * ti] = xi[ti]; }
    }
}
__device__ __forceinline__ void p1_ssm(Frame& F) {
    if (F.wave < 2) {
        for (int task = F.vcu * 2 + F.wave; task < 2 * NGRP; task += F.G * 2) ssm_run<false>(F, task & 255, task >> 8);
    } else {
        for (int task = F.vcu * 6 + (F.wave - 2); task < 32 * NGRP; task += F.G * 6) ssm_run<true>(F, task & 255, task >> 8);
    }
    convert_weights(F, 0, F.G == 256 ? CI_GLU + CI_GU : CI_L0, F.vcu, F.G);
}

__device__ __forceinline__ void final_norm(Frame& F, const float* gain, const float* ssq, float* dst) {
    (void)ssq;
    const float* X = (const float*)(F.ws + WS_XRES); const int gw = F.vcu * NWAVES + F.wave, NGW = F.G * NWAVES;
    f32x4 v[16], w[16];
    if (gw < M) { const GAS f32x4* xr = (const GAS f32x4*)(X + (size_t)gw * DM) + F.lane;
#pragma unroll
        for (int u = 0; u < 16; ++u) v[u] = __builtin_nontemporal_load(xr + 64 * u); }
    for (int r = gw; r < M; r += NGW) {
        const int rn = r + NGW;
        if (rn < M) { const GAS f32x4* xr = (const GAS f32x4*)(X + (size_t)rn * DM) + F.lane;
#pragma unroll
            for (int u = 0; u < 16; ++u) w[u] = __builtin_nontemporal_load(xr + 64 * u); }
        float s = 0.f;
#pragma unroll
        for (int u = 0; u < 16; ++u) s += (v[u].x * v[u].x + v[u].y * v[u].y) + (v[u].z * v[u].z + v[u].w * v[u].w);
        s = wave_sum(s);
        const float rs = __builtin_amdgcn_rsqf(s * (1.0f / DM) + RMS_EPS);
        GAS f32x4* dr = (GAS f32x4*)(dst + (size_t)r * DM) + F.lane; const GAS f32x4* gr = (const GAS f32x4*)gain + F.lane;
#pragma unroll
        for (int u = 0; u < 16; ++u) __builtin_nontemporal_store(v[u] * rs * gr[64 * u], dr + 64 * u);
#pragma unroll
        for (int u = 0; u < 16; ++u) v[u] = w[u];
    }
}
template <int GI, int R, bool PROMPT> __device__ __forceinline__ void pool_elem_g(Frame& F, int vb, int nb) {
    constexpr int W = 2 << GI, NH = R + W - 1, RBASE = PROMPT ? 0 : MP, NROWS = PROMPT ? MP : MS;
    const float* X = (const float*)(F.ws + WS_XRES); const float* ssq1 = (const float*)(F.ctl + CW_SSQ) + M; const float* gain = F.in[I_NMIX] + DM;
    bf16* PP = (bf16*)(F.ws + WS_PPOOL);
    const size_t NT = (size_t)nb * NWAVES * 64;
    static_assert(PROMPT || R == DS, "a sample sequence is exactly one strip");
    for (size_t idx = (size_t)vb * NWAVES * 64 + F.tid; idx < (size_t)(NROWS / R) * 256; idx += NT) {
        const int r0 = RBASE + (int)(idx >> 8) * R, q = (int)(idx & 255), c = GI * 1024 + 4 * q;
        const f32x4 gv = *(const GAS f32x4*)(gain + c);
        constexpr bool prompt = PROMPT; const int t0 = prompt ? (r0 & (SEQ - 1)) : 0; const int b = (r0 - MP) >> 3;
        f32x4 hv[NH]; float sq[NH];
#pragma unroll
        for (int k = 0; k < NH; ++k) { const int d = k - (W - 1), tt = t0 + d; const bool inseq = tt >= 0;
            const float* src = inseq ? X + (size_t)(r0 + d) * DM + c : (prompt ? X + (size_t)r0 * DM + c : F.in[I_SPOOL] + ((size_t)b * PBUF + (PBUF + tt)) * DM + c);
            hv[k] = *(const GAS f32x4*)src; sq[k] = ssq1[inseq ? r0 + d : r0]; }
#pragma unroll
        for (int k = 0; k < NH; ++k) { const bool inseq = (t0 + k - (W - 1)) >= 0; const float rs = __builtin_amdgcn_rsqf(sq[k] * (1.0f / DM) + RMS_EPS);
            hv[k] = hv[k] * (inseq ? gv * rs : (prompt ? (f32x4){0.f, 0.f, 0.f, 0.f} : (f32x4){1.f, 1.f, 1.f, 1.f})); }
#pragma unroll
        for (int i = 0; i < R; ++i) { const int r = r0 + i, t = t0 + i; const f32x4 h = hv[i + W - 1]; f32x4 s = h;
#pragma unroll
            for (int j = 1; j < W; ++j) s += hv[i + W - 1 - j];
            const float cnt = prompt ? (float)((t + 1) < W ? (t + 1) : W) : (float)W;
            const f32x4 p = s / cnt - h;
            *(GAS unsigned long long*)(PP + ((size_t)GI * M + r) * 1024 + 4 * q) = (unsigned long long)cvtpk(p.x, p.y) | ((unsigned long long)cvtpk(p.z, p.w) << 32);
            if (prompt) { if (t >= SEQ - PBUF) *(GAS f32x4*)(F.out + O_PP + ((size_t)(r >> 11) * PBUF + (t - (SEQ - PBUF))) * DM + c) = h; }
            else { float* ob = F.out + O_PS + (size_t)b * PBUF * DM + c;
                *(GAS f32x4*)(ob + (size_t)(PBUF - DS + t) * DM) = h;
                if (t < PBUF - DS) *(GAS f32x4*)(ob + (size_t)t * DM) = *(const GAS f32x4*)(F.in[I_SPOOL] + ((size_t)b * PBUF + DS + t) * DM + c); } }
    }
}
__device__ __forceinline__ void pool_elem(Frame& F) {
    pool_elem_g<3, 8, true>(F, F.vcu, F.G); pool_elem_g<2, 16, true>(F, F.vcu, F.G); pool_elem_g<1, 16, true>(F, F.vcu, F.G); pool_elem_g<0, 16, true>(F, F.vcu, F.G);
    if (F.G % 4 == 0) { const int nb = F.G / 4, vb = F.vcu % nb;
        switch (F.vcu / nb) { case 0: pool_elem_g<0, 8, false>(F, vb, nb); break; case 1: pool_elem_g<1, 8, false>(F, vb, nb); break; case 2: pool_elem_g<2, 8, false>(F, vb, nb); break; default: pool_elem_g<3, 8, false>(F, vb, nb); break; } }
    else { pool_elem_g<0, 8, false>(F, F.vcu, F.G); pool_elem_g<1, 8, false>(F, F.vcu, F.G); pool_elem_g<2, 8, false>(F, F.vcu, F.G); pool_elem_g<3, 8, false>(F, F.vcu, F.G); }
}

__device__ __forceinline__ void down_phase(Frame& F, const unsigned char* wdn, float* ssq_l, int layer) {
    unsigned char* ws = F.ws;
    if (F.G == 256) {
        { pg8::Gemm g{(const pg8::bf16_t*)(ws + WS_HID), (const pg8::bf16_t*)wdn, MP, DM, DFF, 0}; pg8::MallOrder S; S.init(MP, DM, F.G, (int)blockIdx.x, 256, 2);
          pg8::EpiResid<false> E{(float*)(ws + WS_XRES), nullptr, nullptr, ssq_l, 36};
          pg8::gemm_phase<pg8::EpiResid<false>, pg8::MallOrder, PG8_ALIGN, PG8_SP2>(F.lds + RING_OFF, g, S, E); }
        const int c = (int)blockIdx.x, part = c >> 6, unit = (c & 7) * 8 + ((c >> 3) & 7);
        const int kt0 = part == 0 ? 0 : part == 1 ? 36 : part == 2 ? 82 : 128, ntp = part == 0 ? 36 : part == 3 ? 44 : 46;
        pg8::Gemm g{(const pg8::bf16_t*)(ws + WS_HID) + kt0 * 64, (const pg8::bf16_t*)wdn + kt0 * 64, M, DM, DFF, ntp};
        unsigned* ctr = (unsigned*)(F.ctl + CW_SPLIT) + (layer * 64 + unit) * 16;
        pg8::EpiResidSplit E{(float*)(ws + WS_XRES), ssq_l, (float*)(ws + WS_YSSM) + (size_t)unit * 3 * 65536, ctr, part};
        pg8::SplitOrder S{c, 32};
        pg8::gemm_phase<pg8::EpiResidSplit, pg8::SplitOrder, PG8_ALIGN, PG8_SP2>(F.lds + RING_OFF, g, S, E);
        if (part != 0) { __syncthreads();
            if (F.tid == 0) { __builtin_amdgcn_fence(__ATOMIC_RELEASE, "agent"); asm volatile("s_waitcnt vmcnt(0)" ::: "memory"); (void)__hip_atomic_fetch_add(ctr, 1u, __ATOMIC_RELAXED, __HIP_MEMORY_SCOPE_AGENT); } }
    } else {
        pg8::Gemm g{(const pg8::bf16_t*)(ws + WS_HID), (const pg8::bf16_t*)wdn, M, DM, DFF, 0}; pg8::MallOrder S; S.init(M, DM, F.G, (int)blockIdx.x, 192, 2);
        pg8::EpiResid<false> E{(float*)(ws + WS_XRES), nullptr, nullptr, ssq_l, 36};
        pg8::gemm_phase<pg8::EpiResid<false>, pg8::MallOrder, PG8_ALIGN, PG8_SP2, 3>(F.lds + RING_OFF, g, S, E);
    }
}

struct Args { const float* in[21]; float* out; unsigned char* ws; int ph_lo, ph_hi; };
__global__ void __launch_bounds__(NWAVES * 64, 2) skel_fwd(Args args) {
    extern __shared__ __attribute__((aligned(16))) unsigned char lds[];
    Frame F;
    F.lds = (LAS unsigned char*)lds;
    F.MISC = (volatile LAS unsigned*)(F.lds + MISC_OFF);
    F.tid = threadIdx.x; F.lane = F.tid & 63; F.wave = __builtin_amdgcn_readfirstlane(F.tid >> 6);
    F.G = gridDim.x; { const int bx = blockIdx.x; F.vcu = (F.G % 8 == 0) ? (bx % 8) * (F.G / 8) + bx / 8 : bx; }
    unsigned char* ws = args.ws; F.ws = ws; F.out = args.out;
    F.ctl = (gu32*)(ws + WS_CTL);
#pragma unroll
    for (int i = 0; i < 21; ++i) F.in[i] = args.in[i];
    for (int u = F.tid; u < (LDS_BYTES - LDSCTL_OFF) / 4; u += NWAVES * 64) ((LAS unsigned*)(F.lds + LDSCTL_OFF))[u] = 0u;
    __syncthreads();
    const int lo = args.ph_lo, hi = args.ph_hi;
    const bool use_bar = (hi - lo) > 1;
    XcdBarrier bar; bar.bar = (unsigned*)(F.ctl + CW_BAR); bar.x = 0; bar.st = nullptr;
    if (use_bar) bar = xcd_barrier_post((unsigned*)(F.ctl + CW_BAR), F.MISC + 8);
#define IN(k) (lo <= (k) && (k) < hi)
#define SEAM(k) do { if (IN(k) && IN((k) + 1)) xcd_barrier(bar); } while (0)

    float* ssq = (float*)(F.ctl + CW_SSQ);
    if (IN(0)) { p0_prologue(F); SEAM(0); }
    if (IN(1)) { p1_ssm(F); SEAM(1); }
    if (IN(2)) {
        pg8::Gemm g{(const pg8::bf16_t*)(ws + WS_YSSM), (const pg8::bf16_t*)(ws + WS_WGLU), M, 2 * DM, DM}; pg8::MallOrder S; S.init(M, 2 * DM, F.G, (int)blockIdx.x, 256, 1);
        pg8::EpiGlu E{F.in[I_XP], F.in[I_XS], (float*)(ws + WS_XRES), (pg8::bf16_t*)(ws + WS_HA), ssq};
        pg8::gemm_phase<pg8::EpiGlu, pg8::MallOrder, PG8_ALIGN, PG8_SP2>(F.lds + RING_OFF, g, S, E);
        { constexpr int NIDLE = 256 - (36 * 32) % 256, QUOTA = 60; const int j = (int)blockIdx.x - (256 - NIDLE);
          if (F.G == 256 && j >= 0) { convert_reset(F); convert_weights(F, CI_GLU + CI_GU, CI_L0, j, NIDLE); } }
        SEAM(2);
    }
    if (IN(3)) {
        pg8::Gemm g{(const pg8::bf16_t*)(ws + WS_HA), (const pg8::bf16_t*)(ws + WS_WGU0), M, 2 * DFF, DM}; pg8::MallOrder S; S.init(M, 2 * DFF, F.G, (int)blockIdx.x, 256, 1);
        pg8::EpiSwiglu E{(pg8::bf16_t*)(ws + WS_HID), DFF, ssq};
        pg8::gemm_phase<pg8::EpiSwiglu, pg8::MallOrder, PG8_ALIGN, PG8_SP2>(F.lds + RING_OFF, g, S, E);
        { constexpr int NIDLE = 256 - (36 * 86) % 256, LO = CI_L0 + 128 * 60, HI = CI_ALL - CI_DN; const int j = (int)blockIdx.x - (256 - NIDLE);
          if (F.G == 256) { if (j >= 0) { convert_reset(F); convert_weights(F, CI_L0, HI, j, NIDLE); } }
          else { convert_reset(F); convert_weights(F, CI_L0, HI, F.vcu, F.G); } }
        SEAM(3);
    }
    if (IN(4)) { down_phase(F, ws + WS_WDN0, ssq + M, 0); SEAM(4); }
    if (IN(5)) { pool_elem(F); SEAM(5); }
    if (IN(6)) {
        pg8::Gemm g{(const pg8::bf16_t*)(ws + WS_PPOOL), (const pg8::bf16_t*)(ws + WS_WPOOL), 4 * M, 4096, 1024}; pg8::PoolOrder S{F.G, (int)blockIdx.x, 48};
        pg8::EpiResid<true> E{(float*)(ws + WS_XRES), F.in[I_PSCALE], (pg8::bf16_t*)(ws + WS_HA), ssq + 2 * M, 48};
        pg8::gemm_phase<pg8::EpiResid<true>, pg8::PoolOrder, PG8_ALIGN, PG8_SP2, 3>(F.lds + RING_OFF, g, S, E);
        SEAM(6);
    }
    if (IN(7)) {
        pg8::Gemm g{(const pg8::bf16_t*)(ws + WS_HA), (const pg8::bf16_t*)(ws + WS_WGU1), M, 2 * DFF, DM};
        pg8::EpiSwiglu E{(pg8::bf16_t*)(ws + WS_HID), DFF, ssq + 2 * M};
        constexpr int NU = 36 * 86, NT = NU % 256;
        if (F.G == 256) {
            pg8::MallOrder S; S.init(M, 2 * DFF, F.G, (int)blockIdx.x, 256, 1, NU / 256);
            pg8::gemm_phase<pg8::EpiSwiglu, pg8::MallOrder, PG8_ALIGN, PG8_SP2>(F.lds + RING_OFF, g, S, E);
            pg8::TailOrder T{S, NT, NU / 256};
            pg8::gemm_phase<pg8::EpiSwiglu, pg8::TailOrder, PG8_ALIGN, PG8_SP2, 2>(F.lds + RING_OFF, g, T, E);
            const int j = (int)blockIdx.x - 2 * NT;
            if (j >= 0) { convert_reset(F); convert_weights(F, CI_ALL - CI_DN, CI_ALL, j, 256 - 2 * NT); }
        } else {
            pg8::MallOrder S; S.init(M, 2 * DFF, F.G, (int)blockIdx.x, 256, 1);
            pg8::gemm_phase<pg8::EpiSwiglu, pg8::MallOrder, PG8_ALIGN, PG8_SP2>(F.lds + RING_OFF, g, S, E);
            convert_reset(F); convert_weights(F, CI_ALL - CI_DN, CI_ALL, F.vcu, F.G);
        }
        SEAM(7);
    }
    if (IN(8)) { down_phase(F, ws + WS_WDN1, ssq + 3 * M, 1); SEAM(8); }
    if (IN(9)) { final_norm(F, F.in[I_NFIN], ssq + 3 * M, F.out + O_YP); }
#undef IN
#undef SEAM
}

extern "C" void kernel_launch(void* const* d_in, const int* in_sizes, int n_in, void* d_out, int out_size, void* d_ws, size_t ws_size, hipStream_t stream) {
    static int grid = 0;
    if (grid == 0) {
        if (n_in != 21 || in_sizes[0] != MP * DM || (size_t)out_size != O_END || ws_size < WS_END) { fprintf(stderr, "kernel_launch: unexpected shapes (n_in %d, in0 %d, out %d, ws %zu); nothing launched\n", n_in, n_in > 0 ? in_sizes[0] : -1, out_size, ws_size); grid = -1; return; }
        int dev = 0, cus = 0, per_cu = 0;
        if (hipGetDevice(&dev) != hipSuccess || hipDeviceGetAttribute(&cus, hipDeviceAttributeMultiprocessorCount, dev) != hipSuccess) { grid = -1; return; }
        if (hipFuncSetAttribute((const void*)skel_fwd, hipFuncAttributeMaxDynamicSharedMemorySize, LDS_BYTES) != hipSuccess) { fprintf(stderr, "kernel_launch: hipFuncSetAttribute failed\n"); grid = -1; return; }
        if (hipOccupancyMaxActiveBlocksPerMultiprocessor(&per_cu, (const void*)skel_fwd, NWAVES * 64, LDS_BYTES) != hipSuccess || per_cu < 1) { fprintf(stderr, "kernel_launch: occupancy query says %d blocks per CU\n", per_cu); }
        (void)hipGetLastError();
        grid = cus;
    }
    if (grid < 0) return;
    if (hipMemsetAsync((char*)d_ws + WS_CTL, 0, CTL_ZERO_BYTES, stream) != hipSuccess) return;
    Args a{};
    for (int i = 0; i < 21; ++i) a.in[i] = (const float*)d_in[i];
    a.out = (float*)d_out; a.ws = (unsigned char*)d_ws;
#if MK_ONE_LAUNCH
    a.ph_lo = 0; a.ph_hi = N_PHASES;
    hipLaunchKernelGGL(skel_fwd, dim3(grid), dim3(NWAVES * 64), LDS_BYTES, stream, a);
#else
    for (int ph = 0; ph < N_PHASES; ++ph) { a.ph_lo = ph; a.ph_hi = ph + 1; hipLaunchKernelGGL(skel_fwd, dim3(grid), dim3(NWAVES * 64), LDS_BYTES, stream, a); }
#endif
}
```

```cpp
#include <hip/hip_runtime.h>
#include <cstdio>
#include <cstdint>
namespace pg8 {
#define PG8_LAS __attribute__((address_space(3)))
typedef unsigned short bf16_t;
typedef short bf16x8 __attribute__((ext_vector_type(8)));
typedef float f32x4 __attribute__((ext_vector_type(4)));
typedef unsigned u32x4 __attribute__((ext_vector_type(4)));
constexpr int BM = 256, BK = 64, HALF = 128, HTB = HALF * BK * 2  , STAGE_BYTES = 8 * HTB, NXCD = 8, WGM = 8;

__host__ __device__ __forceinline__ int lds_byte(int r, int c) { const int st = (r >> 4) * 2 + (c >> 5), rr = r & 15, cc = c & 31, ob = rr * 64 + cc * 2; return st * 1024 + (ob ^ (((ob >> 9) & 1) << 5)); }
__host__ __device__ __forceinline__ void stage_rc(int b, int& R, int& C) { const int st = b / 1024, sb = b % 1024, swz = sb ^ (((sb >> 9) & 1) << 5); R = (st >> 1) * 16 + swz / 64; C = (st & 1) * 32 + (swz % 64) / 2; }
__host__ __device__ __forceinline__ int perm32(int rho) { const int n = rho >> 4, i = rho & 15; return 8 * (i >> 2) + 4 * n + (i & 3); }

struct Unit { int pm, pn; };
struct Gemm { const bf16_t* A; const bf16_t* Bt; int M, N, K; int nt; };

struct StaticOrder {
    int nM, nN, nwg, G, c;
    __host__ __device__ void init(int M, int N, int G_, int c_, int bm = BM) { nM = M / bm; nN = N / BM; nwg = nM * nN; G = G_; c = c_; }
    __host__ __device__ bool next(int i, Unit& u) const {
        const long L = (long)i * G + c; if (L >= nwg) return false;
        int wgid = (int)L; { const int q = nwg / NXCD, r = nwg % NXCD, xcd = wgid % NXCD, off = wgid / NXCD; wgid = (xcd < r ? xcd * (q + 1) : r * (q + 1) + (xcd - r) * q) + off; }
        const int nig = WGM * nN, gid = wgid / nig, fm = gid * WGM, gsz = (nM - fm) < WGM ? (nM - fm) : WGM;
        u.pm = fm + ((wgid % nig) % gsz); u.pn = (wgid % nig) / gsz; return true;
    }
    __device__ __forceinline__ void a_ready(const Unit&) const {}
    __device__ __forceinline__ void done(const Unit&) const {}
};

struct MallOrder {
    int nM, nN, G, c, XR, maxr;
    __host__ __device__ void init(int M, int N, int G_, int c_, int bm, int XR_, int maxr_ = 1 << 20) { nM = M / bm; nN = N / BM; G = G_; c = c_; XR = XR_; maxr = maxr_; }
    __host__ __device__ bool next(int i, Unit& u) const {
        constexpr int CW = 32; if (i >= maxr) return false;
        const int XC = NXCD / XR, x = c % NXCD, xr = x / XC, xc = x % XC;
        int q = i * (G / NXCD) + c / NXCD;
        for (int ch = 0; ch * CW < nN; ++ch) {
            const int cw = (nN - ch * CW) < CW ? (nN - ch * CW) : CW;
            for (int g = 0; g * XR * 8 < nM; ++g) {
                const int fm = (g * XR + xr) * 8, left = nM - fm, gsz = left < 0 ? 0 : (left < 8 ? left : 8), perg = gsz * cw / XC;
                if (q < perg) { const int uu = xc * perg + q; u.pm = fm + uu % gsz; u.pn = ch * CW + uu / gsz; return true; }
                q -= perg;
            }
        }
        return false;
    }
    __device__ __forceinline__ void a_ready(const Unit&) const {}
    __device__ __forceinline__ void done(const Unit&) const {}
};

struct TailOrder {
    MallOrder base; int nt, round;
    __host__ __device__ bool next(int i, Unit& u) const {
        if (i != 0 || base.c >= 2 * nt) return false;
        MallOrder b = base; b.c = base.c % nt; b.maxr = 1 << 20; Unit v; if (!b.next(round, v)) return false;
        u.pm = 2 * v.pm + base.c / nt; u.pn = v.pn; return true;
    }
    __device__ __forceinline__ void a_ready(const Unit&) const {}
    __device__ __forceinline__ void done(const Unit&) const {}
};


__device__ __forceinline__ unsigned cvt_pk_bf16(float lo, float hi) { unsigned r; asm volatile("v_cvt_pk_bf16_f32 %0, %1, %2" : "=v"(r) : "v"(lo), "v"(hi)); return r; }
__device__ __forceinline__ float sigmoid_f(float x) { return __builtin_amdgcn_rcpf(1.0f + __expf(-x)); }

__device__ __forceinline__ void ssq_add(float* ssq, int row, float s, int fq) {
    s += __shfl_xor(s, 16); s += __shfl_xor(s, 32);
    if (fq == 0) unsafeAtomicAdd(ssq + row, s);
}
__device__ __forceinline__ float rstd_of(const float* ssq, int row) { return __builtin_amdgcn_rsqf(ssq[row] * (1.0f / 4096.0f) + 1e-6f); }
struct EpiGlu {
    static constexpr bool PERM = false, AFTER_DRAIN = false;
    const float* xin_p; const float* xin_s; float* xout; bf16_t* xb; float* ssq;
    template <int MQ> __device__ __forceinline__ void operator()(const f32x4 (&acc)[2][2][MQ][2], const Unit& u, int wr, int wc, int fr, int fq) const {
        constexpr int MHALF = 32 * MQ; const int row0 = u.pm * (2 * MHALF) + wr * (16 * MQ) + fr, col0 = u.pn * HALF + wc * 32 + 4 * fq;
        const float* xi = (row0 < 8192) ? xin_p + (size_t)row0 * 4096 : xin_s + (size_t)(row0 - 8192) * 4096;
        float* ob = xout + (size_t)row0 * 4096; bf16_t* bb = xb + (size_t)row0 * 4096;
#pragma unroll
        for (int ai = 0; ai < 2; ++ai)
#pragma unroll
            for (int m = 0; m < MQ; ++m) { const size_t off = (size_t)(ai * MHALF + m * 16) * 4096 + col0; float sq = 0.f;
#pragma unroll
                for (int n = 0; n < 2; ++n) { const f32x4 xv = *(const f32x4*)(xi + off + 16 * n); const f32x4 a = acc[ai][0][m][n], b = acc[ai][1][m][n]; f32x4 o;
#pragma unroll
                    for (int j = 0; j < 4; ++j) { o[j] = xv[j] + a[j] * sigmoid_f(b[j]); sq = fmaf(o[j], o[j], sq); }
                    *(f32x4*)(ob + off + 16 * n) = o;
                    *(unsigned long long*)(bb + off + 16 * n) = (unsigned long long)cvt_pk_bf16(o[0], o[1]) | ((unsigned long long)cvt_pk_bf16(o[2], o[3]) << 32); }
                ssq_add(ssq, row0 + ai * MHALF + m * 16, sq, fq); }
    }
};
struct EpiSwiglu {
    static constexpr bool PERM = true, AFTER_DRAIN = false;
    bf16_t* O; int ldc; const float* ssq;
    template <int MQ> __device__ __forceinline__ void operator()(const f32x4 (&acc)[2][2][MQ][2], const Unit& u, int wr, int wc, int fr, int fq) const {
        constexpr int MHALF = 32 * MQ; const int row0 = u.pm * (2 * MHALF) + wr * (16 * MQ) + fr, col0 = u.pn * HALF + wc * 32 + 8 * fq;
#pragma unroll
        for (int ai = 0; ai < 2; ++ai)
#pragma unroll
            for (int m = 0; m < MQ; ++m) { const int r = row0 + ai * MHALF + m * 16; bf16_t* rowp = O + (size_t)r * ldc + col0; const float rs = rstd_of(ssq, r);
                const float c2 = rs * -1.4426950408889634f, rs2 = rs * rs;
                f32x4 h[2];
#pragma unroll
                for (int n = 0; n < 2; ++n) { const f32x4 g = acc[ai][0][m][n], v = acc[ai][1][m][n];
#pragma unroll
                    for (int j = 0; j < 4; ++j) h[n][j] = (g[j] * v[j]) * (rs2 * __builtin_amdgcn_rcpf(1.0f + __builtin_amdgcn_exp2f(g[j] * c2))); }
                u32x4 w; w.x = cvt_pk_bf16(h[0][0], h[0][1]); w.y = cvt_pk_bf16(h[0][2], h[0][3]); w.z = cvt_pk_bf16(h[1][0], h[1][1]); w.w = cvt_pk_bf16(h[1][2], h[1][3]);
                *(u32x4*)rowp = w; }
    }
};
template <bool POOL> struct EpiResid {
    static constexpr bool PERM = false, AFTER_DRAIN = false;
    float* x; const float* scale; bf16_t* xb; float* ssq; int npm;
    template <int MQ> __device__ __forceinline__ void operator()(const f32x4 (&acc)[2][2][MQ][2], const Unit& u, int wr, int wc, int fr, int fq) const {
        constexpr int MHALF = 32 * MQ; const int pm = POOL ? (u.pm % npm) : u.pm;
        const int row0 = pm * (2 * MHALF) + wr * (16 * MQ) + fr, col0 = u.pn * BM + wc * 32 + 4 * fq;
        f32x4 sv[2][2];
#pragma unroll
        for (int bj = 0; bj < 2; ++bj)
#pragma unroll
            for (int n = 0; n < 2; ++n) sv[bj][n] = POOL ? *(const f32x4*)(scale + col0 + bj * HALF + n * 16) : (f32x4){1.f, 1.f, 1.f, 1.f};
#pragma unroll
        for (int ai = 0; ai < 2; ++ai)
#pragma unroll
            for (int m = 0; m < MQ; ++m) { const int r = row0 + ai * MHALF + m * 16; float* rowp = x + (size_t)r * 4096 + col0; float sq = 0.f;
#pragma unroll
                for (int bj = 0; bj < 2; ++bj)
#pragma unroll
                    for (int n = 0; n < 2; ++n) { const f32x4 xv = *(const f32x4*)(rowp + bj * HALF + n * 16);
                        const f32x4 o = POOL ? xv + acc[ai][bj][m][n] * sv[bj][n] : xv + acc[ai][bj][m][n];
                        sq += (o[0] * o[0] + o[1] * o[1]) + (o[2] * o[2] + o[3] * o[3]);
                        *(f32x4*)(rowp + bj * HALF + n * 16) = o;
                        if (POOL) *(unsigned long long*)(xb + (size_t)r * 4096 + col0 + bj * HALF + n * 16) = (unsigned long long)cvt_pk_bf16(o[0], o[1]) | ((unsigned long long)cvt_pk_bf16(o[2], o[3]) << 32); }
                ssq_add(ssq, r, sq, fq); }
    }
};
struct EpiResidSplit {
    static constexpr bool PERM = false, AFTER_DRAIN = false;
    float* x; float* ssq; float* slab; unsigned* ctr; int part;
    template <int MQ> __device__ __forceinline__ void operator()(const f32x4 (&acc)[2][2][MQ][2], const Unit& u, int wr, int wc, int fr, int fq) const {
        static_assert(MQ == 4, "split tail: 256-row tiles");
        const int tid = threadIdx.x;
        if (part != 0) {
            f32x4* sp = (f32x4*)slab + (size_t)(part - 1) * 16384 + tid;
#pragma unroll
            for (int ai = 0; ai < 2; ++ai)
#pragma unroll
                for (int bj = 0; bj < 2; ++bj)
#pragma unroll
                    for (int m = 0; m < 4; ++m)
#pragma unroll
                        for (int n = 0; n < 2; ++n) sp[(((ai * 2 + bj) * 4 + m) * 2 + n) * 512] = acc[ai][bj][m][n];
            return;
        }
        { unsigned sp = 0; while (__hip_atomic_load(ctr, __ATOMIC_RELAXED, __HIP_MEMORY_SCOPE_AGENT) < 3u && ++sp < (1u << 22)) __builtin_amdgcn_s_sleep(2); }
        __builtin_amdgcn_fence(__ATOMIC_ACQUIRE, "agent");
        const f32x4* sp = (const f32x4*)slab + tid;
        const int row0 = u.pm * 256 + wr * 64 + fr, col0 = u.pn * BM + wc * 32 + 4 * fq;
#pragma unroll
        for (int ai = 0; ai < 2; ++ai)
#pragma unroll
            for (int m = 0; m < 4; ++m) { const int r = row0 + ai * 128 + m * 16; float* rowp = x + (size_t)r * 4096 + col0; float sq = 0.f;
#pragma unroll
                for (int bj = 0; bj < 2; ++bj)
#pragma unroll
                    for (int n = 0; n < 2; ++n) { const int idx = (((ai * 2 + bj) * 4 + m) * 2 + n) * 512;
                        const f32x4 xv = *(const f32x4*)(rowp + bj * HALF + n * 16);
                        const f32x4 o = (xv + acc[ai][bj][m][n]) + ((sp[idx] + sp[16384 + idx]) + sp[32768 + idx]);
                        sq += (o[0] * o[0] + o[1] * o[1]) + (o[2] * o[2] + o[3] * o[3]);
                        *(f32x4*)(rowp + bj * HALF + n * 16) = o; }
                ssq_add(ssq, r, sq, fq); }
    }
};
struct SplitOrder {
    int c, pm0;
    __device__ bool next(int i, Unit& u) const { if (i != 0) return false; const int slot = (c >> 3) & 7; u.pm = pm0 + (slot & 3); u.pn = 2 * (c & 7) + (slot >> 2); return true; }
    __device__ __forceinline__ void a_ready(const Unit&) const {}
    __device__ __forceinline__ void done(const Unit&) const {}
};
struct PoolOrder {
    int G, c, npm;
    __device__ bool next(int i, Unit& u) const {
        const int per = npm * 4, L = i * G + c; if (L >= 4 * per) return false;
        const int grp = L / per, rem = L % per; u.pm = grp * npm + rem % npm; u.pn = grp * 4 + rem / npm; return true;
    }
    __device__ __forceinline__ void a_ready(const Unit&) const {}
    __device__ __forceinline__ void done(const Unit&) const {}
};

template <class Epi, class Sched, bool ALIGN_EPI = false, bool SP2 = false, int MQ = 4>
__device__ __forceinline__ void gemm_phase(PG8_LAS unsigned char* lds, const Gemm g, const Sched& S, const Epi& E) {
    const int tid = threadIdx.x, wid = __builtin_amdgcn_readfirstlane(tid >> 6), lane = tid & 63, wr = wid >> 2, wc = wid & 3, fr = lane & 15, fq = lane >> 4;
    static_assert(MQ == 4 || ((MQ == 3 || MQ == 2) && SP2), "192- and 128-row tiles: only the SP2 loop carries the wave-group-specific waits");
    const int K = g.K, nt = g.nt ? g.nt : K / BK;
    unsigned voffA[2], voffB[2];
#pragma unroll
    for (int i = 0; i < 2; ++i) { int R, C; stage_rc(tid * 16 + i * 8192, R, C); const int Rb = Epi::PERM ? ((R & ~31) + perm32(R & 31)) : R;
        voffA[i] = (unsigned)(R * K + C) * 2u; voffB[i] = (unsigned)(Rb * K + C) * 2u; }
    const size_t kstep = (size_t)(BK * 2);
    const size_t hstep = (size_t)HALF * K * 2, hstepA = (size_t)(32 * MQ) * K * 2;
    const size_t tstep = 2 * hstep, tstepA = 2 * hstepA;
    const unsigned ldsw = (unsigned)wid * 1024u;
    const int aoff = lds_byte(wr * (16 * MQ) + fr, fq * 8), boff = lds_byte(wc * 32 + fr, fq * 8);
#define PG8_SA(b, h) (((b) * 2 + (h)) * HTB)
#define PG8_SB(b, h) ((4 + (b) * 2 + (h)) * HTB)
#define PG8_STAGE(bufoff, gbase, voff) do { _Pragma("unroll") for (int _i = 0; _i < 2; ++_i) \
        __builtin_amdgcn_global_load_lds((const unsigned*)((const char*)(gbase) + (voff)[_i]), (PG8_LAS unsigned*)(lds + (bufoff) + ldsw + _i * 8192), 16, 0, 0); } while (0)
#define PG8_STAGE_A(bufoff, gbase) do { __builtin_amdgcn_global_load_lds((const unsigned*)((const char*)(gbase) + voffA[0]), (PG8_LAS unsigned*)(lds + (bufoff) + ldsw), 16, 0, 0); \
        if (MQ == 4 || (MQ == 3 && wid < 4)) __builtin_amdgcn_global_load_lds((const unsigned*)((const char*)(gbase) + voffA[1]), (PG8_LAS unsigned*)(lds + (bufoff) + ldsw + 8192), 16, 0, 0); } while (0)
#define PG8_LDA(dst, b, h) do { _Pragma("unroll") for (int m = 0; m < MQ; ++m) _Pragma("unroll") for (int k = 0; k < 2; ++k) dst[m][k] = *(const PG8_LAS bf16x8*)(lds + PG8_SA(b, h) + aoff + m * 2048 + k * 1024); } while (0)
#define PG8_LDB(dst, b, h) do { _Pragma("unroll") for (int n = 0; n < 2; ++n) _Pragma("unroll") for (int k = 0; k < 2; ++k) dst[n][k] = *(const PG8_LAS bf16x8*)(lds + PG8_SB(b, h) + boff + n * 2048 + k * 1024); } while (0)
#define PG8_MMA(ai, bj, At, Bt) do { __builtin_amdgcn_s_setprio(1); _Pragma("unroll") for (int m = 0; m < MQ; ++m) _Pragma("unroll") for (int n = 0; n < 2; ++n) _Pragma("unroll") for (int k = 0; k < 2; ++k) \
        acc[ai][bj][m][n] = __builtin_amdgcn_mfma_f32_16x16x32_bf16(Bt[n][k], At[m][k], acc[ai][bj][m][n], 0, 0, 0); __builtin_amdgcn_s_setprio(0); } while (0)
#define PG8_WAIT_V(n) asm volatile("s_waitcnt vmcnt(" #n ")" ::: "memory")
#define PG8_WAIT_V8 do { if (MQ == 2 || (MQ == 3 && wid >= 4)) PG8_WAIT_V(6); else PG8_WAIT_V(8); } while (0)
#define PG8_WAIT_L(n) asm volatile("s_waitcnt lgkmcnt(" #n ")" ::: "memory")
#define PG8_BAR __builtin_amdgcn_s_barrier()
#define PG8_SCHED __builtin_amdgcn_sched_barrier(0)
    Unit cur, nxt; int ui = 0;
    if (!S.next(0, cur)) return;
    f32x4 acc[2][2][MQ][2];
#pragma unroll
    for (int a = 0; a < 2; ++a)
#pragma unroll
        for (int b = 0; b < 2; ++b)
#pragma unroll
            for (int m = 0; m < MQ; ++m)
#pragma unroll
                for (int n = 0; n < 2; ++n) acc[a][b][m][n] = (f32x4){0.f, 0.f, 0.f, 0.f};
    bf16x8 At[MQ][2], B0[2][2], B1[2][2];
    const char* cA = (const char*)g.A + (size_t)cur.pm * tstepA; const char* cB = (const char*)g.Bt + (size_t)cur.pn * tstep;
    S.a_ready(cur);
    if constexpr (SP2) {
        PG8_STAGE(PG8_SB(0, 0), cB, voffB); PG8_STAGE(PG8_SB(0, 1), cB + hstep, voffB); PG8_STAGE_A(PG8_SA(0, 0), cA); PG8_STAGE_A(PG8_SA(0, 1), cA + hstepA);
        if (wr == 1) PG8_BAR;
        if (MQ == 2 || (MQ == 3 && wid >= 4)) PG8_WAIT_V(1); else PG8_WAIT_V(2);
        PG8_BAR;
        PG8_STAGE(PG8_SB(1, 0), cB + kstep, voffB); PG8_STAGE_A(PG8_SA(1, 0), cA + kstep); PG8_STAGE(PG8_SB(1, 1), cB + hstep + kstep, voffB);
        if (MQ == 2 || (MQ == 3 && wid >= 4)) PG8_WAIT_V(5); else PG8_WAIT_V(6);
        PG8_BAR;
    } else {
        PG8_STAGE(PG8_SB(0, 0), cB, voffB); PG8_STAGE_A(PG8_SA(0, 0), cA); PG8_STAGE(PG8_SB(0, 1), cB + hstep, voffB); PG8_STAGE_A(PG8_SA(0, 1), cA + hstepA);
        if (wr == 1) PG8_BAR;
        PG8_WAIT_V(4); PG8_BAR;
        PG8_STAGE(PG8_SB(1, 0), cB + kstep, voffB); PG8_STAGE_A(PG8_SA(1, 0), cA + kstep); PG8_STAGE(PG8_SB(1, 1), cB + hstep + kstep, voffB);
        PG8_WAIT_V(6); PG8_BAR;
    }
    for (;;) {
        const bool has_next = S.next(ui + 1, nxt);
        const char* nA = has_next ? (const char*)g.A + (size_t)nxt.pm * tstepA : cA; const char* nB = has_next ? (const char*)g.Bt + (size_t)nxt.pn * tstep : cB;
        for (int t = 0; t < nt; t += 2) {
            const bool last = (t == nt - 2);
            const char* a1 = cA + (size_t)(t + 1) * kstep;
            const char* a2 = last ? nA : cA + (size_t)(t + 2) * kstep; const char* b2 = last ? nB : cB + (size_t)(t + 2) * kstep;
            const char* a3 = a2 + kstep; const char* b3 = b2 + kstep;
            if (last && has_next) S.a_ready(nxt);
            if constexpr (SP2) {
            PG8_LDB(B0, 0, 0); PG8_LDB(B1, 0, 1); PG8_SCHED; PG8_LDA(At, 0, 0); PG8_STAGE_A(PG8_SA(1, 1), a1 + hstepA);
            PG8_WAIT_V8; PG8_WAIT_L(0); PG8_BAR; PG8_MMA(0, 0, At, B0); PG8_MMA(0, 1, At, B1); PG8_BAR; PG8_SCHED;
            PG8_LDA(At, 0, 1); PG8_STAGE(PG8_SB(0, 0), b2, voffB); PG8_STAGE(PG8_SB(0, 1), b2 + hstep, voffB); PG8_STAGE_A(PG8_SA(0, 0), a2);
            PG8_WAIT_V8; PG8_WAIT_L(0); PG8_BAR; PG8_MMA(1, 0, At, B0); PG8_MMA(1, 1, At, B1); PG8_BAR; PG8_SCHED;
            PG8_LDB(B0, 1, 0); PG8_LDB(B1, 1, 1); PG8_SCHED; PG8_LDA(At, 1, 0); PG8_STAGE_A(PG8_SA(0, 1), a2 + hstepA);
            PG8_WAIT_V8; PG8_WAIT_L(0); PG8_BAR; PG8_MMA(0, 0, At, B0); PG8_MMA(0, 1, At, B1); PG8_BAR; PG8_SCHED;
            PG8_LDA(At, 1, 1); PG8_STAGE(PG8_SB(1, 0), b3, voffB); PG8_STAGE(PG8_SB(1, 1), b3 + hstep, voffB); PG8_STAGE_A(PG8_SA(1, 0), a3);
            PG8_WAIT_V8; PG8_WAIT_L(0); PG8_BAR; PG8_MMA(1, 0, At, B0); PG8_MMA(1, 1, At, B1); PG8_BAR; PG8_SCHED;
            } else {
            PG8_LDB(B0, 0, 0); PG8_SCHED; PG8_LDA(At, 0, 0); PG8_STAGE_A(PG8_SA(1, 1), a1 + hstepA);
            PG8_WAIT_L(8); PG8_BAR; PG8_WAIT_L(0); PG8_MMA(0, 0, At, B0); PG8_BAR; PG8_SCHED;
            PG8_LDB(B1, 0, 1); PG8_STAGE(PG8_SB(0, 0), b2, voffB);
            PG8_BAR; PG8_WAIT_L(0); PG8_MMA(0, 1, At, B1); PG8_BAR;
            PG8_LDA(At, 0, 1); PG8_STAGE_A(PG8_SA(0, 0), a2);
            PG8_BAR; PG8_WAIT_L(0); PG8_MMA(1, 0, At, B0); PG8_BAR; PG8_SCHED;
            PG8_STAGE(PG8_SB(0, 1), b2 + hstep, voffB);
            PG8_WAIT_V(6); PG8_BAR; PG8_MMA(1, 1, At, B1); PG8_BAR;
            PG8_LDB(B0, 1, 0); PG8_SCHED; PG8_LDA(At, 1, 0); PG8_STAGE_A(PG8_SA(0, 1), a2 + hstepA);
            PG8_WAIT_L(8); PG8_BAR; PG8_WAIT_L(0); PG8_MMA(0, 0, At, B0); PG8_BAR; PG8_SCHED;
            PG8_LDB(B1, 1, 1); PG8_STAGE(PG8_SB(1, 0), b3, voffB);
            PG8_BAR; PG8_WAIT_L(0); PG8_MMA(0, 1, At, B1); PG8_BAR;
            PG8_LDA(At, 1, 1); PG8_STAGE_A(PG8_SA(1, 0), a3);
            PG8_BAR; PG8_WAIT_L(0); PG8_MMA(1, 0, At, B0); PG8_BAR; PG8_SCHED;
            PG8_STAGE(PG8_SB(1, 1), b3 + hstep, voffB);
            PG8_WAIT_V(6); PG8_BAR; PG8_MMA(1, 1, At, B1); PG8_BAR;
            }
        }
        if constexpr (ALIGN_EPI) { if (wr == 0) PG8_BAR; }
        if constexpr (!Epi::AFTER_DRAIN) { E(acc, cur, wr, wc, fr, fq); S.done(cur); }
        if (!has_next) break;
#pragma unroll
        for (int a = 0; a < 2; ++a)
#pragma unroll
            for (int b = 0; b < 2; ++b)
#pragma unroll
                for (int m = 0; m < MQ; ++m)
#pragma unroll
                    for (int n = 0; n < 2; ++n) acc[a][b][m][n] = (f32x4){0.f, 0.f, 0.f, 0.f};
        cur = nxt; cA = nA; cB = nB; ++ui;
        if constexpr (ALIGN_EPI) { if (wr == 1) PG8_BAR; }
    }
    PG8_WAIT_V(0);
    if constexpr (!ALIGN_EPI) { if (wr == 0) PG8_BAR; }
    PG8_BAR;
    if constexpr (Epi::AFTER_DRAIN) { E.fused(acc, cur, wr, wc, fr, fq, lds, wid, lane); S.done(cur); }
#undef PG8_SA
#undef PG8_SB
#undef PG8_STAGE
#undef PG8_LDA
#undef PG8_LDB
#undef PG8_MMA
#undef PG8_WAIT_V
#undef PG8_WAIT_V8
#undef PG8_STAGE_A
#undef PG8_WAIT_L
#undef PG8_BAR
#undef PG8_SCHED
}
}

#ifndef PG8_SP2
#define PG8_SP2 true
#endif
#ifndef PG8_ALIGN
#define PG8_ALIGN true
#endif
#ifndef MK_ONE_LAUNCH
#define MK_ONE_LAUNCH 1
#endif

constexpr int NWAVES = 8;
constexpr int DM = 4096, SEQ = 2048, NB = 4, DB = 128, DS = 8, MP = NB * SEQ, MS = DB * DS, M = MP + MS;
constexpr int DFF = 11008, NGRP = 256, NST = 64, NCH = 16, PBUF = 15;
constexpr float RMS_EPS = 1e-6f;
constexpr int N_PHASES = 10;
constexpr size_t O_YP = 0, O_YS = (size_t)MP * DM, O_SRP = O_YS + (size_t)MS * DM, O_SIP = O_SRP + (size_t)NB * NGRP * NST, O_PP = O_SIP + (size_t)NB * NGRP * NST,
                 O_SRS = O_PP + (size_t)NB * PBUF * DM, O_SIS = O_SRS + (size_t)DB * NGRP * NST, O_PS = O_SIS + (size_t)DB * NGRP * NST, O_END = O_PS + (size_t)DB * PBUF * DM;
constexpr size_t MiB = 1u << 20;
constexpr size_t WS_CTL = 0, CTL_ZERO_BYTES = 1 * MiB;
constexpr size_t WS_WGLU = 16 * MiB, WS_WGU0 = 80 * MiB, WS_WGU1 = 252 * MiB, WS_WDN0 = 424 * MiB, WS_WDN1 = 510 * MiB, WS_WPOOL = 596 * MiB;
constexpr size_t WS_XRES = 608 * MiB, WS_HA = 752 * MiB, WS_YSSM = 824 * MiB, WS_PPOOL = 896 * MiB, WS_HID = 968 * MiB, WS_SSMP = 1164 * MiB, WS_RSTD = 1169 * MiB, WS_END = 1170 * MiB;
static_assert(WS_WGLU + (size_t)2 * DM * DM * 2 <= WS_WGU0 && WS_WGU0 + (size_t)2 * DFF * DM * 2 <= WS_WGU1 && WS_WGU1 + (size_t)2 * DFF * DM * 2 <= WS_WDN0 && WS_WDN0 + (size_t)DM * DFF * 2 <= WS_WDN1 &&
              WS_WDN1 + (size_t)DM * DFF * 2 <= WS_WPOOL && WS_WPOOL + (size_t)4 * 1024 * 1024 * 2 <= WS_XRES && WS_XRES + (size_t)M * DM * 4 <= WS_HA && WS_HA + (size_t)M * DM * 2 <= WS_YSSM &&
              WS_YSSM + (size_t)M * DM * 2 <= WS_PPOOL && WS_PPOOL + (size_t)M * DM * 2 <= WS_HID && WS_HID + (size_t)M * DFF * 2 <= WS_SSMP, "d_ws map");
constexpr size_t SPB_AR = 0, SPB_AI = 65536, SPB_BF = 131072, SPB_CF = 131072 + 1048576;
constexpr int CW_BAR = 4096;
constexpr int CW_SPLIT = 65536;
constexpr int CW_SSQ = 16384;
constexpr int RING_OFF = 0, RING_BYTES = 131072;
constexpr int LDSCTL_OFF = RING_BYTES, MISC_OFF = LDSCTL_OFF + 320;
constexpr int LDS_BYTES = 147456;
static_assert(MISC_OFF + 128 <= LDS_BYTES, "LDS map");

#define GAS __attribute__((address_space(1)))
#define LAS __attribute__((address_space(3)))
typedef unsigned short bf16;
typedef unsigned v4u __attribute__((ext_vector_type(4)));
typedef float f32x4 __attribute__((ext_vector_type(4)));
typedef short bf16x8 __attribute__((ext_vector_type(8)));
typedef GAS unsigned gu32;
typedef GAS unsigned long long gu64;
#define RLX_AGENT __ATOMIC_RELAXED, __HIP_MEMORY_SCOPE_AGENT
#define LDS_WAIT() asm volatile("s_waitcnt lgkmcnt(0)" ::: "memory")
#define VM_WAIT() asm volatile("s_waitcnt vmcnt(0)" ::: "memory")
__device__ __forceinline__ unsigned long long rt() { return __builtin_amdgcn_s_memrealtime(); }
__device__ __forceinline__ unsigned f2bf(float f) { unsigned u = __builtin_bit_cast(unsigned, f); return (u + 0x7fffu + ((u >> 16) & 1u)) >> 16; }
__device__ __forceinline__ unsigned pk2(float lo, float hi) { return f2bf(lo) | (f2bf(hi) << 16); }

#define XB_TMO      128
#define XB_XCNT(j)  (256  + 64 * (j))
#define XB_XSUB(j)  (1280 + 64 * (j))
#define XB_XGEN(j)  (2304 + 64 * (j))
#define XB_TOP      3328
#define XB_TOPGEN   3392
#define XCD_BAR_WORDS 3456
#define XB_SPIN_CAP (1u << 18)

__device__ __forceinline__ unsigned xb_ld(unsigned* p)              { return __hip_atomic_load(p, __ATOMIC_RELAXED, __HIP_MEMORY_SCOPE_AGENT); }
__device__ __forceinline__ unsigned xb_add(unsigned* p, unsigned v) { return __hip_atomic_fetch_add(p, v, __ATOMIC_RELAXED, __HIP_MEMORY_SCOPE_AGENT); }
__device__ __forceinline__ unsigned xb_xcc_id() { return (unsigned)__builtin_amdgcn_s_getreg((3 << 11) | 20) & 0xFu; }
#define XB_SPIN(cond, bar) do { unsigned _sp = 0; while (cond) { __builtin_amdgcn_s_sleep(1); \
    if ((++_sp & 255u) == 0u) { if (xb_ld(&(bar)[XB_TMO])) break; if (_sp > XB_SPIN_CAP) { atomicAdd(&(bar)[XB_TMO], 1u); break; } } } } while (0)

struct XcdBarrier {
    unsigned* bar; unsigned x;
    volatile LAS unsigned* st;
};

__device__ __forceinline__ XcdBarrier xcd_barrier_post(unsigned* bar, volatile LAS unsigned* st) {
    XcdBarrier b; b.bar = bar; b.x = xb_xcc_id(); b.st = st;
    if (threadIdx.x == 0) (void)xb_add(&bar[XB_XCNT(b.x)], 1u);
    return b;
}
__device__ __forceinline__ void xcd_barrier_complete(unsigned* bar, unsigned x, unsigned& nloc, unsigned& nx) {
    const unsigned G = gridDim.x * gridDim.y * gridDim.z;
    unsigned sum, cnt, mine, sp = 0u;
    for (;;) {
        sum = 0u; cnt = 0u; mine = 0u;
#pragma unroll
        for (unsigned j = 0; j < 16; ++j) { const unsigned c = xb_ld(&bar[XB_XCNT(j)]); sum += c; cnt += (c > 0u) ? 1u : 0u; mine = (j == x) ? c : mine; }
        if (sum == G) break;
        __builtin_amdgcn_s_sleep(1);
        if ((++sp & 255u) == 0u) { if (xb_ld(&bar[XB_TMO])) break; if (sp > XB_SPIN_CAP) { atomicAdd(&bar[XB_TMO], 1u); break; } }
    }
    nloc = mine > 0u ? mine : 1u; nx = cnt > 0u ? cnt : 1u;
}

__device__ __forceinline__ void xcd_barrier(const XcdBarrier& b) {
    asm volatile("s_waitcnt vmcnt(0)" ::: "memory");
    __syncthreads();
    if (threadIdx.x == 0) {
        unsigned* bar = b.bar;
        __builtin_amdgcn_s_waitcnt(0);
        unsigned nloc = b.st[0], nx = b.st[1];
        if (nloc == 0u) { xcd_barrier_complete(bar, b.x, nloc, nx); b.st[0] = nloc; b.st[1] = nx; }
        const unsigned old = xb_add(&bar[XB_XSUB(b.x)], 1u);
        const unsigned gen = old / nloc;
        if (old + 1u == (gen + 1u) * nloc) {
            __builtin_amdgcn_fence(__ATOMIC_RELEASE, "agent");
            asm volatile("s_waitcnt vmcnt(0)" ::: "memory");
            const unsigned og = xb_add(&bar[XB_TOP], 1u);
            const unsigned tg = og / nx;
            if (og + 1u == (tg + 1u) * nx) xb_add(&bar[XB_TOPGEN], 1u);
            else XB_SPIN(xb_ld(&bar[XB_TOPGEN]) == tg, bar);
            __builtin_amdgcn_fence(__ATOMIC_ACQUIRE, "agent");
            xb_add(&bar[XB_XGEN(b.x)], 1u);
            asm volatile("s_waitcnt vmcnt(0)" ::: "memory");
        } else {
            XB_SPIN(xb_ld(&bar[XB_XGEN(b.x)]) == gen, bar);
            __builtin_amdgcn_fence(__ATOMIC_ACQUIRE, "agent");
            asm volatile("s_waitcnt vmcnt(0)" ::: "memory");
        }
    }
    __syncthreads();
}

struct Frame {
    LAS unsigned char* lds;
    volatile LAS unsigned* MISC;
    gu32* ctl;
    int tid, lane, wave;
    int vcu, G;
    const float* in[21];
    float* out;
    unsigned char* ws;
};
enum { I_XP = 0, I_XS, I_SRE, I_SIM, I_SPOOL, I_NMIX, I_NFFN, I_LRE, I_LIM, I_LSTEP, I_BRE, I_BIM, I_CRE, I_CIM, I_SD, I_WGLU, I_WPOOL, I_PSCALE, I_WGU, I_WDN, I_NFIN };

__device__ __forceinline__ float wave_sum(float v) {
#pragma unroll
    for (int o = 1; o < 64; o <<= 1) v += __shfl_xor(v, o);
    return v;
}
typedef float f32x2_t __attribute__((ext_vector_type(2)));
typedef __bf16 b16x2_t __attribute__((ext_vector_type(2)));
typedef float f32x16 __attribute__((ext_vector_type(16)));
__device__ __forceinline__ unsigned cvtpk(float lo, float hi) { return __builtin_bit_cast(unsigned, __builtin_convertvector((f32x2_t){lo, hi}, b16x2_t)); }
__device__ __forceinline__ const float* xrow_in(const Frame& F, int r) { return r < MP ? F.in[I_XP] + (size_t)r * DM : F.in[I_XS] + (size_t)(r - MP) * DM; }

__device__ __forceinline__ void tr_item(const float* W, int K, int N, bf16* WT, int k0, int n0, int drow0, int lane, const float* kgain = nullptr) {
    const int kq = lane >> 3, nq = lane & 7;
    f32x4 v[2][8];
#pragma unroll
    for (int h = 0; h < 2; ++h)
#pragma unroll
        for (int i = 0; i < 8; ++i) v[h][i] = __builtin_nontemporal_load((const GAS f32x4*)(W + (size_t)(k0 + 8 * kq + i) * N + n0 + 32 * h + 4 * nq));
    if (kgain) {
        const f32x4 g0 = *(const GAS f32x4*)(kgain + k0 + 8 * kq), g1 = *(const GAS f32x4*)(kgain + k0 + 8 * kq + 4);
#pragma unroll
        for (int h = 0; h < 2; ++h)
#pragma unroll
            for (int i = 0; i < 8; ++i) v[h][i] = v[h][i] * (i < 4 ? g0[i & 3] : g1[i & 3]);
    }
#pragma unroll
    for (int h = 0; h < 2; ++h)
#pragma unroll
        for (int j = 0; j < 4; ++j) { v4u o; o.x = cvtpk(v[h][0][j], v[h][1][j]); o.y = cvtpk(v[h][2][j], v[h][3][j]); o.z = cvtpk(v[h][4][j], v[h][5][j]); o.w = cvtpk(v[h][6][j], v[h][7][j]);
            *(GAS v4u*)(WT + (size_t)(drow0 + 32 * h + 4 * nq + j) * K + k0 + 8 * kq) = o; }
}
__device__ __forceinline__ int drow_pair(int n0, int NH) { const int half = n0 >= NH ? 1 : 0, nn = n0 - half * NH; return 256 * (nn >> 7) + 128 * half + (nn & 127); }

__device__ __forceinline__ double exp_d(double x) {
    const double k = __builtin_rint(x * 1.4426950408889634074); const double r = x - k * 0.69314718055994530942;
    double s = 1.0, t = 1.0;
#pragma unroll
    for (int i = 1; i <= 16; ++i) { t *= r * (1.0 / (double)i); s += t; }
    const long long e = (long long)k + 1023; return s * __builtin_bit_cast(double, (unsigned long long)e << 52);
}
__device__ __forceinline__ void sincos_d(double th, double& sn, double& cs) {
    const double n = __builtin_rint(th * 0.15915494309189533577); const double r = (th - n * 6.283185307179586232) - n * 2.4492935982947064e-16; const double r2 = r * r;
    double s = r, c = 1.0, ts = r, tc = 1.0;
#pragma unroll
    for (int i = 1; i <= 15; ++i) { tc *= r2 * (-1.0 / (double)((2 * i - 1) * (2 * i))); ts *= r2 * (-1.0 / (double)((2 * i) * (2 * i + 1))); c += tc; s += ts; }
    sn = s; cs = c;
}

constexpr int CI_GLU = (DM / 64) * (2 * DM / 64), CI_GU = (DM / 64) * (2 * DFF / 64), CI_DN = (DFF / 64) * (DM / 64), CI_PL = 4 * 16 * 16;
constexpr int CI_L0 = CI_GLU + CI_GU + CI_DN, CI_ALL = CI_L0 + CI_GU + CI_DN + CI_PL;
__device__ __forceinline__ void convert_weights(Frame& F, int lo, int hi, int first, int step) {
    LAS unsigned* ctr = (LAS unsigned*)(F.lds + MISC_OFF + 80);
    for (;;) {
        unsigned k = 0; if (F.lane == 0) k = __hip_atomic_fetch_add(ctr, 1u, __ATOMIC_RELAXED, __HIP_MEMORY_SCOPE_WORKGROUP);
        k = (unsigned)__builtin_amdgcn_readfirstlane((int)k);
        const long itl = (long)lo + first + (long)step * k; if (itl >= hi) break;
        int r = (int)itl;
        if (r < CI_GLU) { const int nb = r % (2 * DM / 64), kb = r / (2 * DM / 64); tr_item(F.in[I_WGLU], DM, 2 * DM, (bf16*)(F.ws + WS_WGLU), kb * 64, nb * 64, drow_pair(nb * 64, DM), F.lane); continue; } r -= CI_GLU;
        if (r >= 2 * CI_GU + CI_DN && r < 2 * CI_GU + CI_DN + CI_PL) { r -= 2 * CI_GU + CI_DN; const int g = r / 256; r -= g * 256; const int nb = r % 16, kb = r / 16;
            tr_item(F.in[I_WPOOL] + (size_t)g * 1024 * 1024, 1024, 1024, (bf16*)(F.ws + WS_WPOOL) + (size_t)g * 1024 * 1024, kb * 64, nb * 64, nb * 64, F.lane); continue; }
        int l, isdn;
        if (r < CI_GU) { l = 0; isdn = 0; } else if (r < CI_GU + CI_DN) { r -= CI_GU; l = 0; isdn = 1; } else if (r < 2 * CI_GU + CI_DN) { r -= CI_GU + CI_DN; l = 1; isdn = 0; } else { r -= 2 * CI_GU + CI_DN + CI_PL; l = 1; isdn = 1; }
        if (!isdn) { const int nb = r % (2 * DFF / 64), kb = r / (2 * DFF / 64);
            tr_item(F.in[I_WGU] + (size_t)l * DM * 2 * DFF, DM, 2 * DFF, (bf16*)(F.ws + (l ? WS_WGU1 : WS_WGU0)), kb * 64, nb * 64, drow_pair(nb * 64, DFF), F.lane, F.in[I_NFFN] + l * DM); continue; }
        { const int nb = r % (DM / 64), kb = r / (DM / 64);
            tr_item(F.in[I_WDN] + (size_t)l * DFF * DM, DFF, DM, (bf16*)(F.ws + (l ? WS_WDN1 : WS_WDN0)), kb * 64, nb * 64, nb * 64, F.lane); }
    }
}
__device__ __forceinline__ void convert_reset(Frame& F) { __syncthreads(); if (F.tid == 0) *(LAS unsigned*)(F.lds + MISC_OFF + 80) = 0u; __syncthreads(); }
__device__ __forceinline__ void p0_prologue(Frame& F) {
    const int gw = F.vcu * NWAVES + F.wave, NGW = F.G * NWAVES;
    float* rstd0 = (float*)(F.ws + WS_RSTD);
    for (int r = gw; r < M; r += NGW) { const GAS f32x4* xr = (const GAS f32x4*)xrow_in(F, r) + F.lane; float s = 0.f;
#pragma unroll
        for (int j = 0; j < 16; ++j) { const f32x4 v = xr[64 * j]; s += (v.x * v.x + v.y * v.y) + (v.z * v.z + v.w * v.w); }
        s = wave_sum(s); if (F.lane == 0) rstd0[r] = 1.0f / sqrtf(s * (1.0f / DM) + RMS_EPS); }
    unsigned char* spb = F.ws + WS_SSMP;
    for (int idx = F.vcu * (NWAVES * 64) + F.tid; idx < NGRP * NST; idx += F.G * NWAVES * 64) {
        const int g = idx >> 6, p = idx & 63, ti = p >> 5, sl = p & 31;
        const double lr = (double)F.in[I_LRE][idx], li = (double)F.in[I_LIM][idx], dt = exp_d((double)F.in[I_LSTEP][g]);
        const double mag = exp_d(lr * dt); double sn, cs; sincos_d(li * dt, sn, cs);
        const double ar = mag * cs, ai = mag * sn, den = lr * lr + li * li;
        const double fr = ((ar - 1.0) * lr + ai * li) / den, fi = (ai * lr - (ar - 1.0) * li) / den;
        ((float*)(spb + SPB_AR))[idx] = (float)ar; ((float*)(spb + SPB_AI))[idx] = (float)ai;
#pragma unroll
        for (int hl = 0; hl < 2; ++hl) { float re[8], im[8];
#pragma unroll
            for (int c4 = 0; c4 < 2; ++c4) { const f32x4 br = *(const GAS f32x4*)(F.in[I_BRE] + (size_t)idx * 16 + 8 * hl + 4 * c4), bi = *(const GAS f32x4*)(F.in[I_BIM] + (size_t)idx * 16 + 8 * hl + 4 * c4);
                const f32x4 gn = *(const GAS f32x4*)(F.in[I_NMIX] + g * 16 + 8 * hl + 4 * c4);
#pragma unroll
                for (int j = 0; j < 4; ++j) { re[4 * c4 + j] = (float)((fr * (double)br[j] - fi * (double)bi[j]) * (double)gn[j]); im[4 * c4 + j] = (float)((fr * (double)bi[j] + fi * (double)br[j]) * (double)gn[j]); } }
            const int ln = 32 * hl + sl; v4u o;
            o.x = cvtpk(re[0], re[1]); o.y = cvtpk(re[2], re[3]); o.z = cvtpk(re[4], re[5]); o.w = cvtpk(re[6], re[7]);
            *(GAS v4u*)(spb + SPB_BF + ((size_t)(((g * 2 + ti) * 2 + 0) * 64 + ln)) * 16) = o;
            o.x = cvtpk(im[0], im[1]); o.y = cvtpk(im[2], im[3]); o.z = cvtpk(im[4], im[5]); o.w = cvtpk(im[6], im[7]);
            *(GAS v4u*)(spb + SPB_BF + ((size_t)(((g * 2 + ti) * 2 + 1) * 64 + ln)) * 16) = o; }
    }
    for (int idx = F.vcu * (NWAVES * 64) + F.tid; idx < NGRP * 4 * 64; idx += F.G * NWAVES * 64) {
        const int g = idx >> 8, ks = (idx >> 6) & 3, ln = idx & 63, q = ln >> 4, c = ln & 15, p0 = 16 * ks + 4 * q;
        const f32x4 cr = *(const GAS f32x4*)(F.in[I_CRE] + ((size_t)g * 16 + c) * NST + p0), ci = *(const GAS f32x4*)(F.in[I_CIM] + ((size_t)g * 16 + c) * NST + p0);
        v4u o; o.x = cvtpk(cr[0], -ci[0]); o.y = cvtpk(cr[1], -ci[1]); o.z = cvtpk(cr[2], -ci[2]); o.w = cvtpk(cr[3], -ci[3]);
        *(GAS v4u*)(spb + SPB_CF + (size_t)idx * 16) = o;
    }
}

__device__ __forceinline__ float gelu_tanh(float x) { const float z = 0.7978845608028654f * (x + 0.044715f * x * x * x); return x * __builtin_amdgcn_rcpf(1.0f + __expf(-2.0f * z)); }
template <bool SAMPLE>
__device__ __forceinline__ void ssm_run(Frame& F, int g, int sel) {
    const int lane = F.lane, hl = lane >> 5, sl = lane & 31, q = lane >> 4, cl = lane & 15;
    const unsigned char* spb = F.ws + WS_SSMP; const float* rstd0 = (const float*)(F.ws + WS_RSTD);
    bf16x8 bfr[2][2], cfr[4];
#pragma unroll
    for (int ti = 0; ti < 2; ++ti)
#pragma unroll
        for (int part = 0; part < 2; ++part) bfr[ti][part] = *(const GAS bf16x8*)(spb + SPB_BF + ((size_t)(((g * 2 + ti) * 2 + part) * 64 + lane)) * 16);
#pragma unroll
    for (int ks = 0; ks < 4; ++ks) cfr[ks] = *(const GAS bf16x8*)(spb + SPB_CF + ((size_t)((g * 4 + ks) * 64 + lane)) * 16);
    float ar[2], ai[2];
#pragma unroll
    for (int ti = 0; ti < 2; ++ti) { ar[ti] = ((const float*)(spb + SPB_AR))[g * NST + 32 * ti + sl]; ai[ti] = ((const float*)(spb + SPB_AI))[g * NST + 32 * ti + sl]; }
    const f32x4 dg = *(const GAS f32x4*)(F.in[I_SD] + g * 16 + 4 * q) * *(const GAS f32x4*)(F.in[I_NMIX] + g * 16 + 4 * q);
    const int hA = (sl >> 2) & 1, rA = (sl & 3) + 4 * (sl >> 3);
    const int hE = (cl >> 2) & 1, rE = (cl & 3) + 4 * (cl >> 3);
    LAS unsigned char* xl = F.lds + RING_OFF + F.wave * 8704;
    LAS unsigned* xw = (LAS unsigned*)(xl + hl * (4 * 272) + sl * 4);
    const LAS unsigned char* xrd = xl + cl * 272 + q * 16;
    int rowA, rowE[2], nch; float xr[2], xi[2], xr2[2], xi2[2]; float *o1r, *o1i, *o2r = nullptr, *o2i = nullptr;
    if constexpr (SAMPLE) { const int b0 = 4 * sel; nch = 1;
        rowA = MP + (b0 + 2 * hA + (rA >> 3)) * DS + (rA & 7); rowE[0] = MP + (b0 + 2 * hE) * DS + rE; rowE[1] = MP + (b0 + 2 * hE + 1) * DS + rE;
        const size_t s1 = ((size_t)(b0 + 2 * hl) * NGRP + g) * NST + sl, s2 = s1 + (size_t)NGRP * NST;
#pragma unroll
        for (int ti = 0; ti < 2; ++ti) { xr[ti] = F.in[I_SRE][s1 + 32 * ti]; xi[ti] = F.in[I_SIM][s1 + 32 * ti]; xr2[ti] = F.in[I_SRE][s2 + 32 * ti]; xi2[ti] = F.in[I_SIM][s2 + 32 * ti]; }
        o1r = F.out + O_SRS + s1; o1i = F.out + O_SIS + s1; o2r = F.out + O_SRS + s2; o2i = F.out + O_SIS + s2;
    } else { const int seq0 = 2 * sel; nch = SEQ / 16;
        rowA = (seq0 + hA) * SEQ + rA; rowE[0] = (seq0 + hE) * SEQ + rE; rowE[1] = rowE[0] + 8;
#pragma unroll
        for (int ti = 0; ti < 2; ++ti) { xr[ti] = 0.f; xi[ti] = 0.f; xr2[ti] = 0.f; xi2[ti] = 0.f; }
        const size_t s1 = ((size_t)(seq0 + hl) * NGRP + g) * NST + sl; o1r = F.out + O_SRP + s1; o1i = F.out + O_SIP + s1;
    }
    f32x16 zero16;
#pragma unroll
    for (int i = 0; i < 16; ++i) zero16[i] = 0.f;
    f32x4 nx0, nx1, nxe[2]; float nrs, nre[2];
    { const float* xp = xrow_in(F, rowA) + g * 16 + 8 * hl; nx0 = *(const GAS f32x4*)xp; nx1 = *(const GAS f32x4*)(xp + 4); nrs = rstd0[rowA];
#pragma unroll
      for (int rt = 0; rt < 2; ++rt) { nxe[rt] = *(const GAS f32x4*)(xrow_in(F, rowE[rt]) + g * 16 + 4 * q); nre[rt] = rstd0[rowE[rt]]; } }
    for (int ch = 0; ch < nch; ++ch) {
        const f32x4 x0 = nx0, x1 = nx1; const float rs = nrs;
        f32x4 xe[2]; float re[2];
#pragma unroll
        for (int rt = 0; rt < 2; ++rt) { xe[rt] = nxe[rt]; re[rt] = nre[rt]; }
        if (ch + 1 < nch) { const int ra = rowA + 16 * (ch + 1); const float* xp = xrow_in(F, ra) + g * 16 + 8 * hl; nx0 = *(const GAS f32x4*)xp; nx1 = *(const GAS f32x4*)(xp + 4); nrs = rstd0[ra];
#pragma unroll
            for (int rt = 0; rt < 2; ++rt) { const int r = rowE[rt] + 16 * (ch + 1); nxe[rt] = *(const GAS f32x4*)(xrow_in(F, r) + g * 16 + 4 * q); nre[rt] = rstd0[r]; } }
        v4u au; au.x = cvtpk(x0[0] * rs, x0[1] * rs); au.y = cvtpk(x0[2] * rs, x0[3] * rs); au.z = cvtpk(x1[0] * rs, x1[1] * rs); au.w = cvtpk(x1[2] * rs, x1[3] * rs);
        const bf16x8 afr = __builtin_bit_cast(bf16x8, au);
#pragma unroll
        for (int ti = 0; ti < 2; ++ti) {
            f32x16 dr = __builtin_amdgcn_mfma_f32_32x32x16_bf16(afr, bfr[ti][0], zero16, 0, 0, 0);
            f32x16 di = __builtin_amdgcn_mfma_f32_32x32x16_bf16(afr, bfr[ti][1], zero16, 0, 0, 0);
            float sr = xr[ti], si = xi[ti];
#pragma unroll
            for (int r = 0; r < 16; ++r) {
                if (SAMPLE && r == 8) { o1r[32 * ti] = sr; o1i[32 * ti] = si; sr = xr2[ti]; si = xi2[ti]; }
                const float nr = fmaf(-ai[ti], si, fmaf(ar[ti], sr, dr[r])), ni = fmaf(ai[ti], sr, fmaf(ar[ti], si, di[r])); sr = nr; si = ni;
                xw[(((r & 3) + 8 * (r >> 2)) * 272 + ti * 128) / 4] = cvtpk(sr, si);
            }
            xr[ti] = sr; xi[ti] = si;
        }
        asm volatile("s_waitcnt lgkmcnt(0)" ::: "memory"); __builtin_amdgcn_sched_barrier(0);
        f32x4 y[2];
#pragma unroll
        for (int rt = 0; rt < 2; ++rt) { y[rt] = (f32x4){0.f, 0.f, 0.f, 0.f};
#pragma unroll
            for (int ks = 0; ks < 4; ++ks) { const bf16x8 xf = *(const LAS bf16x8*)(xrd + rt * (16 * 272) + ks * 64); y[rt] = __builtin_amdgcn_mfma_f32_16x16x32_bf16(cfr[ks], xf, y[rt], 0, 0, 0); } }
        asm volatile("s_waitcnt lgkmcnt(0)" ::: "memory"); __builtin_amdgcn_sched_barrier(0);
#pragma unroll
        for (int rt = 0; rt < 2; ++rt) { const int r = rowE[rt] + 16 * ch; f32x4 v;
#pragma unroll
            for (int j = 0; j < 4; ++j) v[j] = gelu_tanh(y[rt][j] + dg[j] * (xe[rt][j] * re[rt]));
            *(GAS unsigned long long*)((bf16*)(F.ws + WS_YSSM) + (size_t)r * DM + g * 16 + 4 * q) = (unsigned long long)cvtpk(v[0], v[1]) | ((unsigned long long)cvtpk(v[2], v[3]) << 32); }
    }
    if constexpr (SAMPLE) {
#pragma unroll
        for (int ti = 0; ti < 2; ++ti) { o2r[32 * ti] = xr[ti]; o2i[32 * ti] = xi[ti]; }
    } else {
#pragma unroll
        for (int ti = 0; ti < 2; ++ti) { o1r[32 * ti] = xr[ti]; o1i[32 * ti] = xi[ti]; }
    }
}
__device__ __forceinline__ void p1_ssm(Frame& F) {
    if (F.wave < 2) {
        for (int task = F.vcu * 2 + F.wave; task < 2 * NGRP; task += F.G * 2) ssm_run<false>(F, task & 255, task >> 8);
    } else {
        for (int task = F.vcu * 6 + (F.wave - 2); task < 32 * NGRP; task += F.G * 6) ssm_run<true>(F, task & 255, task >> 8);
    }
    convert_weights(F, 0, F.G == 256 ? CI_GLU + CI_GU : CI_L0, F.vcu, F.G);
}

__device__ __forceinline__ void final_norm(Frame& F, const float* gain, const float* ssq, float* dst) {
    (void)ssq;
    const float* X = (const float*)(F.ws + WS_XRES); const int gw = F.vcu * NWAVES + F.wave, NGW = F.G * NWAVES;
    f32x4 v[16], w[16];
    if (gw < M) { const GAS f32x4* xr = (const GAS f32x4*)(X + (size_t)gw * DM) + F.lane;
#pragma unroll
        for (int u = 0; u < 16; ++u) v[u] = __builtin_nontemporal_load(xr + 64 * u); }
    for (int r = gw; r < M; r += NGW) {
        const int rn = r + NGW;
        if (rn < M) { const GAS f32x4* xr = (const GAS f32x4*)(X + (size_t)rn * DM) + F.lane;
#pragma unroll
            for (int u = 0; u < 16; ++u) w[u] = __builtin_nontemporal_load(xr + 64 * u); }
        float s = 0.f;
#pragma unroll
        for (int u = 0; u < 16; ++u) s += (v[u].x * v[u].x + v[u].y * v[u].y) + (v[u].z * v[u].z + v[u].w * v[u].w);
        s = wave_sum(s);
        const float rs = __builtin_amdgcn_rsqf(s * (1.0f / DM) + RMS_EPS);
        GAS f32x4* dr = (GAS f32x4*)(dst + (size_t)r * DM) + F.lane; const GAS f32x4* gr = (const GAS f32x4*)gain + F.lane;
#pragma unroll
        for (int u = 0; u < 16; ++u) __builtin_nontemporal_store(v[u] * rs * gr[64 * u], dr + 64 * u);
#pragma unroll
        for (int u = 0; u < 16; ++u) v[u] = w[u];
    }
}
template <int GI, int R, bool PROMPT> __device__ __forceinline__ void pool_elem_g(Frame& F, int vb, int nb) {
    constexpr int W = 2 << GI, NH = R + W - 1, RBASE = PROMPT ? 0 : MP, NROWS = PROMPT ? MP : MS;
    const float* X = (const float*)(F.ws + WS_XRES); const float* ssq1 = (const float*)(F.ctl + CW_SSQ) + M; const float* gain = F.in[I_NMIX] + DM;
    bf16* PP = (bf16*)(F.ws + WS_PPOOL);
    const size_t NT = (size_t)nb * NWAVES * 64;
    static_assert(PROMPT || R == DS, "a sample sequence is exactly one strip");
    for (size_t idx = (size_t)vb * NWAVES * 64 + F.tid; idx < (size_t)(NROWS / R) * 256; idx += NT) {
        const int r0 = RBASE + (int)(idx >> 8) * R, q = (int)(idx & 255), c = GI * 1024 + 4 * q;
        const f32x4 gv = *(const GAS f32x4*)(gain + c);
        constexpr bool prompt = PROMPT; const int t0 = prompt ? (r0 & (SEQ - 1)) : 0; const int b = (r0 - MP) >> 3;
        f32x4 hv[NH]; float sq[NH];
#pragma unroll
        for (int k = 0; k < NH; ++k) { const int d = k - (W - 1), tt = t0 + d; const bool inseq = tt >= 0;
            const float* src = inseq ? X + (size_t)(r0 + d) * DM + c : (prompt ? X + (size_t)r0 * DM + c : F.in[I_SPOOL] + ((size_t)b * PBUF + (PBUF + tt)) * DM + c);
            hv[k] = *(const GAS f32x4*)src; sq[k] = ssq1[inseq ? r0 + d : r0]; }
#pragma unroll
        for (int k = 0; k < NH; ++k) { const bool inseq = (t0 + k - (W - 1)) >= 0; const float rs = __builtin_amdgcn_rsqf(sq[k] * (1.0f / DM) + RMS_EPS);
            hv[k] = hv[k] * (inseq ? gv * rs : (prompt ? (f32x4){0.f, 0.f, 0.f, 0.f} : (f32x4){1.f, 1.f, 1.f, 1.f})); }
#pragma unroll
        for (int i = 0; i < R; ++i) { const int r = r0 + i, t = t0 + i; const f32x4 h = hv[i + W - 1]; f32x4 s = h;
#pragma unroll
            for (int j = 1; j < W; ++j) s += hv[i + W - 1 - j];
            const float cnt = prompt ? (float)((t + 1) < W ? (t + 1) : W) : (float)W;
            const f32x4 p = s / cnt - h;
            *(GAS unsigned long long*)(PP + ((size_t)GI * M + r) * 1024 + 4 * q) = (unsigned long long)cvtpk(p.x, p.y) | ((unsigned long long)cvtpk(p.z, p.w) << 32);
            if (prompt) { if (t >= SEQ - PBUF) *(GAS f32x4*)(F.out + O_PP + ((size_t)(r >> 11) * PBUF + (t - (SEQ - PBUF))) * DM + c) = h; }
            else { float* ob = F.out + O_PS + (size_t)b * PBUF * DM + c;
                *(GAS f32x4*)(ob + (size_t)(PBUF - DS + t) * DM) = h;
                if (t < PBUF - DS) *(GAS f32x4*)(ob + (size_t)t * DM) = *(const GAS f32x4*)(F.in[I_SPOOL] + ((size_t)b * PBUF + DS + t) * DM + c); } }
    }
}
__device__ __forceinline__ void pool_elem(Frame& F) {
    pool_elem_g<3, 8, true>(F, F.vcu, F.G); pool_elem_g<2, 16, true>(F, F.vcu, F.G); pool_elem_g<1, 16, true>(F, F.vcu, F.G); pool_elem_g<0, 16, true>(F, F.vcu, F.G);
    if (F.G % 4 == 0) { const int nb = F.G / 4, vb = F.vcu % nb;
        switch (F.vcu / nb) { case 0: pool_elem_g<0, 8, false>(F, vb, nb); break; case 1: pool_elem_g<1, 8, false>(F, vb, nb); break; case 2: pool_elem_g<2, 8, false>(F, vb, nb); break; default: pool_elem_g<3, 8, false>(F, vb, nb); break; } }
    else { pool_elem_g<0, 8, false>(F, F.vcu, F.G); pool_elem_g<1, 8, false>(F, F.vcu, F.G); pool_elem_g<2, 8, false>(F, F.vcu, F.G); pool_elem_g<3, 8, false>(F, F.vcu, F.G); }
}

__device__ __forceinline__ void down_phase(Frame& F, const unsigned char* wdn, float* ssq_l, int layer) {
    unsigned char* ws = F.ws;
    if (F.G == 256) {
        { pg8::Gemm g{(const pg8::bf16_t*)(ws + WS_HID), (const pg8::bf16_t*)wdn, MP, DM, DFF, 0}; pg8::MallOrder S; S.init(MP, DM, F.G, (int)blockIdx.x, 256, 2);
          pg8::EpiResid<false> E{(float*)(ws + WS_XRES), nullptr, nullptr, ssq_l, 36};
          pg8::gemm_phase<pg8::EpiResid<false>, pg8::MallOrder, PG8_ALIGN, PG8_SP2>(F.lds + RING_OFF, g, S, E); }
        const int c = (int)blockIdx.x, part = c >> 6, unit = (c & 7) * 8 + ((c >> 3) & 7);
        const int kt0 = part == 0 ? 0 : part == 1 ? 36 : part == 2 ? 82 : 128, ntp = part == 0 ? 36 : part == 3 ? 44 : 46;
        pg8::Gemm g{(const pg8::bf16_t*)(ws + WS_HID) + kt0 * 64, (const pg8::bf16_t*)wdn + kt0 * 64, M, DM, DFF, ntp};
        unsigned* ctr = (unsigned*)(F.ctl + CW_SPLIT) + (layer * 64 + unit) * 16;
        pg8::EpiResidSplit E{(float*)(ws + WS_XRES), ssq_l, (float*)(ws + WS_YSSM) + (size_t)unit * 3 * 65536, ctr, part};
        pg8::SplitOrder S{c, 32};
        pg8::gemm_phase<pg8::EpiResidSplit, pg8::SplitOrder, PG8_ALIGN, PG8_SP2>(F.lds + RING_OFF, g, S, E);
        if (part != 0) { __syncthreads();
            if (F.tid == 0) { __builtin_amdgcn_fence(__ATOMIC_RELEASE, "agent"); asm volatile("s_waitcnt vmcnt(0)" ::: "memory"); (void)__hip_atomic_fetch_add(ctr, 1u, __ATOMIC_RELAXED, __HIP_MEMORY_SCOPE_AGENT); } }
    } else {
        pg8::Gemm g{(const pg8::bf16_t*)(ws + WS_HID), (const pg8::bf16_t*)wdn, M, DM, DFF, 0}; pg8::MallOrder S; S.init(M, DM, F.G, (int)blockIdx.x, 192, 2);
        pg8::EpiResid<false> E{(float*)(ws + WS_XRES), nullptr, nullptr, ssq_l, 36};
        pg8::gemm_phase<pg8::EpiResid<false>, pg8::MallOrder, PG8_ALIGN, PG8_SP2, 3>(F.lds + RING_OFF, g, S, E);
    }
}

struct Args { const float* in[21]; float* out; unsigned char* ws; int ph_lo, ph_hi; };
__global__ void __launch_bounds__(NWAVES * 64, 2) skel_fwd(Args args) {
    extern __shared__ __attribute__((aligned(16))) unsigned char lds[];
    Frame F;
    F.lds = (LAS unsigned char*)lds;
    F.MISC = (volatile LAS unsigned*)(F.lds + MISC_OFF);
    F.tid = threadIdx.x; F.lane = F.tid & 63; F.wave = __builtin_amdgcn_readfirstlane(F.tid >> 6);
    F.G = gridDim.x; { const int bx = blockIdx.x; F.vcu = (F.G % 8 == 0) ? (bx % 8) * (F.G / 8) + bx / 8 : bx; }
    unsigned char* ws = args.ws; F.ws = ws; F.out = args.out;
    F.ctl = (gu32*)(ws + WS_CTL);
#pragma unroll
    for (int i = 0; i < 21; ++i) F.in[i] = args.in[i];
    for (int u = F.tid; u < (LDS_BYTES - LDSCTL_OFF) / 4; u += NWAVES * 64) ((LAS unsigned*)(F.lds + LDSCTL_OFF))[u] = 0u;
    __syncthreads();
    const int lo = args.ph_lo, hi = args.ph_hi;
    const bool use_bar = (hi - lo) > 1;
    XcdBarrier bar; bar.bar = (unsigned*)(F.ctl + CW_BAR); bar.x = 0; bar.st = nullptr;
    if (use_bar) bar = xcd_barrier_post((unsigned*)(F.ctl + CW_BAR), F.MISC + 8);
#define IN(k) (lo <= (k) && (k) < hi)
#define SEAM(k) do { if (IN(k) && IN((k) + 1)) xcd_barrier(bar); } while (0)

    float* ssq = (float*)(F.ctl + CW_SSQ);
    if (IN(0)) { p0_prologue(F); SEAM(0); }
    if (IN(1)) { p1_ssm(F); SEAM(1); }
    if (IN(2)) {
        pg8::Gemm g{(const pg8::bf16_t*)(ws + WS_YSSM), (const pg8::bf16_t*)(ws + WS_WGLU), M, 2 * DM, DM}; pg8::MallOrder S; S.init(M, 2 * DM, F.G, (int)blockIdx.x, 256, 1);
        pg8::EpiGlu E{F.in[I_XP], F.in[I_XS], (float*)(ws + WS_XRES), (pg8::bf16_t*)(ws + WS_HA), ssq};
        pg8::gemm_phase<pg8::EpiGlu, pg8::MallOrder, PG8_ALIGN, PG8_SP2>(F.lds + RING_OFF, g, S, E);
        { constexpr int NIDLE = 256 - (36 * 32) % 256, QUOTA = 60; const int j = (int)blockIdx.x - (256 - NIDLE);
          if (F.G == 256 && j >= 0) { convert_reset(F); convert_weights(F, CI_GLU + CI_GU, CI_L0, j, NIDLE); } }
        SEAM(2);
    }
    if (IN(3)) {
        pg8::Gemm g{(const pg8::bf16_t*)(ws + WS_HA), (const pg8::bf16_t*)(ws + WS_WGU0), M, 2 * DFF, DM}; pg8::MallOrder S; S.init(M, 2 * DFF, F.G, (int)blockIdx.x, 256, 1);
        pg8::EpiSwiglu E{(pg8::bf16_t*)(ws + WS_HID), DFF, ssq};
        pg8::gemm_phase<pg8::EpiSwiglu, pg8::MallOrder, PG8_ALIGN, PG8_SP2>(F.lds + RING_OFF, g, S, E);
        { constexpr int NIDLE = 256 - (36 * 86) % 256, LO = CI_L0 + 128 * 60, HI = CI_ALL - CI_DN; const int j = (int)blockIdx.x - (256 - NIDLE);
          if (F.G == 256) { if (j >= 0) { convert_reset(F); convert_weights(F, CI_L0, HI, j, NIDLE); } }
          else { convert_reset(F); convert_weights(F, CI_L0, HI, F.vcu, F.G); } }
        SEAM(3);
    }
    if (IN(4)) { down_phase(F, ws + WS_WDN0, ssq + M, 0); SEAM(4); }
    if (IN(5)) { pool_elem(F); SEAM(5); }
    if (IN(6)) {
        pg8::Gemm g{(const pg8::bf16_t*)(ws + WS_PPOOL), (const pg8::bf16_t*)(ws + WS_WPOOL), 4 * M, 4096, 1024}; pg8::PoolOrder S{F.G, (int)blockIdx.x, 48};
        pg8::EpiResid<true> E{(float*)(ws + WS_XRES), F.in[I_PSCALE], (pg8::bf16_t*)(ws + WS_HA), ssq + 2 * M, 48};
        pg8::gemm_phase<pg8::EpiResid<true>, pg8::PoolOrder, PG8_ALIGN, PG8_SP2, 3>(F.lds + RING_OFF, g, S, E);
        SEAM(6);
    }
    if (IN(7)) {
        pg8::Gemm g{(const pg8::bf16_t*)(ws + WS_HA), (const pg8::bf16_t*)(ws + WS_WGU1), M, 2 * DFF, DM};
        pg8::EpiSwiglu E{(pg8::bf16_t*)(ws + WS_HID), DFF, ssq + 2 * M};
        constexpr int NU = 36 * 86, NT = NU % 256;
        if (F.G == 256) {
            pg8::MallOrder S; S.init(M, 2 * DFF, F.G, (int)blockIdx.x, 256, 1, NU / 256);
            pg8::gemm_phase<pg8::EpiSwiglu, pg8::MallOrder, PG8_ALIGN, PG8_SP2>(F.lds + RING_OFF, g, S, E);
            pg8::TailOrder T{S, NT, NU / 256};
            pg8::gemm_phase<pg8::EpiSwiglu, pg8::TailOrder, PG8_ALIGN, PG8_SP2, 2>(F.lds + RING_OFF, g, T, E);
            const int j = (int)blockIdx.x - 2 * NT;
            if (j >= 0) { convert_reset(F); convert_weights(F, CI_ALL - CI_DN, CI_ALL, j, 256 - 2 * NT); }
        } else {
            pg8::MallOrder S; S.init(M, 2 * DFF, F.G, (int)blockIdx.x, 256, 1);
            pg8::gemm_phase<pg8::EpiSwiglu, pg8::MallOrder, PG8_ALIGN, PG8_SP2>(F.lds + RING_OFF, g, S, E);
            convert_reset(F); convert_weights(F, CI_ALL - CI_DN, CI_ALL, F.vcu, F.G);
        }
        SEAM(7);
    }
    if (IN(8)) { down_phase(F, ws + WS_WDN1, ssq + 3 * M, 1); SEAM(8); }
    if (IN(9)) { final_norm(F, F.in[I_NFIN], ssq + 3 * M, F.out + O_YP); }
#undef IN
#undef SEAM
}

extern "C" void kernel_launch(void* const* d_in, const int* in_sizes, int n_in, void* d_out, int out_size, void* d_ws, size_t ws_size, hipStream_t stream) {
    static int grid = 0;
    if (grid == 0) {
        if (n_in != 21 || in_sizes[0] != MP * DM || (size_t)out_size != O_END || ws_size < WS_END) { fprintf(stderr, "kernel_launch: unexpected shapes (n_in %d, in0 %d, out %d, ws %zu); nothing launched\n", n_in, n_in > 0 ? in_sizes[0] : -1, out_size, ws_size); grid = -1; return; }
        int dev = 0, cus = 0, per_cu = 0;
        if (hipGetDevice(&dev) != hipSuccess || hipDeviceGetAttribute(&cus, hipDeviceAttributeMultiprocessorCount, dev) != hipSuccess) { grid = -1; return; }
        if (hipFuncSetAttribute((const void*)skel_fwd, hipFuncAttributeMaxDynamicSharedMemorySize, LDS_BYTES) != hipSuccess) { fprintf(stderr, "kernel_launch: hipFuncSetAttribute failed\n"); grid = -1; return; }
        if (hipOccupancyMaxActiveBlocksPerMultiprocessor(&per_cu, (const void*)skel_fwd, NWAVES * 64, LDS_BYTES) != hipSuccess || per_cu < 1) { fprintf(stderr, "kernel_launch: occupancy query says %d blocks per CU\n", per_cu); }
        (void)hipGetLastError();
        grid = cus;
    }
    if (grid < 0) return;
    if (hipMemsetAsync((char*)d_ws + WS_CTL, 0, CTL_ZERO_BYTES, stream) != hipSuccess) return;
    Args a{};
    for (int i = 0; i < 21; ++i) a.in[i] = (const float*)d_in[i];
    a.out = (float*)d_out; a.ws = (unsigned char*)d_ws;
#if MK_ONE_LAUNCH
    a.ph_lo = 0; a.ph_hi = N_PHASES;
    hipLaunchKernelGGL(skel_fwd, dim3(grid), dim3(NWAVES * 64), LDS_BYTES, stream, a);
#else
    for (int ph = 0; ph < N_PHASES; ++ph) { a.ph_lo = ph; a.ph_hi = ph + 1; hipLaunchKernelGGL(skel_fwd, dim3(grid), dim3(NWAVES * 64), LDS_BYTES, stream, a); }
#endif
}
```

```cpp
#include <hip/hip_runtime.h>
#include <cstdio>
#include <cstdint>
namespace pg8 {
#define PG8_LAS __attribute__((address_space(3)))
typedef unsigned short bf16_t;
typedef short bf16x8 __attribute__((ext_vector_type(8)));
typedef float f32x4 __attribute__((ext_vector_type(4)));
typedef unsigned u32x4 __attribute__((ext_vector_type(4)));
constexpr int BM = 256, BK = 64, HALF = 128, HTB = HALF * BK * 2  , STAGE_BYTES = 8 * HTB, NXCD = 8, WGM = 8;

__host__ __device__ __forceinline__ int lds_byte(int r, int c) { const int st = (r >> 4) * 2 + (c >> 5), rr = r & 15, cc = c & 31, ob = rr * 64 + cc * 2; return st * 1024 + (ob ^ (((ob >> 9) & 1) << 5)); }
__host__ __device__ __forceinline__ void stage_rc(int b, int& R, int& C) { const int st = b / 1024, sb = b % 1024, swz = sb ^ (((sb >> 9) & 1) << 5); R = (st >> 1) * 16 + swz / 64; C = (st & 1) * 32 + (swz % 64) / 2; }
__host__ __device__ __forceinline__ int perm32(int rho) { const int n = rho >> 4, i = rho & 15; return 8 * (i >> 2) + 4 * n + (i & 3); }

struct Unit { int pm, pn; };
struct Gemm { const bf16_t* A; const bf16_t* Bt; int M, N, K; int nt; };

struct StaticOrder {
    int nM, nN, nwg, G, c;
    __host__ __device__ void init(int M, int N, int G_, int c_, int bm = BM) { nM = M / bm; nN = N / BM; nwg = nM * nN; G = G_; c = c_; }
    __host__ __device__ bool next(int i, Unit& u) const {
        const long L = (long)i * G + c; if (L >= nwg) return false;
        int wgid = (int)L; { const int q = nwg / NXCD, r = nwg % NXCD, xcd = wgid % NXCD, off = wgid / NXCD; wgid = (xcd < r ? xcd * (q + 1) : r * (q + 1) + (xcd - r) * q) + off; }
        const int nig = WGM * nN, gid = wgid / nig, fm = gid * WGM, gsz = (nM - fm) < WGM ? (nM - fm) : WGM;
        u.pm = fm + ((wgid % nig) % gsz); u.pn = (wgid % nig) / gsz; return true;
    }
    __device__ __forceinline__ void a_ready(const Unit&) const {}
    __device__ __forceinline__ void done(const Unit&) const {}
};

struct MallOrder {
    int nM, nN, G, c, XR, maxr;
    __host__ __device__ void init(int M, int N, int G_, int c_, int bm, int XR_, int maxr_ = 1 << 20) { nM = M / bm; nN = N / BM; G = G_; c = c_; XR = XR_; maxr = maxr_; }
    __host__ __device__ bool next(int i, Unit& u) const {
        constexpr int CW = 32; if (i >= maxr) return false;
        const int XC = NXCD / XR, x = c % NXCD, xr = x / XC, xc = x % XC;
        int q = i * (G / NXCD) + c / NXCD;
        for (int ch = 0; ch * CW < nN; ++ch) {
            const int cw = (nN - ch * CW) < CW ? (nN - ch * CW) : CW;
            for (int g = 0; g * XR * 8 < nM; ++g) {
                const int fm = (g * XR + xr) * 8, left = nM - fm, gsz = left < 0 ? 0 : (left < 8 ? left : 8), perg = gsz * cw / XC;
                if (q < perg) { const int uu = xc * perg + q; u.pm = fm + uu % gsz; u.pn = ch * CW + uu / gsz; return true; }
                q -= perg;
            }
        }
        return false;
    }
    __device__ __forceinline__ void a_ready(const Unit&) const {}
    __device__ __forceinline__ void done(const Unit&) const {}
};

struct TailOrder {
    MallOrder base; int nt, round;
    __host__ __device__ bool next(int i, Unit& u) const {
        if (i != 0 || base.c >= 2 * nt) return false;
        MallOrder b = base; b.c = base.c % nt; b.maxr = 1 << 20; Unit v; if (!b.next(round, v)) return false;
        u.pm = 2 * v.pm + base.c / nt; u.pn = v.pn; return true;
    }
    __device__ __forceinline__ void a_ready(const Unit&) const {}
    __device__ __forceinline__ void done(const Unit&) const {}
};


__device__ __forceinline__ unsigned cvt_pk_bf16(float lo, float hi) { unsigned r; asm volatile("v_cvt_pk_bf16_f32 %0, %1, %2" : "=v"(r) : "v"(lo), "v"(hi)); return r; }
__device__ __forceinline__ float sigmoid_f(float x) { return __builtin_amdgcn_rcpf(1.0f + __expf(-x)); }

__device__ __forceinline__ void ssq_add(float* ssq, int row, float s, int fq) {
    s += __shfl_xor(s, 16); s += __shfl_xor(s, 32);
    if (fq == 0) unsafeAtomicAdd(ssq + row, s);
}
__device__ __forceinline__ float rstd_of(const float* ssq, int row) { return __builtin_amdgcn_rsqf(ssq[row] * (1.0f / 4096.0f) + 1e-6f); }
struct EpiGlu {
    static constexpr bool PERM = false, AFTER_DRAIN = false;
    const float* xin_p; const float* xin_s; float* xout; bf16_t* xb; float* ssq;
    template <int MQ> __device__ __forceinline__ void operator()(const f32x4 (&acc)[2][2][MQ][2], const Unit& u, int wr, int wc, int fr, int fq) const {
        constexpr int MHALF = 32 * MQ; const int row0 = u.pm * (2 * MHALF) + wr * (16 * MQ) + fr, col0 = u.pn * HALF + wc * 32 + 4 * fq;
        const float* xi = (row0 < 8192) ? xin_p + (size_t)row0 * 4096 : xin_s + (size_t)(row0 - 8192) * 4096;
        float* ob = xout + (size_t)row0 * 4096; bf16_t* bb = xb + (size_t)row0 * 4096;
#pragma unroll
        for (int ai = 0; ai < 2; ++ai)
#pragma unroll
            for (int m = 0; m < MQ; ++m) { const size_t off = (size_t)(ai * MHALF + m * 16) * 4096 + col0; float sq = 0.f;
#pragma unroll
                for (int n = 0; n < 2; ++n) { const f32x4 xv = *(const f32x4*)(xi + off + 16 * n); const f32x4 a = acc[ai][0][m][n], b = acc[ai][1][m][n]; f32x4 o;
#pragma unroll
                    for (int j = 0; j < 4; ++j) { o[j] = xv[j] + a[j] * sigmoid_f(b[j]); sq = fmaf(o[j], o[j], sq); }
                    *(f32x4*)(ob + off + 16 * n) = o;
                    *(unsigned long long*)(bb + off + 16 * n) = (unsigned long long)cvt_pk_bf16(o[0], o[1]) | ((unsigned long long)cvt_pk_bf16(o[2], o[3]) << 32); }
                ssq_add(ssq, row0 + ai * MHALF + m * 16, sq, fq); }
    }
};
struct EpiSwiglu {
    static constexpr bool PERM = true, AFTER_DRAIN = false;
    bf16_t* O; int ldc; const float* ssq;
    template <int MQ> __device__ __forceinline__ void operator()(const f32x4 (&acc)[2][2][MQ][2], const Unit& u, int wr, int wc, int fr, int fq) const {
        constexpr int MHALF = 32 * MQ; const int row0 = u.pm * (2 * MHALF) + wr * (16 * MQ) + fr, col0 = u.pn * HALF + wc * 32 + 8 * fq;
#pragma unroll
        for (int ai = 0; ai < 2; ++ai)
#pragma unroll
            for (int m = 0; m < MQ; ++m) { const int r = row0 + ai * MHALF + m * 16; bf16_t* rowp = O + (size_t)r * ldc + col0; const float rs = rstd_of(ssq, r);
                const float c2 = rs * -1.4426950408889634f, rs2 = rs * rs;
                f32x4 h[2];
#pragma unroll
                for (int n = 0; n < 2; ++n) { const f32x4 g = acc[ai][0][m][n], v = acc[ai][1][m][n];
#pragma unroll
                    for (int j = 0; j < 4; ++j) h[n][j] = (g[j] * v[j]) * (rs2 * __builtin_amdgcn_rcpf(1.0f + __builtin_amdgcn_exp2f(g[j] * c2))); }
                u32x4 w; w.x = cvt_pk_bf16(h[0][0], h[0][1]); w.y = cvt_pk_bf16(h[0][2], h[0][3]); w.z = cvt_pk_bf16(h[1][0], h[1][1]); w.w = cvt_pk_bf16(h[1][2], h[1][3]);
                *(u32x4*)rowp = w; }
    }
};
template <bool POOL> struct EpiResid {
    static constexpr bool PERM = false, AFTER_DRAIN = false;
    float* x; const float* scale; bf16_t* xb; float* ssq; int npm;
    template <int MQ> __device__ __forceinline__ void operator()(const f32x4 (&acc)[2][2][MQ][2], const Unit& u, int wr, int wc, int fr, int fq) const {
        constexpr int MHALF = 32 * MQ; const int pm = POOL ? (u.pm % npm) : u.pm;
        const int row0 = pm * (2 * MHALF) + wr * (16 * MQ) + fr, col0 = u.pn * BM + wc * 32 + 4 * fq;
        f32x4 sv[2][2];
#pragma unroll
        for (int bj = 0; bj < 2; ++bj)
#pragma unroll
            for (int n = 0; n < 2; ++n) sv[bj][n] = POOL ? *(const f32x4*)(scale + col0 + bj * HALF + n * 16) : (f32x4){1.f, 1.f, 1.f, 1.f};
#pragma unroll
        for (int ai = 0; ai < 2; ++ai)
#pragma unroll
            for (int m = 0; m < MQ; ++m) { const int r = row0 + ai * MHALF + m * 16; float* rowp = x + (size_t)r * 4096 + col0; float sq = 0.f;
#pragma unroll
                for (int bj = 0; bj < 2; ++bj)
#pragma unroll
                    for (int n = 0; n < 2; ++n) { const f32x4 xv = *(const f32x4*)(rowp + bj * HALF + n * 16);
                        const f32x4 o = POOL ? xv + acc[ai][bj][m][n] * sv[bj][n] : xv + acc[ai][bj][m][n];
                        sq += (o[0] * o[0] + o[1] * o[1]) + (o[2] * o[2] + o[3] * o[3]);
                        *(f32x4*)(rowp + bj * HALF + n * 16) = o;
                        if (POOL) *(unsigned long long*)(xb + (size_t)r * 4096 + col0 + bj * HALF + n * 16) = (unsigned long long)cvt_pk_bf16(o[0], o[1]) | ((unsigned long long)cvt_pk_bf16(o[2], o[3]) << 32); }
                if (ssq) ssq_add(ssq, r, sq, fq); }
    }
};
struct EpiResidSplit {
    static constexpr bool PERM = false, AFTER_DRAIN = false;
    float* x; float* ssq; float* slab; unsigned* ctr; int part;
    template <int MQ> __device__ __forceinline__ void operator()(const f32x4 (&acc)[2][2][MQ][2], const Unit& u, int wr, int wc, int fr, int fq) const {
        static_assert(MQ == 4, "split tail: 256-row tiles");
        const int tid = threadIdx.x;
        if (part != 0) {
            f32x4* sp = (f32x4*)slab + (size_t)(part - 1) * 16384 + tid;
#pragma unroll
            for (int ai = 0; ai < 2; ++ai)
#pragma unroll
                for (int bj = 0; bj < 2; ++bj)
#pragma unroll
                    for (int m = 0; m < 4; ++m)
#pragma unroll
                        for (int n = 0; n < 2; ++n) sp[(((ai * 2 + bj) * 4 + m) * 2 + n) * 512] = acc[ai][bj][m][n];
            return;
        }
        { unsigned sp = 0; while (__hip_atomic_load(ctr, __ATOMIC_RELAXED, __HIP_MEMORY_SCOPE_AGENT) < 3u && ++sp < (1u << 22)) __builtin_amdgcn_s_sleep(2); }
        __builtin_amdgcn_fence(__ATOMIC_ACQUIRE, "agent");
        const f32x4* sp = (const f32x4*)slab + tid;
        const int row0 = u.pm * 256 + wr * 64 + fr, col0 = u.pn * BM + wc * 32 + 4 * fq;
#pragma unroll
        for (int ai = 0; ai < 2; ++ai)
#pragma unroll
            for (int m = 0; m < 4; ++m) { const int r = row0 + ai * 128 + m * 16; float* rowp = x + (size_t)r * 4096 + col0; float sq = 0.f;
#pragma unroll
                for (int bj = 0; bj < 2; ++bj)
#pragma unroll
                    for (int n = 0; n < 2; ++n) { const int idx = (((ai * 2 + bj) * 4 + m) * 2 + n) * 512;
                        const f32x4 xv = *(const f32x4*)(rowp + bj * HALF + n * 16);
                        const f32x4 o = (xv + acc[ai][bj][m][n]) + ((sp[idx] + sp[16384 + idx]) + sp[32768 + idx]);
                        sq += (o[0] * o[0] + o[1] * o[1]) + (o[2] * o[2] + o[3] * o[3]);
                        *(f32x4*)(rowp + bj * HALF + n * 16) = o; }
                if (ssq) ssq_add(ssq, r, sq, fq); }
    }
};
struct SplitOrder {
    int c, pm0;
    __device__ bool next(int i, Unit& u) const { if (i != 0) return false; const int slot = (c >> 3) & 7; u.pm = pm0 + (slot & 3); u.pn = 2 * (c & 7) + (slot >> 2); return true; }
    __device__ __forceinline__ void a_ready(const Unit&) const {}
    __device__ __forceinline__ void done(const Unit&) const {}
};
struct PoolOrder {
    int G, c, npm;
    __device__ bool next(int i, Unit& u) const {
        const int per = npm * 4, L = i * G + c; if (L >= 4 * per) return false;
        const int grp = L / per, rem = L % per; u.pm = grp * npm + rem % npm; u.pn = grp * 4 + rem / npm; return true;
    }
    __device__ __forceinline__ void a_ready(const Unit&) const {}
    __device__ __forceinline__ void done(const Unit&) const {}
};

template <class Epi, class Sched, bool ALIGN_EPI = false, bool SP2 = false, int MQ = 4>
__device__ __forceinline__ void gemm_phase(PG8_LAS unsigned char* lds, const Gemm g, const Sched& S, const Epi& E) {
    const int tid = threadIdx.x, wid = __builtin_amdgcn_readfirstlane(tid >> 6), lane = tid & 63, wr = wid >> 2, wc = wid & 3, fr = lane & 15, fq = lane >> 4;
    static_assert(MQ == 4 || ((MQ == 3 || MQ == 2) && SP2), "192- and 128-row tiles: only the SP2 loop carries the wave-group-specific waits");
    const int K = g.K, nt = g.nt ? g.nt : K / BK;
    unsigned voffA[2], voffB[2];
#pragma unroll
    for (int i = 0; i < 2; ++i) { int R, C; stage_rc(tid * 16 + i * 8192, R, C); const int Rb = Epi::PERM ? ((R & ~31) + perm32(R & 31)) : R;
        voffA[i] = (unsigned)(R * K + C) * 2u; voffB[i] = (unsigned)(Rb * K + C) * 2u; }
    const size_t kstep = (size_t)(BK * 2);
    const size_t hstep = (size_t)HALF * K * 2, hstepA = (size_t)(32 * MQ) * K * 2;
    const size_t tstep = 2 * hstep, tstepA = 2 * hstepA;
    const unsigned ldsw = (unsigned)wid * 1024u;
    const int aoff = lds_byte(wr * (16 * MQ) + fr, fq * 8), boff = lds_byte(wc * 32 + fr, fq * 8);
#define PG8_SA(b, h) (((b) * 2 + (h)) * HTB)
#define PG8_SB(b, h) ((4 + (b) * 2 + (h)) * HTB)
#define PG8_STAGE(bufoff, gbase, voff) do { _Pragma("unroll") for (int _i = 0; _i < 2; ++_i) \
        __builtin_amdgcn_global_load_lds((const unsigned*)((const char*)(gbase) + (voff)[_i]), (PG8_LAS unsigned*)(lds + (bufoff) + ldsw + _i * 8192), 16, 0, 0); } while (0)
#define PG8_STAGE_A(bufoff, gbase) do { __builtin_amdgcn_global_load_lds((const unsigned*)((const char*)(gbase) + voffA[0]), (PG8_LAS unsigned*)(lds + (bufoff) + ldsw), 16, 0, 0); \
        if (MQ == 4 || (MQ == 3 && wid < 4)) __builtin_amdgcn_global_load_lds((const unsigned*)((const char*)(gbase) + voffA[1]), (PG8_LAS unsigned*)(lds + (bufoff) + ldsw + 8192), 16, 0, 0); } while (0)
#define PG8_LDA(dst, b, h) do { _Pragma("unroll") for (int m = 0; m < MQ; ++m) _Pragma("unroll") for (int k = 0; k < 2; ++k) dst[m][k] = *(const PG8_LAS bf16x8*)(lds + PG8_SA(b, h) + aoff + m * 2048 + k * 1024); } while (0)
#define PG8_LDB(dst, b, h) do { _Pragma("unroll") for (int n = 0; n < 2; ++n) _Pragma("unroll") for (int k = 0; k < 2; ++k) dst[n][k] = *(const PG8_LAS bf16x8*)(lds + PG8_SB(b, h) + boff + n * 2048 + k * 1024); } while (0)
#define PG8_MMA(ai, bj, At, Bt) do { __builtin_amdgcn_s_setprio(1); _Pragma("unroll") for (int m = 0; m < MQ; ++m) _Pragma("unroll") for (int n = 0; n < 2; ++n) _Pragma("unroll") for (int k = 0; k < 2; ++k) \
        acc[ai][bj][m][n] = __builtin_amdgcn_mfma_f32_16x16x32_bf16(Bt[n][k], At[m][k], acc[ai][bj][m][n], 0, 0, 0); __builtin_amdgcn_s_setprio(0); } while (0)
#define PG8_WAIT_V(n) asm volatile("s_waitcnt vmcnt(" #n ")" ::: "memory")
#define PG8_WAIT_V8 do { if (MQ == 2 || (MQ == 3 && wid >= 4)) PG8_WAIT_V(6); else PG8_WAIT_V(8); } while (0)
#define PG8_WAIT_L(n) asm volatile("s_waitcnt lgkmcnt(" #n ")" ::: "memory")
#define PG8_BAR __builtin_amdgcn_s_barrier()
#define PG8_SCHED __builtin_amdgcn_sched_barrier(0)
    Unit cur, nxt; int ui = 0;
    if (!S.next(0, cur)) return;
    f32x4 acc[2][2][MQ][2];
#pragma unroll
    for (int a = 0; a < 2; ++a)
#pragma unroll
        for (int b = 0; b < 2; ++b)
#pragma unroll
            for (int m = 0; m < MQ; ++m)
#pragma unroll
                for (int n = 0; n < 2; ++n) acc[a][b][m][n] = (f32x4){0.f, 0.f, 0.f, 0.f};
    bf16x8 At[MQ][2], B0[2][2], B1[2][2];
    const char* cA = (const char*)g.A + (size_t)cur.pm * tstepA; const char* cB = (const char*)g.Bt + (size_t)cur.pn * tstep;
    S.a_ready(cur);
    if constexpr (SP2) {
        PG8_STAGE(PG8_SB(0, 0), cB, voffB); PG8_STAGE(PG8_SB(0, 1), cB + hstep, voffB); PG8_STAGE_A(PG8_SA(0, 0), cA); PG8_STAGE_A(PG8_SA(0, 1), cA + hstepA);
        if (wr == 1) PG8_BAR;
        if (MQ == 2 || (MQ == 3 && wid >= 4)) PG8_WAIT_V(1); else PG8_WAIT_V(2);
        PG8_BAR;
        PG8_STAGE(PG8_SB(1, 0), cB + kstep, voffB); PG8_STAGE_A(PG8_SA(1, 0), cA + kstep); PG8_STAGE(PG8_SB(1, 1), cB + hstep + kstep, voffB);
        if (MQ == 2 || (MQ == 3 && wid >= 4)) PG8_WAIT_V(5); else PG8_WAIT_V(6);
        PG8_BAR;
    } else {
        PG8_STAGE(PG8_SB(0, 0), cB, voffB); PG8_STAGE_A(PG8_SA(0, 0), cA); PG8_STAGE(PG8_SB(0, 1), cB + hstep, voffB); PG8_STAGE_A(PG8_SA(0, 1), cA + hstepA);
        if (wr == 1) PG8_BAR;
        PG8_WAIT_V(4); PG8_BAR;
        PG8_STAGE(PG8_SB(1, 0), cB + kstep, voffB); PG8_STAGE_A(PG8_SA(1, 0), cA + kstep); PG8_STAGE(PG8_SB(1, 1), cB + hstep + kstep, voffB);
        PG8_WAIT_V(6); PG8_BAR;
    }
    for (;;) {
        const bool has_next = S.next(ui + 1, nxt);
        const char* nA = has_next ? (const char*)g.A + (size_t)nxt.pm * tstepA : cA; const char* nB = has_next ? (const char*)g.Bt + (size_t)nxt.pn * tstep : cB;
        for (int t = 0; t < nt; t += 2) {
            const bool last = (t == nt - 2);
            const char* a1 = cA + (size_t)(t + 1) * kstep;
            const char* a2 = last ? nA : cA + (size_t)(t + 2) * kstep; const char* b2 = last ? nB : cB + (size_t)(t + 2) * kstep;
            const char* a3 = a2 + kstep; const char* b3 = b2 + kstep;
            if (last && has_next) S.a_ready(nxt);
            if constexpr (SP2) {
            PG8_LDB(B0, 0, 0); PG8_LDB(B1, 0, 1); PG8_SCHED; PG8_LDA(At, 0, 0); PG8_STAGE_A(PG8_SA(1, 1), a1 + hstepA);
            PG8_WAIT_V8; PG8_WAIT_L(0); PG8_BAR; PG8_MMA(0, 0, At, B0); PG8_MMA(0, 1, At, B1); PG8_BAR; PG8_SCHED;
            PG8_LDA(At, 0, 1); PG8_STAGE(PG8_SB(0, 0), b2, voffB); PG8_STAGE(PG8_SB(0, 1), b2 + hstep, voffB); PG8_STAGE_A(PG8_SA(0, 0), a2);
            PG8_WAIT_V8; PG8_WAIT_L(0); PG8_BAR; PG8_MMA(1, 0, At, B0); PG8_MMA(1, 1, At, B1); PG8_BAR; PG8_SCHED;
            PG8_LDB(B0, 1, 0); PG8_LDB(B1, 1, 1); PG8_SCHED; PG8_LDA(At, 1, 0); PG8_STAGE_A(PG8_SA(0, 1), a2 + hstepA);
            PG8_WAIT_V8; PG8_WAIT_L(0); PG8_BAR; PG8_MMA(0, 0, At, B0); PG8_MMA(0, 1, At, B1); PG8_BAR; PG8_SCHED;
            PG8_LDA(At, 1, 1); PG8_STAGE(PG8_SB(1, 0), b3, voffB); PG8_STAGE(PG8_SB(1, 1), b3 + hstep, voffB); PG8_STAGE_A(PG8_SA(1, 0), a3);
            PG8_WAIT_V8; PG8_WAIT_L(0); PG8_BAR; PG8_MMA(1, 0, At, B0); PG8_MMA(1, 1, At, B1); PG8_BAR; PG8_SCHED;
            } else {
            PG8_LDB(B0, 0, 0); PG8_SCHED; PG8_LDA(At, 0, 0); PG8_STAGE_A(PG8_SA(1, 1), a1 + hstepA);
            PG8_WAIT_L(8); PG8_BAR; PG8_WAIT_L(0); PG8_MMA(0, 0, At, B0); PG8_BAR; PG8_SCHED;
            PG8_LDB(B1, 0, 1); PG8_STAGE(PG8_SB(0, 0), b2, voffB);
            PG8_BAR; PG8_WAIT_L(0); PG8_MMA(0, 1, At, B1); PG8_BAR;
            PG8_LDA(At, 0, 1); PG8_STAGE_A(PG8_SA(0, 0), a2);
            PG8_BAR; PG8_WAIT_L(0); PG8_MMA(1, 0, At, B0); PG8_BAR; PG8_SCHED;
            PG8_STAGE(PG8_SB(0, 1), b2 + hstep, voffB);
            PG8_WAIT_V(6); PG8_BAR; PG8_MMA(1, 1, At, B1); PG8_BAR;
            PG8_LDB(B0, 1, 0); PG8_SCHED; PG8_LDA(At, 1, 0); PG8_STAGE_A(PG8_SA(0, 1), a2 + hstepA);
            PG8_WAIT_L(8); PG8_BAR; PG8_WAIT_L(0); PG8_MMA(0, 0, At, B0); PG8_BAR; PG8_SCHED;
            PG8_LDB(B1, 1, 1); PG8_STAGE(PG8_SB(1, 0), b3, voffB);
            PG8_BAR; PG8_WAIT_L(0); PG8_MMA(0, 1, At, B1); PG8_BAR;
            PG8_LDA(At, 1, 1); PG8_STAGE_A(PG8_SA(1, 0), a3);
            PG8_BAR; PG8_WAIT_L(0); PG8_MMA(1, 0, At, B0); PG8_BAR; PG8_SCHED;
            PG8_STAGE(PG8_SB(1, 1), b3 + hstep, voffB);
            PG8_WAIT_V(6); PG8_BAR; PG8_MMA(1, 1, At, B1); PG8_BAR;
            }
        }
        if constexpr (ALIGN_EPI) { if (wr == 0) PG8_BAR; }
        if constexpr (!Epi::AFTER_DRAIN) { E(acc, cur, wr, wc, fr, fq); S.done(cur); }
        if (!has_next) break;
#pragma unroll
        for (int a = 0; a < 2; ++a)
#pragma unroll
            for (int b = 0; b < 2; ++b)
#pragma unroll
                for (int m = 0; m < MQ; ++m)
#pragma unroll
                    for (int n = 0; n < 2; ++n) acc[a][b][m][n] = (f32x4){0.f, 0.f, 0.f, 0.f};
        cur = nxt; cA = nA; cB = nB; ++ui;
        if constexpr (ALIGN_EPI) { if (wr == 1) PG8_BAR; }
    }
    PG8_WAIT_V(0);
    if constexpr (!ALIGN_EPI) { if (wr == 0) PG8_BAR; }
    PG8_BAR;
    if constexpr (Epi::AFTER_DRAIN) { E.fused(acc, cur, wr, wc, fr, fq, lds, wid, lane); S.done(cur); }
#undef PG8_SA
#undef PG8_SB
#undef PG8_STAGE
#undef PG8_LDA
#undef PG8_LDB
#undef PG8_MMA
#undef PG8_WAIT_V
#undef PG8_WAIT_V8
#undef PG8_STAGE_A
#undef PG8_WAIT_L
#undef PG8_BAR
#undef PG8_SCHED
}
}

#ifndef PG8_SP2
#define PG8_SP2 true
#endif
#ifndef PG8_ALIGN
#define PG8_ALIGN true
#endif
#ifndef MK_ONE_LAUNCH
#define MK_ONE_LAUNCH 1
#endif

constexpr int NWAVES = 8;
constexpr int DM = 4096, SEQ = 2048, NB = 4, DB = 128, DS = 8, MP = NB * SEQ, MS = DB * DS, M = MP + MS;
constexpr int DFF = 11008, NGRP = 256, NST = 64, NCH = 16, PBUF = 15;
constexpr float RMS_EPS = 1e-6f;
constexpr int N_PHASES = 10;
constexpr size_t O_YP = 0, O_YS = (size_t)MP * DM, O_SRP = O_YS + (size_t)MS * DM, O_SIP = O_SRP + (size_t)NB * NGRP * NST, O_PP = O_SIP + (size_t)NB * NGRP * NST,
                 O_SRS = O_PP + (size_t)NB * PBUF * DM, O_SIS = O_SRS + (size_t)DB * NGRP * NST, O_PS = O_SIS + (size_t)DB * NGRP * NST, O_END = O_PS + (size_t)DB * PBUF * DM;
constexpr size_t MiB = 1u << 20;
constexpr size_t WS_CTL = 0, CTL_ZERO_BYTES = 1 * MiB;
constexpr size_t WS_WGLU = 16 * MiB, WS_WGU0 = 80 * MiB, WS_WGU1 = 252 * MiB, WS_WDN0 = 424 * MiB, WS_WDN1 = 510 * MiB, WS_WPOOL = 596 * MiB;
constexpr size_t WS_XRES = 608 * MiB, WS_HA = 752 * MiB, WS_YSSM = 824 * MiB, WS_PPOOL = 896 * MiB, WS_HID = 968 * MiB, WS_SSMP = 1164 * MiB, WS_RSTD = 1169 * MiB, WS_END = 1170 * MiB;
static_assert(WS_WGLU + (size_t)2 * DM * DM * 2 <= WS_WGU0 && WS_WGU0 + (size_t)2 * DFF * DM * 2 <= WS_WGU1 && WS_WGU1 + (size_t)2 * DFF * DM * 2 <= WS_WDN0 && WS_WDN0 + (size_t)DM * DFF * 2 <= WS_WDN1 &&
              WS_WDN1 + (size_t)DM * DFF * 2 <= WS_WPOOL && WS_WPOOL + (size_t)4 * 1024 * 1024 * 2 <= WS_XRES && WS_XRES + (size_t)M * DM * 4 <= WS_HA && WS_HA + (size_t)M * DM * 2 <= WS_YSSM &&
              WS_YSSM + (size_t)M * DM * 2 <= WS_PPOOL && WS_PPOOL + (size_t)M * DM * 2 <= WS_HID && WS_HID + (size_t)M * DFF * 2 <= WS_SSMP, "d_ws map");
constexpr size_t SPB_AR = 0, SPB_AI = 65536, SPB_BF = 131072, SPB_CF = 131072 + 1048576;
constexpr int CW_BAR = 4096;
constexpr int CW_SPLIT = 65536;
constexpr int CW_SSQ = 16384;
constexpr int RING_OFF = 0, RING_BYTES = 131072;
constexpr int LDSCTL_OFF = RING_BYTES, MISC_OFF = LDSCTL_OFF + 320;
constexpr int LDS_BYTES = 147456;
static_assert(MISC_OFF + 128 <= LDS_BYTES, "LDS map");

#define GAS __attribute__((address_space(1)))
#define LAS __attribute__((address_space(3)))
typedef unsigned short bf16;
typedef unsigned v4u __attribute__((ext_vector_type(4)));
typedef float f32x4 __attribute__((ext_vector_type(4)));
typedef short bf16x8 __attribute__((ext_vector_type(8)));
typedef GAS unsigned gu32;
typedef GAS unsigned long long gu64;
#define RLX_AGENT __ATOMIC_RELAXED, __HIP_MEMORY_SCOPE_AGENT
#define LDS_WAIT() asm volatile("s_waitcnt lgkmcnt(0)" ::: "memory")
#define VM_WAIT() asm volatile("s_waitcnt vmcnt(0)" ::: "memory")
__device__ __forceinline__ unsigned long long rt() { return __builtin_amdgcn_s_memrealtime(); }
__device__ __forceinline__ unsigned f2bf(float f) { unsigned u = __builtin_bit_cast(unsigned, f); return (u + 0x7fffu + ((u >> 16) & 1u)) >> 16; }
__device__ __forceinline__ unsigned pk2(float lo, float hi) { return f2bf(lo) | (f2bf(hi) << 16); }

#define XB_TMO      128
#define XB_XCNT(j)  (256  + 64 * (j))
#define XB_XSUB(j)  (1280 + 64 * (j))
#define XB_XGEN(j)  (2304 + 64 * (j))
#define XB_TOP      3328
#define XB_TOPGEN   3392
#define XCD_BAR_WORDS 3456
#define XB_SPIN_CAP (1u << 18)

__device__ __forceinline__ unsigned xb_ld(unsigned* p)              { return __hip_atomic_load(p, __ATOMIC_RELAXED, __HIP_MEMORY_SCOPE_AGENT); }
__device__ __forceinline__ unsigned xb_add(unsigned* p, unsigned v) { return __hip_atomic_fetch_add(p, v, __ATOMIC_RELAXED, __HIP_MEMORY_SCOPE_AGENT); }
__device__ __forceinline__ unsigned xb_xcc_id() { return (unsigned)__builtin_amdgcn_s_getreg((3 << 11) | 20) & 0xFu; }
#define XB_SPIN(cond, bar) do { unsigned _sp = 0; while (cond) { __builtin_amdgcn_s_sleep(1); \
    if ((++_sp & 255u) == 0u) { if (xb_ld(&(bar)[XB_TMO])) break; if (_sp > XB_SPIN_CAP) { atomicAdd(&(bar)[XB_TMO], 1u); break; } } } } while (0)

struct XcdBarrier {
    unsigned* bar; unsigned x;
    volatile LAS unsigned* st;
};

__device__ __forceinline__ XcdBarrier xcd_barrier_post(unsigned* bar, volatile LAS unsigned* st) {
    XcdBarrier b; b.bar = bar; b.x = xb_xcc_id(); b.st = st;
    if (threadIdx.x == 0) (void)xb_add(&bar[XB_XCNT(b.x)], 1u);
    return b;
}
__device__ __forceinline__ void xcd_barrier_complete(unsigned* bar, unsigned x, unsigned& nloc, unsigned& nx) {
    const unsigned G = gridDim.x * gridDim.y * gridDim.z;
    unsigned sum, cnt, mine, sp = 0u;
    for (;;) {
        sum = 0u; cnt = 0u; mine = 0u;
#pragma unroll
        for (unsigned j = 0; j < 16; ++j) { const unsigned c = xb_ld(&bar[XB_XCNT(j)]); sum += c; cnt += (c > 0u) ? 1u : 0u; mine = (j == x) ? c : mine; }
        if (sum == G) break;
        __builtin_amdgcn_s_sleep(1);
        if ((++sp & 255u) == 0u) { if (xb_ld(&bar[XB_TMO])) break; if (sp > XB_SPIN_CAP) { atomicAdd(&bar[XB_TMO], 1u); break; } }
    }
    nloc = mine > 0u ? mine : 1u; nx = cnt > 0u ? cnt : 1u;
}

__device__ __forceinline__ void xcd_barrier(const XcdBarrier& b) {
    asm volatile("s_waitcnt vmcnt(0)" ::: "memory");
    __syncthreads();
    if (threadIdx.x == 0) {
        unsigned* bar = b.bar;
        __builtin_amdgcn_s_waitcnt(0);
        unsigned nloc = b.st[0], nx = b.st[1];
        if (nloc == 0u) { xcd_barrier_complete(bar, b.x, nloc, nx); b.st[0] = nloc; b.st[1] = nx; }
        const unsigned old = xb_add(&bar[XB_XSUB(b.x)], 1u);
        const unsigned gen = old / nloc;
        if (old + 1u == (gen + 1u) * nloc) {
            __builtin_amdgcn_fence(__ATOMIC_RELEASE, "agent");
            asm volatile("s_waitcnt vmcnt(0)" ::: "memory");
            const unsigned og = xb_add(&bar[XB_TOP], 1u);
            const unsigned tg = og / nx;
            if (og + 1u == (tg + 1u) * nx) xb_add(&bar[XB_TOPGEN], 1u);
            else XB_SPIN(xb_ld(&bar[XB_TOPGEN]) == tg, bar);
            __builtin_amdgcn_fence(__ATOMIC_ACQUIRE, "agent");
            xb_add(&bar[XB_XGEN(b.x)], 1u);
            asm volatile("s_waitcnt vmcnt(0)" ::: "memory");
        } else {
            XB_SPIN(xb_ld(&bar[XB_XGEN(b.x)]) == gen, bar);
            __builtin_amdgcn_fence(__ATOMIC_ACQUIRE, "agent");
            asm volatile("s_waitcnt vmcnt(0)" ::: "memory");
        }
    }
    __syncthreads();
}

struct Frame {
    LAS unsigned char* lds;
    volatile LAS unsigned* MISC;
    gu32* ctl;
    int tid, lane, wave;
    int vcu, G;
    const float* in[21];
    float* out;
    unsigned char* ws;
};
enum { I_XP = 0, I_XS, I_SRE, I_SIM, I_SPOOL, I_NMIX, I_NFFN, I_LRE, I_LIM, I_LSTEP, I_BRE, I_BIM, I_CRE, I_CIM, I_SD, I_WGLU, I_WPOOL, I_PSCALE, I_WGU, I_WDN, I_NFIN };

__device__ __forceinline__ float wave_sum(float v) {
#pragma unroll
    for (int o = 1; o < 64; o <<= 1) v += __shfl_xor(v, o);
    return v;
}
typedef float f32x2_t __attribute__((ext_vector_type(2)));
typedef __bf16 b16x2_t __attribute__((ext_vector_type(2)));
typedef float f32x16 __attribute__((ext_vector_type(16)));
__device__ __forceinline__ unsigned cvtpk(float lo, float hi) { return __builtin_bit_cast(unsigned, __builtin_convertvector((f32x2_t){lo, hi}, b16x2_t)); }
__device__ __forceinline__ const float* xrow_in(const Frame& F, int r) { return r < MP ? F.in[I_XP] + (size_t)r * DM : F.in[I_XS] + (size_t)(r - MP) * DM; }

__device__ __forceinline__ void tr_item(const float* W, int K, int N, bf16* WT, int k0, int n0, int drow0, int lane, const float* kgain = nullptr) {
    const int kq = lane >> 3, nq = lane & 7;
    f32x4 v[2][8];
#pragma unroll
    for (int h = 0; h < 2; ++h)
#pragma unroll
        for (int i = 0; i < 8; ++i) v[h][i] = __builtin_nontemporal_load((const GAS f32x4*)(W + (size_t)(k0 + 8 * kq + i) * N + n0 + 32 * h + 4 * nq));
    if (kgain) {
        const f32x4 g0 = *(const GAS f32x4*)(kgain + k0 + 8 * kq), g1 = *(const GAS f32x4*)(kgain + k0 + 8 * kq + 4);
#pragma unroll
        for (int h = 0; h < 2; ++h)
#pragma unroll
            for (int i = 0; i < 8; ++i) v[h][i] = v[h][i] * (i < 4 ? g0[i & 3] : g1[i & 3]);
    }
#pragma unroll
    for (int h = 0; h < 2; ++h)
#pragma unroll
        for (int j = 0; j < 4; ++j) { v4u o; o.x = cvtpk(v[h][0][j], v[h][1][j]); o.y = cvtpk(v[h][2][j], v[h][3][j]); o.z = cvtpk(v[h][4][j], v[h][5][j]); o.w = cvtpk(v[h][6][j], v[h][7][j]);
            *(GAS v4u*)(WT + (size_t)(drow0 + 32 * h + 4 * nq + j) * K + k0 + 8 * kq) = o; }
}
__device__ __forceinline__ int drow_pair(int n0, int NH) { const int half = n0 >= NH ? 1 : 0, nn = n0 - half * NH; return 256 * (nn >> 7) + 128 * half + (nn & 127); }

__device__ __forceinline__ double exp_d(double x) {
    const double k = __builtin_rint(x * 1.4426950408889634074); const double r = x - k * 0.69314718055994530942;
    double s = 1.0, t = 1.0;
#pragma unroll
    for (int i = 1; i <= 16; ++i) { t *= r * (1.0 / (double)i); s += t; }
    const long long e = (long long)k + 1023; return s * __builtin_bit_cast(double, (unsigned long long)e << 52);
}
__device__ __forceinline__ void sincos_d(double th, double& sn, double& cs) {
    const double n = __builtin_rint(th * 0.15915494309189533577); const double r = (th - n * 6.283185307179586232) - n * 2.4492935982947064e-16; const double r2 = r * r;
    double s = r, c = 1.0, ts = r, tc = 1.0;
#pragma unroll
    for (int i = 1; i <= 15; ++i) { tc *= r2 * (-1.0 / (double)((2 * i - 1) * (2 * i))); ts *= r2 * (-1.0 / (double)((2 * i) * (2 * i + 1))); c += tc; s += ts; }
    sn = s; cs = c;
}

constexpr int CI_GLU = (DM / 64) * (2 * DM / 64), CI_GU = (DM / 64) * (2 * DFF / 64), CI_DN = (DFF / 64) * (DM / 64), CI_PL = 4 * 16 * 16;
constexpr int CI_L0 = CI_GLU + CI_GU + CI_DN, CI_ALL = CI_L0 + CI_GU + CI_DN + CI_PL;
__device__ __forceinline__ void convert_weights(Frame& F, int lo, int hi, int first, int step) {
    LAS unsigned* ctr = (LAS unsigned*)(F.lds + MISC_OFF + 80);
    for (;;) {
        unsigned k = 0; if (F.lane == 0) k = __hip_atomic_fetch_add(ctr, 1u, __ATOMIC_RELAXED, __HIP_MEMORY_SCOPE_WORKGROUP);
        k = (unsigned)__builtin_amdgcn_readfirstlane((int)k);
        const long itl = (long)lo + first + (long)step * k; if (itl >= hi) break;
        int r = (int)itl;
        if (r < CI_GLU) { const int nb = r % (2 * DM / 64), kb = r / (2 * DM / 64); tr_item(F.in[I_WGLU], DM, 2 * DM, (bf16*)(F.ws + WS_WGLU), kb * 64, nb * 64, drow_pair(nb * 64, DM), F.lane); continue; } r -= CI_GLU;
        if (r >= 2 * CI_GU + CI_DN && r < 2 * CI_GU + CI_DN + CI_PL) { r -= 2 * CI_GU + CI_DN; const int g = r / 256; r -= g * 256; const int nb = r % 16, kb = r / 16;
            tr_item(F.in[I_WPOOL] + (size_t)g * 1024 * 1024, 1024, 1024, (bf16*)(F.ws + WS_WPOOL) + (size_t)g * 1024 * 1024, kb * 64, nb * 64, nb * 64, F.lane); continue; }
        int l, isdn;
        if (r < CI_GU) { l = 0; isdn = 0; } else if (r < CI_GU + CI_DN) { r -= CI_GU; l = 0; isdn = 1; } else if (r < 2 * CI_GU + CI_DN) { r -= CI_GU + CI_DN; l = 1; isdn = 0; } else { r -= 2 * CI_GU + CI_DN + CI_PL; l = 1; isdn = 1; }
        if (!isdn) { const int nb = r % (2 * DFF / 64), kb = r / (2 * DFF / 64);
            tr_item(F.in[I_WGU] + (size_t)l * DM * 2 * DFF, DM, 2 * DFF, (bf16*)(F.ws + (l ? WS_WGU1 : WS_WGU0)), kb * 64, nb * 64, drow_pair(nb * 64, DFF), F.lane, F.in[I_NFFN] + l * DM); continue; }
        { const int nb = r % (DM / 64), kb = r / (DM / 64);
            tr_item(F.in[I_WDN] + (size_t)l * DFF * DM, DFF, DM, (bf16*)(F.ws + (l ? WS_WDN1 : WS_WDN0)), kb * 64, nb * 64, nb * 64, F.lane); }
    }
}
__device__ __forceinline__ void convert_reset(Frame& F) { __syncthreads(); if (F.tid == 0) *(LAS unsigned*)(F.lds + MISC_OFF + 80) = 0u; __syncthreads(); }
__device__ __forceinline__ void p0_prologue(Frame& F) {
    const int gw = F.vcu * NWAVES + F.wave, NGW = F.G * NWAVES;
    float* rstd0 = (float*)(F.ws + WS_RSTD);
    for (int r = gw; r < M; r += NGW) { const GAS f32x4* xr = (const GAS f32x4*)xrow_in(F, r) + F.lane; float s = 0.f;
#pragma unroll
        for (int j = 0; j < 16; ++j) { const f32x4 v = xr[64 * j]; s += (v.x * v.x + v.y * v.y) + (v.z * v.z + v.w * v.w); }
        s = wave_sum(s); if (F.lane == 0) rstd0[r] = 1.0f / sqrtf(s * (1.0f / DM) + RMS_EPS); }
    unsigned char* spb = F.ws + WS_SSMP;
    for (int idx = F.vcu * (NWAVES * 64) + F.tid; idx < NGRP * NST; idx += F.G * NWAVES * 64) {
        const int g = idx >> 6, p = idx & 63, ti = p >> 5, sl = p & 31;
        const double lr = (double)F.in[I_LRE][idx], li = (double)F.in[I_LIM][idx], dt = exp_d((double)F.in[I_LSTEP][g]);
        const double mag = exp_d(lr * dt); double sn, cs; sincos_d(li * dt, sn, cs);
        const double ar = mag * cs, ai = mag * sn, den = lr * lr + li * li;
        const double fr = ((ar - 1.0) * lr + ai * li) / den, fi = (ai * lr - (ar - 1.0) * li) / den;
        ((float*)(spb + SPB_AR))[idx] = (float)ar; ((float*)(spb + SPB_AI))[idx] = (float)ai;
#pragma unroll
        for (int hl = 0; hl < 2; ++hl) { float re[8], im[8];
#pragma unroll
            for (int c4 = 0; c4 < 2; ++c4) { const f32x4 br = *(const GAS f32x4*)(F.in[I_BRE] + (size_t)idx * 16 + 8 * hl + 4 * c4), bi = *(const GAS f32x4*)(F.in[I_BIM] + (size_t)idx * 16 + 8 * hl + 4 * c4);
                const f32x4 gn = *(const GAS f32x4*)(F.in[I_NMIX] + g * 16 + 8 * hl + 4 * c4);
#pragma unroll
                for (int j = 0; j < 4; ++j) { re[4 * c4 + j] = (float)((fr * (double)br[j] - fi * (double)bi[j]) * (double)gn[j]); im[4 * c4 + j] = (float)((fr * (double)bi[j] + fi * (double)br[j]) * (double)gn[j]); } }
            const int ln = 32 * hl + sl; v4u o;
            o.x = cvtpk(re[0], re[1]); o.y = cvtpk(re[2], re[3]); o.z = cvtpk(re[4], re[5]); o.w = cvtpk(re[6], re[7]);
            *(GAS v4u*)(spb + SPB_BF + ((size_t)(((g * 2 + ti) * 2 + 0) * 64 + ln)) * 16) = o;
            o.x = cvtpk(im[0], im[1]); o.y = cvtpk(im[2], im[3]); o.z = cvtpk(im[4], im[5]); o.w = cvtpk(im[6], im[7]);
            *(GAS v4u*)(spb + SPB_BF + ((size_t)(((g * 2 + ti) * 2 + 1) * 64 + ln)) * 16) = o; }
    }
    for (int idx = F.vcu * (NWAVES * 64) + F.tid; idx < NGRP * 4 * 64; idx += F.G * NWAVES * 64) {
        const int g = idx >> 8, ks = (idx >> 6) & 3, ln = idx & 63, q = ln >> 4, c = ln & 15, p0 = 16 * ks + 4 * q;
        const f32x4 cr = *(const GAS f32x4*)(F.in[I_CRE] + ((size_t)g * 16 + c) * NST + p0), ci = *(const GAS f32x4*)(F.in[I_CIM] + ((size_t)g * 16 + c) * NST + p0);
        v4u o; o.x = cvtpk(cr[0], -ci[0]); o.y = cvtpk(cr[1], -ci[1]); o.z = cvtpk(cr[2], -ci[2]); o.w = cvtpk(cr[3], -ci[3]);
        *(GAS v4u*)(spb + SPB_CF + (size_t)idx * 16) = o;
    }
}

__device__ __forceinline__ float gelu_tanh(float x) { const float z = 0.7978845608028654f * (x + 0.044715f * x * x * x); return x * __builtin_amdgcn_rcpf(1.0f + __expf(-2.0f * z)); }
template <bool SAMPLE>
__device__ __forceinline__ void ssm_run(Frame& F, int g, int sel) {
    const int lane = F.lane, hl = lane >> 5, sl = lane & 31, q = lane >> 4, cl = lane & 15;
    const unsigned char* spb = F.ws + WS_SSMP; const float* rstd0 = (const float*)(F.ws + WS_RSTD);
    bf16x8 bfr[2][2], cfr[4];
#pragma unroll
    for (int ti = 0; ti < 2; ++ti)
#pragma unroll
        for (int part = 0; part < 2; ++part) bfr[ti][part] = *(const GAS bf16x8*)(spb + SPB_BF + ((size_t)(((g * 2 + ti) * 2 + part) * 64 + lane)) * 16);
#pragma unroll
    for (int ks = 0; ks < 4; ++ks) cfr[ks] = *(const GAS bf16x8*)(spb + SPB_CF + ((size_t)((g * 4 + ks) * 64 + lane)) * 16);
    float ar[2], ai[2];
#pragma unroll
    for (int ti = 0; ti < 2; ++ti) { ar[ti] = ((const float*)(spb + SPB_AR))[g * NST + 32 * ti + sl]; ai[ti] = ((const float*)(spb + SPB_AI))[g * NST + 32 * ti + sl]; }
    const f32x4 dg = *(const GAS f32x4*)(F.in[I_SD] + g * 16 + 4 * q) * *(const GAS f32x4*)(F.in[I_NMIX] + g * 16 + 4 * q);
    const int hA = (sl >> 2) & 1, rA = (sl & 3) + 4 * (sl >> 3);
    const int hE = (cl >> 2) & 1, rE = (cl & 3) + 4 * (cl >> 3);
    LAS unsigned char* xl = F.lds + RING_OFF + F.wave * 8704;
    LAS unsigned* xw = (LAS unsigned*)(xl + hl * (4 * 272) + sl * 4);
    const LAS unsigned char* xrd = xl + cl * 272 + q * 16;
    int rowA, rowE[2], nch; float xr[2], xi[2], xr2[2], xi2[2]; float *o1r, *o1i, *o2r = nullptr, *o2i = nullptr;
    if constexpr (SAMPLE) { const int b0 = 4 * sel; nch = 1;
        rowA = MP + (b0 + 2 * hA + (rA >> 3)) * DS + (rA & 7); rowE[0] = MP + (b0 + 2 * hE) * DS + rE; rowE[1] = MP + (b0 + 2 * hE + 1) * DS + rE;
        const size_t s1 = ((size_t)(b0 + 2 * hl) * NGRP + g) * NST + sl, s2 = s1 + (size_t)NGRP * NST;
#pragma unroll
        for (int ti = 0; ti < 2; ++ti) { xr[ti] = F.in[I_SRE][s1 + 32 * ti]; xi[ti] = F.in[I_SIM][s1 + 32 * ti]; xr2[ti] = F.in[I_SRE][s2 + 32 * ti]; xi2[ti] = F.in[I_SIM][s2 + 32 * ti]; }
        o1r = F.out + O_SRS + s1; o1i = F.out + O_SIS + s1; o2r = F.out + O_SRS + s2; o2i = F.out + O_SIS + s2;
    } else { const int seq0 = 2 * sel; nch = SEQ / 16;
        rowA = (seq0 + hA) * SEQ + rA; rowE[0] = (seq0 + hE) * SEQ + rE; rowE[1] = rowE[0] + 8;
#pragma unroll
        for (int ti = 0; ti < 2; ++ti) { xr[ti] = 0.f; xi[ti] = 0.f; xr2[ti] = 0.f; xi2[ti] = 0.f; }
        const size_t s1 = ((size_t)(seq0 + hl) * NGRP + g) * NST + sl; o1r = F.out + O_SRP + s1; o1i = F.out + O_SIP + s1;
    }
    f32x16 zero16;
#pragma unroll
    for (int i = 0; i < 16; ++i) zero16[i] = 0.f;
    f32x4 nx0, nx1, nxe[2]; float nrs, nre[2];
    { const float* xp = xrow_in(F, rowA) + g * 16 + 8 * hl; nx0 = *(const GAS f32x4*)xp; nx1 = *(const GAS f32x4*)(xp + 4); nrs = rstd0[rowA];
#pragma unroll
      for (int rt = 0; rt < 2; ++rt) { nxe[rt] = *(const GAS f32x4*)(xrow_in(F, rowE[rt]) + g * 16 + 4 * q); nre[rt] = rstd0[rowE[rt]]; } }
    for (int ch = 0; ch < nch; ++ch) {
        const f32x4 x0 = nx0, x1 = nx1; const float rs = nrs;
        f32x4 xe[2]; float re[2];
#pragma unroll
        for (int rt = 0; rt < 2; ++rt) { xe[rt] = nxe[rt]; re[rt] = nre[rt]; }
        if (ch + 1 < nch) { const int ra = rowA + 16 * (ch + 1); const float* xp = xrow_in(F, ra) + g * 16 + 8 * hl; nx0 = *(const GAS f32x4*)xp; nx1 = *(const GAS f32x4*)(xp + 4); nrs = rstd0[ra];
#pragma unroll
            for (int rt = 0; rt < 2; ++rt) { const int r = rowE[rt] + 16 * (ch + 1); nxe[rt] = *(const GAS f32x4*)(xrow_in(F, r) + g * 16 + 4 * q); nre[rt] = rstd0[r]; } }
        v4u au; au.x = cvtpk(x0[0] * rs, x0[1] * rs); au.y = cvtpk(x0[2] * rs, x0[3] * rs); au.z = cvtpk(x1[0] * rs, x1[1] * rs); au.w = cvtpk(x1[2] * rs, x1[3] * rs);
        const bf16x8 afr = __builtin_bit_cast(bf16x8, au);
#pragma unroll
        for (int ti = 0; ti < 2; ++ti) {
            f32x16 dr = __builtin_amdgcn_mfma_f32_32x32x16_bf16(afr, bfr[ti][0], zero16, 0, 0, 0);
            f32x16 di = __builtin_amdgcn_mfma_f32_32x32x16_bf16(afr, bfr[ti][1], zero16, 0, 0, 0);
            float sr = xr[ti], si = xi[ti];
#pragma unroll
            for (int r = 0; r < 16; ++r) {
                if (SAMPLE && r == 8) { o1r[32 * ti] = sr; o1i[32 * ti] = si; sr = xr2[ti]; si = xi2[ti]; }
                const float nr = fmaf(-ai[ti], si, fmaf(ar[ti], sr, dr[r])), ni = fmaf(ai[ti], sr, fmaf(ar[ti], si, di[r])); sr = nr; si = ni;
                xw[(((r & 3) + 8 * (r >> 2)) * 272 + ti * 128) / 4] = cvtpk(sr, si);
            }
            xr[ti] = sr; xi[ti] = si;
        }
        asm volatile("s_waitcnt lgkmcnt(0)" ::: "memory"); __builtin_amdgcn_sched_barrier(0);
        f32x4 y[2];
#pragma unroll
        for (int rt = 0; rt < 2; ++rt) { y[rt] = (f32x4){0.f, 0.f, 0.f, 0.f};
#pragma unroll
            for (int ks = 0; ks < 4; ++ks) { const bf16x8 xf = *(const LAS bf16x8*)(xrd + rt * (16 * 272) + ks * 64); y[rt] = __builtin_amdgcn_mfma_f32_16x16x32_bf16(cfr[ks], xf, y[rt], 0, 0, 0); } }
        asm volatile("s_waitcnt lgkmcnt(0)" ::: "memory"); __builtin_amdgcn_sched_barrier(0);
#pragma unroll
        for (int rt = 0; rt < 2; ++rt) { const int r = rowE[rt] + 16 * ch; f32x4 v;
#pragma unroll
            for (int j = 0; j < 4; ++j) v[j] = gelu_tanh(y[rt][j] + dg[j] * (xe[rt][j] * re[rt]));
            *(GAS unsigned long long*)((bf16*)(F.ws + WS_YSSM) + (size_t)r * DM + g * 16 + 4 * q) = (unsigned long long)cvtpk(v[0], v[1]) | ((unsigned long long)cvtpk(v[2], v[3]) << 32); }
    }
    if constexpr (SAMPLE) {
#pragma unroll
        for (int ti = 0; ti < 2; ++ti) { o2r[32 * ti] = xr[ti]; o2i[32 * ti] = xi[ti]; }
    } else {
#pragma unroll
        for (int ti = 0; ti < 2; ++ti) { o1r[32 * ti] = xr[ti]; o1i[32 * ti] = xi[ti]; }
    }
}
__device__ __forceinline__ void p1_ssm(Frame& F) {
    if (F.wave < 2) {
        for (int task = F.vcu * 2 + F.wave; task < 2 * NGRP; task += F.G * 2) ssm_run<false>(F, task & 255, task >> 8);
    } else {
        for (int task = F.vcu * 6 + (F.wave - 2); task < 32 * NGRP; task += F.G * 6) ssm_run<true>(F, task & 255, task >> 8);
    }
    convert_weights(F, 0, F.G == 256 ? CI_GLU + CI_GU : CI_L0, F.vcu, F.G);
}

__device__ __forceinline__ void final_norm(Frame& F, const float* gain, const float* ssq, float* dst) {
    (void)ssq;
    const float* X = (const float*)(F.ws + WS_XRES); const int gw = F.vcu * NWAVES + F.wave, NGW = F.G * NWAVES;
    f32x4 v[16], w[16];
    if (gw < M) { const GAS f32x4* xr = (const GAS f32x4*)(X + (size_t)gw * DM) + F.lane;
#pragma unroll
        for (int u = 0; u < 16; ++u) v[u] = __builtin_nontemporal_load(xr + 64 * u); }
    for (int r = gw; r < M; r += NGW) {
        const int rn = r + NGW;
        if (rn < M) { const GAS f32x4* xr = (const GAS f32x4*)(X + (size_t)rn * DM) + F.lane;
#pragma unroll
            for (int u = 0; u < 16; ++u) w[u] = __builtin_nontemporal_load(xr + 64 * u); }
        float s = 0.f;
#pragma unroll
        for (int u = 0; u < 16; ++u) s += (v[u].x * v[u].x + v[u].y * v[u].y) + (v[u].z * v[u].z + v[u].w * v[u].w);
        s = wave_sum(s);
        const float rs = __builtin_amdgcn_rsqf(s * (1.0f / DM) + RMS_EPS);
        GAS f32x4* dr = (GAS f32x4*)(dst + (size_t)r * DM) + F.lane; const GAS f32x4* gr = (const GAS f32x4*)gain + F.lane;
#pragma unroll
        for (int u = 0; u < 16; ++u) __builtin_nontemporal_store(v[u] * rs * gr[64 * u], dr + 64 * u);
#pragma unroll
        for (int u = 0; u < 16; ++u) v[u] = w[u];
    }
}
template <int GI, int R, bool PROMPT> __device__ __forceinline__ void pool_elem_g(Frame& F, int vb, int nb) {
    constexpr int W = 2 << GI, NH = R + W - 1, RBASE = PROMPT ? 0 : MP, NROWS = PROMPT ? MP : MS;
    const float* X = (const float*)(F.ws + WS_XRES); const float* ssq1 = (const float*)(F.ctl + CW_SSQ) + M; const float* gain = F.in[I_NMIX] + DM;
    bf16* PP = (bf16*)(F.ws + WS_PPOOL);
    const size_t NT = (size_t)nb * NWAVES * 64;
    static_assert(PROMPT || R == DS, "a sample sequence is exactly one strip");
    for (size_t idx = (size_t)vb * NWAVES * 64 + F.tid; idx < (size_t)(NROWS / R) * 256; idx += NT) {
        const int r0 = RBASE + (int)(idx >> 8) * R, q = (int)(idx & 255), c = GI * 1024 + 4 * q;
        const f32x4 gv = *(const GAS f32x4*)(gain + c);
        constexpr bool prompt = PROMPT; const int t0 = prompt ? (r0 & (SEQ - 1)) : 0; const int b = (r0 - MP) >> 3;
        f32x4 hv[NH]; float sq[NH];
#pragma unroll
        for (int k = 0; k < NH; ++k) { const int d = k - (W - 1), tt = t0 + d; const bool inseq = tt >= 0;
            const float* src = inseq ? X + (size_t)(r0 + d) * DM + c : (prompt ? X + (size_t)r0 * DM + c : F.in[I_SPOOL] + ((size_t)b * PBUF + (PBUF + tt)) * DM + c);
            hv[k] = *(const GAS f32x4*)src; sq[k] = ssq1[inseq ? r0 + d : r0]; }
#pragma unroll
        for (int k = 0; k < NH; ++k) { const bool inseq = (t0 + k - (W - 1)) >= 0; const float rs = __builtin_amdgcn_rsqf(sq[k] * (1.0f / DM) + RMS_EPS);
            hv[k] = hv[k] * (inseq ? gv * rs : (prompt ? (f32x4){0.f, 0.f, 0.f, 0.f} : (f32x4){1.f, 1.f, 1.f, 1.f})); }
#pragma unroll
        for (int i = 0; i < R; ++i) { const int r = r0 + i, t = t0 + i; const f32x4 h = hv[i + W - 1]; f32x4 s = h;
#pragma unroll
            for (int j = 1; j < W; ++j) s += hv[i + W - 1 - j];
            const float cnt = prompt ? (float)((t + 1) < W ? (t + 1) : W) : (float)W;
            const f32x4 p = s / cnt - h;
            *(GAS unsigned long long*)(PP + ((size_t)GI * M + r) * 1024 + 4 * q) = (unsigned long long)cvtpk(p.x, p.y) | ((unsigned long long)cvtpk(p.z, p.w) << 32);
            if (prompt) { if (t >= SEQ - PBUF) *(GAS f32x4*)(F.out + O_PP + ((size_t)(r >> 11) * PBUF + (t - (SEQ - PBUF))) * DM + c) = h; }
            else { float* ob = F.out + O_PS + (size_t)b * PBUF * DM + c;
                *(GAS f32x4*)(ob + (size_t)(PBUF - DS + t) * DM) = h;
                if (t < PBUF - DS) *(GAS f32x4*)(ob + (size_t)t * DM) = *(const GAS f32x4*)(F.in[I_SPOOL] + ((size_t)b * PBUF + DS + t) * DM + c); } }
    }
}
__device__ __forceinline__ void pool_elem(Frame& F) {
    pool_elem_g<3, 8, true>(F, F.vcu, F.G); pool_elem_g<2, 16, true>(F, F.vcu, F.G); pool_elem_g<1, 16, true>(F, F.vcu, F.G); pool_elem_g<0, 16, true>(F, F.vcu, F.G);
    if (F.G % 4 == 0) { const int nb = F.G / 4, vb = F.vcu % nb;
        switch (F.vcu / nb) { case 0: pool_elem_g<0, 8, false>(F, vb, nb); break; case 1: pool_elem_g<1, 8, false>(F, vb, nb); break; case 2: pool_elem_g<2, 8, false>(F, vb, nb); break; default: pool_elem_g<3, 8, false>(F, vb, nb); break; } }
    else { pool_elem_g<0, 8, false>(F, F.vcu, F.G); pool_elem_g<1, 8, false>(F, F.vcu, F.G); pool_elem_g<2, 8, false>(F, F.vcu, F.G); pool_elem_g<3, 8, false>(F, F.vcu, F.G); }
}

__device__ __forceinline__ void down_phase(Frame& F, const unsigned char* wdn, float* ssq_l, int layer) {
    unsigned char* ws = F.ws;
    if (F.G == 256) {
        { pg8::Gemm g{(const pg8::bf16_t*)(ws + WS_HID), (const pg8::bf16_t*)wdn, MP, DM, DFF, 0}; pg8::MallOrder S; S.init(MP, DM, F.G, (int)blockIdx.x, 256, 2);
          pg8::EpiResid<false> E{(float*)(ws + WS_XRES), nullptr, nullptr, ssq_l, 36};
          pg8::gemm_phase<pg8::EpiResid<false>, pg8::MallOrder, PG8_ALIGN, PG8_SP2>(F.lds + RING_OFF, g, S, E); }
        const int c = (int)blockIdx.x, part = c >> 6, unit = (c & 7) * 8 + ((c >> 3) & 7);
        const int kt0 = part == 0 ? 0 : part == 1 ? 36 : part == 2 ? 82 : 128, ntp = part == 0 ? 36 : part == 3 ? 44 : 46;
        pg8::Gemm g{(const pg8::bf16_t*)(ws + WS_HID) + kt0 * 64, (const pg8::bf16_t*)wdn + kt0 * 64, M, DM, DFF, ntp};
        unsigned* ctr = (unsigned*)(F.ctl + CW_SPLIT) + (layer * 64 + unit) * 16;
        pg8::EpiResidSplit E{(float*)(ws + WS_XRES), ssq_l, (float*)(ws + WS_YSSM) + (size_t)unit * 3 * 65536, ctr, part};
        pg8::SplitOrder S{c, 32};
        pg8::gemm_phase<pg8::EpiResidSplit, pg8::SplitOrder, PG8_ALIGN, PG8_SP2>(F.lds + RING_OFF, g, S, E);
        if (part != 0) { __syncthreads();
            if (F.tid == 0) { __builtin_amdgcn_fence(__ATOMIC_RELEASE, "agent"); asm volatile("s_waitcnt vmcnt(0)" ::: "memory"); (void)__hip_atomic_fetch_add(ctr, 1u, __ATOMIC_RELAXED, __HIP_MEMORY_SCOPE_AGENT); } }
    } else {
        pg8::Gemm g{(const pg8::bf16_t*)(ws + WS_HID), (const pg8::bf16_t*)wdn, M, DM, DFF, 0}; pg8::MallOrder S; S.init(M, DM, F.G, (int)blockIdx.x, 192, 2);
        pg8::EpiResid<false> E{(float*)(ws + WS_XRES), nullptr, nullptr, ssq_l, 36};
        pg8::gemm_phase<pg8::EpiResid<false>, pg8::MallOrder, PG8_ALIGN, PG8_SP2, 3>(F.lds + RING_OFF, g, S, E);
    }
}

struct Args { const float* in[21]; float* out; unsigned char* ws; int ph_lo, ph_hi; };
__global__ void __launch_bounds__(NWAVES * 64, 2) skel_fwd(Args args) {
    extern __shared__ __attribute__((aligned(16))) unsigned char lds[];
    Frame F;
    F.lds = (LAS unsigned char*)lds;
    F.MISC = (volatile LAS unsigned*)(F.lds + MISC_OFF);
    F.tid = threadIdx.x; F.lane = F.tid & 63; F.wave = __builtin_amdgcn_readfirstlane(F.tid >> 6);
    F.G = gridDim.x; { const int bx = blockIdx.x; F.vcu = (F.G % 8 == 0) ? (bx % 8) * (F.G / 8) + bx / 8 : bx; }
    unsigned char* ws = args.ws; F.ws = ws; F.out = args.out;
    F.ctl = (gu32*)(ws + WS_CTL);
#pragma unroll
    for (int i = 0; i < 21; ++i) F.in[i] = args.in[i];
    for (int u = F.tid; u < (LDS_BYTES - LDSCTL_OFF) / 4; u += NWAVES * 64) ((LAS unsigned*)(F.lds + LDSCTL_OFF))[u] = 0u;
    __syncthreads();
    const int lo = args.ph_lo, hi = args.ph_hi;
    const bool use_bar = (hi - lo) > 1;
    XcdBarrier bar; bar.bar = (unsigned*)(F.ctl + CW_BAR); bar.x = 0; bar.st = nullptr;
    if (use_bar) bar = xcd_barrier_post((unsigned*)(F.ctl + CW_BAR), F.MISC + 8);
#define IN(k) (lo <= (k) && (k) < hi)
#define SEAM(k) do { if (IN(k) && IN((k) + 1)) xcd_barrier(bar); } while (0)

    float* ssq = (float*)(F.ctl + CW_SSQ);
    if (IN(0)) { p0_prologue(F); SEAM(0); }
    if (IN(1)) { p1_ssm(F); SEAM(1); }
    if (IN(2)) {
        pg8::Gemm g{(const pg8::bf16_t*)(ws + WS_YSSM), (const pg8::bf16_t*)(ws + WS_WGLU), M, 2 * DM, DM}; pg8::MallOrder S; S.init(M, 2 * DM, F.G, (int)blockIdx.x, 256, 1);
        pg8::EpiGlu E{F.in[I_XP], F.in[I_XS], (float*)(ws + WS_XRES), (pg8::bf16_t*)(ws + WS_HA), ssq};
        pg8::gemm_phase<pg8::EpiGlu, pg8::MallOrder, PG8_ALIGN, PG8_SP2>(F.lds + RING_OFF, g, S, E);
        { constexpr int NIDLE = 256 - (36 * 32) % 256, QUOTA = 60; const int j = (int)blockIdx.x - (256 - NIDLE);
          if (F.G == 256 && j >= 0) { convert_reset(F); convert_weights(F, CI_GLU + CI_GU, CI_L0, j, NIDLE); } }
        SEAM(2);
    }
    if (IN(3)) {
        pg8::Gemm g{(const pg8::bf16_t*)(ws + WS_HA), (const pg8::bf16_t*)(ws + WS_WGU0), M, 2 * DFF, DM}; pg8::MallOrder S; S.init(M, 2 * DFF, F.G, (int)blockIdx.x, 256, 1);
        pg8::EpiSwiglu E{(pg8::bf16_t*)(ws + WS_HID), DFF, ssq};
        pg8::gemm_phase<pg8::EpiSwiglu, pg8::MallOrder, PG8_ALIGN, PG8_SP2>(F.lds + RING_OFF, g, S, E);
        { constexpr int NIDLE = 256 - (36 * 86) % 256, LO = CI_L0 + 128 * 60, HI = CI_ALL - CI_DN; const int j = (int)blockIdx.x - (256 - NIDLE);
          if (F.G == 256) { if (j >= 0) { convert_reset(F); convert_weights(F, CI_L0, HI, j, NIDLE); } }
          else { convert_reset(F); convert_weights(F, CI_L0, HI, F.vcu, F.G); } }
        SEAM(3);
    }
    if (IN(4)) { down_phase(F, ws + WS_WDN0, ssq + M, 0); SEAM(4); }
    if (IN(5)) { pool_elem(F); SEAM(5); }
    if (IN(6)) {
        pg8::Gemm g{(const pg8::bf16_t*)(ws + WS_PPOOL), (const pg8::bf16_t*)(ws + WS_WPOOL), 4 * M, 4096, 1024}; pg8::PoolOrder S{F.G, (int)blockIdx.x, 48};
        pg8::EpiResid<true> E{(float*)(ws + WS_XRES), F.in[I_PSCALE], (pg8::bf16_t*)(ws + WS_HA), ssq + 2 * M, 48};
        pg8::gemm_phase<pg8::EpiResid<true>, pg8::PoolOrder, PG8_ALIGN, PG8_SP2, 3>(F.lds + RING_OFF, g, S, E);
        SEAM(6);
    }
    if (IN(7)) {
        pg8::Gemm g{(const pg8::bf16_t*)(ws + WS_HA), (const pg8::bf16_t*)(ws + WS_WGU1), M, 2 * DFF, DM};
        pg8::EpiSwiglu E{(pg8::bf16_t*)(ws + WS_HID), DFF, ssq + 2 * M};
        constexpr int NU = 36 * 86, NT = NU % 256;
        if (F.G == 256) {
            pg8::MallOrder S; S.init(M, 2 * DFF, F.G, (int)blockIdx.x, 256, 1, NU / 256);
            pg8::gemm_phase<pg8::EpiSwiglu, pg8::MallOrder, PG8_ALIGN, PG8_SP2>(F.lds + RING_OFF, g, S, E);
            pg8::TailOrder T{S, NT, NU / 256};
            pg8::gemm_phase<pg8::EpiSwiglu, pg8::TailOrder, PG8_ALIGN, PG8_SP2, 2>(F.lds + RING_OFF, g, T, E);
            const int j = (int)blockIdx.x - 2 * NT;
            if (j >= 0) { convert_reset(F); convert_weights(F, CI_ALL - CI_DN, CI_ALL, j, 256 - 2 * NT); }
        } else {
            pg8::MallOrder S; S.init(M, 2 * DFF, F.G, (int)blockIdx.x, 256, 1);
            pg8::gemm_phase<pg8::EpiSwiglu, pg8::MallOrder, PG8_ALIGN, PG8_SP2>(F.lds + RING_OFF, g, S, E);
            convert_reset(F); convert_weights(F, CI_ALL - CI_DN, CI_ALL, F.vcu, F.G);
        }
        SEAM(7);
    }
    if (IN(8)) { down_phase(F, ws + WS_WDN1, nullptr, 1); SEAM(8); }
    if (IN(9)) { final_norm(F, F.in[I_NFIN], ssq + 3 * M, F.out + O_YP); }
#undef IN
#undef SEAM
}

extern "C" void kernel_launch(void* const* d_in, const int* in_sizes, int n_in, void* d_out, int out_size, void* d_ws, size_t ws_size, hipStream_t stream) {
    static int grid = 0;
    if (grid == 0) {
        if (n_in != 21 || in_sizes[0] != MP * DM || (size_t)out_size != O_END || ws_size < WS_END) { fprintf(stderr, "kernel_launch: unexpected shapes (n_in %d, in0 %d, out %d, ws %zu); nothing launched\n", n_in, n_in > 0 ? in_sizes[0] : -1, out_size, ws_size); grid = -1; return; }
        int dev = 0, cus = 0, per_cu = 0;
        if (hipGetDevice(&dev) != hipSuccess || hipDeviceGetAttribute(&cus, hipDeviceAttributeMultiprocessorCount, dev) != hipSuccess) { grid = -1; return; }
        if (hipFuncSetAttribute((const void*)skel_fwd, hipFuncAttributeMaxDynamicSharedMemorySize, LDS_BYTES) != hipSuccess) { fprintf(stderr, "kernel_launch: hipFuncSetAttribute failed\n"); grid = -1; return; }
        if (hipOccupancyMaxActiveBlocksPerMultiprocessor(&per_cu, (const void*)skel_fwd, NWAVES * 64, LDS_BYTES) != hipSuccess || per_cu < 1) { fprintf(stderr, "kernel_launch: occupancy query says %d blocks per CU\n", per_cu); }
        (void)hipGetLastError();
        grid = cus;
    }
    if (grid < 0) return;
    if (hipMemsetAsync((char*)d_ws + WS_CTL, 0, CTL_ZERO_BYTES, stream) != hipSuccess) return;
    Args a{};
    for (int i = 0; i < 21; ++i) a.in[i] = (const float*)d_in[i];
    a.out = (float*)d_out; a.ws = (unsigned char*)d_ws;
#if MK_ONE_LAUNCH
    a.ph_lo = 0; a.ph_hi = N_PHASES;
    hipLaunchKernelGGL(skel_fwd, dim3(grid), dim3(NWAVES * 64), LDS_BYTES, stream, a);
#else
    for (int ph = 0; ph < N_PHASES; ++ph) { a.ph_lo = ph; a.ph_hi = ph + 1; hipLaunchKernelGGL(skel_fwd, dim3(grid), dim3(NWAVES * 64), LDS_BYTES, stream, a); }
#endif
}
```
